# Optimizing an MI355X kernel written in HIP

```python
import jax, jax.numpy as jnp
from jax import lax
import numpy as np

D_MODEL = 2048
BATCH = 1
SEQ = 8192
DEPTH = 1

PLE_DIM = 256
CONV_A_WIDTH = 1024
CONV_A_K = 3
CONF_WIDTH = 1024
CONF_K = 31
D_FF = -(-8 * D_MODEL // (3 * 256)) * 256
EPS = 1e-6
LN_EPS = 1e-5

IN_SPLIT_SIZES = (
    CONV_A_WIDTH,
    CONV_A_WIDTH,
    CONV_A_WIDTH,
    CONF_WIDTH,
    CONF_WIDTH,
    D_MODEL,
    D_MODEL,
)
IN_COLS = sum(IN_SPLIT_SIZES)

kernel_name = "hybrid_gated_conv_conformer_block"


def rmsnorm(x, g):
    xf = x.astype(jnp.float32)
    y = xf * lax.rsqrt(jnp.mean(xf * xf, axis=-1, keepdims=True) + EPS)
    return (y * g.astype(jnp.float32)).astype(x.dtype)


def layernorm(x, g, b):
    xf = x.astype(jnp.float32)
    mu = jnp.mean(xf, axis=-1, keepdims=True)
    xc = xf - mu
    var = jnp.mean(xc * xc, axis=-1, keepdims=True)
    y = xc * lax.rsqrt(var + LN_EPS)
    return (y * g.astype(jnp.float32) + b.astype(jnp.float32)).astype(x.dtype)


def causal_depthwise_conv(u, w):
    k, c = w.shape
    return lax.conv_general_dilated(
        u, w[:, None, :].astype(u.dtype),
        window_strides=(1,), padding=[(k - 1, 0)],
        dimension_numbers=("NWC", "WIO", "NWC"),
        feature_group_count=c)


def setup_inputs(seed: int = 0) -> dict:
    key = jax.random.key(seed)
    ks = jax.random.split(key, 24)
    f32 = jnp.float32
    L = DEPTH

    def nrm(k, shape, scale):
        return jax.random.normal(k, shape, f32) * scale

    def gain(k, shape):
        return 1.0 + 0.02 * jax.random.normal(k, shape, f32)

    return {
        "x": jax.random.normal(ks[0], (BATCH, SEQ, D_MODEL), f32),
        "p": jax.random.normal(ks[1], (DEPTH, BATCH, SEQ, PLE_DIM), f32),
        "g_mix": gain(ks[2], (L, D_MODEL)),
        "w_in": nrm(ks[3], (L, D_MODEL, IN_COLS), D_MODEL ** -0.5),
        "conv_a_w": nrm(ks[4], (L, CONV_A_K, CONV_A_WIDTH), CONV_A_K ** -0.5),
        "w_out_a": nrm(ks[5], (L, CONV_A_WIDTH, D_MODEL), CONV_A_WIDTH ** -0.5),
        "b_glu": nrm(ks[6], (L, 2 * CONF_WIDTH), 0.02),
        "conf_dw_w": nrm(ks[7], (L, CONF_K, CONF_WIDTH), CONF_K ** -0.5),
        "conf_dw_b": nrm(ks[8], (L, CONF_WIDTH), 0.02),
        "conf_ln_g": gain(ks[9], (L, CONF_WIDTH)),
        "conf_ln_b": nrm(ks[10], (L, CONF_WIDTH), 0.02),
        "w_pw_b": nrm(ks[11], (L, CONF_WIDTH, D_MODEL), CONF_WIDTH ** -0.5),
        "b_pw_b": nrm(ks[12], (L, D_MODEL), 0.02),
        "w_o": nrm(ks[13], (L, D_MODEL, D_MODEL), D_MODEL ** -0.5),
        "g_ffn": gain(ks[14], (L, D_MODEL)),
        "w_gate": nrm(ks[15], (L, D_MODEL, D_FF), D_MODEL ** -0.5),
        "w_up": nrm(ks[16], (L, D_MODEL, D_FF), D_MODEL ** -0.5),
        "w_down": nrm(ks[17], (L, D_FF, D_MODEL), D_FF ** -0.5),
        "g_ple": gain(ks[18], (L, D_MODEL)),
        "w_ple_gate": nrm(ks[19], (L, D_MODEL, D_MODEL), D_MODEL ** -0.5),
        "w_ple_proj": nrm(ks[20], (L, PLE_DIM, D_MODEL), PLE_DIM ** -0.5),
        "g_final": gain(ks[21], (D_MODEL,)),
    }


def reference(x, p, g_mix, w_in, conv_a_w, w_out_a, b_glu, conf_dw_w, conf_dw_b,
              conf_ln_g, conf_ln_b, w_pw_b, b_pw_b, w_o, g_ffn, w_gate, w_up, w_down,
              g_ple, w_ple_gate, w_ple_proj, g_final):
    h = x
    cuts = np.cumsum(IN_SPLIT_SIZES)[:-1].tolist()
    for i in range(DEPTH):
        n = rmsnorm(h, g_mix[i])
        proj = jnp.einsum("bsd,dc->bsc", n, w_in[i])
        a_h, a_b, a_c, glu_v, glu_g, gate_a, gate_b = jnp.split(proj, cuts, axis=-1)

        y_a = a_b * causal_depthwise_conv(a_c * a_h, conv_a_w[i])
        y_a = jnp.einsum("bsc,cd->bsd", y_a, w_out_a[i])

        bv, bg = jnp.split(b_glu[i], 2)
        u = (glu_v + bv) * jax.nn.sigmoid(glu_g + bg)
        v = causal_depthwise_conv(u, conf_dw_w[i]) + conf_dw_b[i]
        v = jax.nn.silu(layernorm(v, conf_ln_g[i], conf_ln_b[i]))
        y_b = jnp.einsum("bsc,cd->bsd", v, w_pw_b[i]) + b_pw_b[i]

        m = jax.nn.sigmoid(gate_a) * y_a + jax.nn.sigmoid(gate_b) * y_b
        h = h + jnp.einsum("bsd,de->bse", m, w_o[i])

        n2 = rmsnorm(h, g_ffn[i])
        f = jax.nn.silu(jnp.einsum("bsd,df->bsf", n2, w_gate[i])) * jnp.einsum("bsd,df->bsf", n2, w_up[i])
        h = h + jnp.einsum("bsf,fd->bsd", f, w_down[i])

        n3 = rmsnorm(h, g_ple[i])
        ple = jnp.einsum("bse,ed->bsd", p[i].astype(h.dtype), w_ple_proj[i])
        h = h + jax.nn.sigmoid(jnp.einsum("bsd,de->bse", n3, w_ple_gate[i])) * ple

    return rmsnorm(h, g_final)
```

```cpp
#include <hip/hip_runtime.h>
#include <hip/hip_cooperative_groups.h>
#include <cstdio>
#include <cstdint>
namespace cg = cooperative_groups;
namespace pg8 {
#define PG8_LAS __attribute__((address_space(3)))
typedef unsigned short bf16_t;
typedef short bf16x8 __attribute__((ext_vector_type(8)));
typedef float f32x4 __attribute__((ext_vector_type(4)));
typedef unsigned u32x4 __attribute__((ext_vector_type(4)));
constexpr int BM = 256, BK = 64, HALF = 128, HTB = HALF * BK * 2  , STAGE_BYTES = 8 * HTB, NXCD = 8, WGM = 8;

__host__ __device__ __forceinline__ int lds_byte(int r, int c) { const int st = (r >> 4) * 2 + (c >> 5), rr = r & 15, cc = c & 31, ob = rr * 64 + cc * 2; return st * 1024 + (ob ^ (((ob >> 9) & 1) << 5)); }
__host__ __device__ __forceinline__ void stage_rc(int b, int& R, int& C) { const int st = b / 1024, sb = b % 1024, swz = sb ^ (((sb >> 9) & 1) << 5); R = (st >> 1) * 16 + swz / 64; C = (st & 1) * 32 + (swz % 64) / 2; }
__host__ __device__ __forceinline__ int perm32(int rho) { const int n = rho >> 4, i = rho & 15; return 8 * (i >> 2) + 4 * n + (i & 3); }

struct Unit { int pm, pn; };
struct Gemm { const bf16_t* A; const bf16_t* Bt; int M, N, K; };

struct StaticOrder {
    int nM, nN, nwg, G, c;
    __host__ __device__ void init(int M, int N, int G_, int c_) { nM = M / BM; nN = N / BM; nwg = nM * nN; G = G_; c = c_; }
    __host__ __device__ bool next(int i, Unit& u) const {
        const long L = (long)i * G + c; if (L >= nwg) return false;
        int wgid = (int)L; { const int q = nwg / NXCD, r = nwg % NXCD, xcd = wgid % NXCD, off = wgid / NXCD; wgid = (xcd < r ? xcd * (q + 1) : r * (q + 1) + (xcd - r) * q) + off; }
        const int nig = WGM * nN, gid = wgid / nig, fm = gid * WGM, gsz = (nM - fm) < WGM ? (nM - fm) : WGM;
        u.pm = fm + ((wgid % nig) % gsz); u.pn = (wgid % nig) / gsz; return true;
    }
    __device__ __forceinline__ void a_ready(const Unit&) const {}
    __device__ __forceinline__ void done(const Unit&) const {}
};

__device__ __forceinline__ unsigned cvt_pk_bf16(float lo, float hi) { unsigned r; asm volatile("v_cvt_pk_bf16_f32 %0, %1, %2" : "=v"(r) : "v"(lo), "v"(hi)); return r; }
typedef float f32x2 __attribute__((ext_vector_type(2)));
template <class Epi, class Sched, bool ALIGN_EPI = false, bool SP2 = false>
__device__ __forceinline__ void gemm_phase(PG8_LAS unsigned char* lds, const Gemm g, const Sched& S, const Epi& E) {
    const int tid = threadIdx.x, wid = __builtin_amdgcn_readfirstlane(tid >> 6), lane = tid & 63, wr = wid >> 2, wc = wid & 3, fr = lane & 15, fq = lane >> 4;
    const int K = g.K, nt = K / BK;
    unsigned voffA[2], voffB[2];
#pragma unroll
    for (int i = 0; i < 2; ++i) { int R, C; stage_rc(tid * 16 + i * 8192, R, C); const int Rb = Epi::PERM ? ((R & ~31) + perm32(R & 31)) : R;
        voffA[i] = (unsigned)(R * K + C) * 2u; voffB[i] = (unsigned)(Rb * K + C) * 2u; }
    const size_t kstep = (size_t)(BK * 2);
    const size_t hstep = (size_t)HALF * K * 2;
    const size_t tstep = 2 * hstep;
    const unsigned ldsw = (unsigned)wid * 1024u;
    const int aoff = lds_byte(wr * 64 + fr, fq * 8), boff = lds_byte(wc * 32 + fr, fq * 8);
#define PG8_SA(b, h) (((b) * 2 + (h)) * HTB)
#define PG8_SB(b, h) ((4 + (b) * 2 + (h)) * HTB)
#define PG8_STAGE(bufoff, gbase, voff) do { _Pragma("unroll") for (int _i = 0; _i < 2; ++_i) \
        __builtin_amdgcn_global_load_lds((const unsigned*)((const char*)(gbase) + (voff)[_i]), (PG8_LAS unsigned*)(lds + (bufoff) + ldsw + _i * 8192), 16, 0, 0); } while (0)
#define PG8_LDA(dst, b, h) do { _Pragma("unroll") for (int m = 0; m < 4; ++m) _Pragma("unroll") for (int k = 0; k < 2; ++k) dst[m][k] = *(const PG8_LAS bf16x8*)(lds + PG8_SA(b, h) + aoff + m * 2048 + k * 1024); } while (0)
#define PG8_LDB(dst, b, h) do { _Pragma("unroll") for (int n = 0; n < 2; ++n) _Pragma("unroll") for (int k = 0; k < 2; ++k) dst[n][k] = *(const PG8_LAS bf16x8*)(lds + PG8_SB(b, h) + boff + n * 2048 + k * 1024); } while (0)
#define PG8_MMA(ai, bj, At, Bt) do { __builtin_amdgcn_s_setprio(1); _Pragma("unroll") for (int m = 0; m < 4; ++m) _Pragma("unroll") for (int n = 0; n < 2; ++n) _Pragma("unroll") for (int k = 0; k < 2; ++k) \
        acc[ai][bj][m][n] = __builtin_amdgcn_mfma_f32_16x16x32_bf16(Bt[n][k], At[m][k], acc[ai][bj][m][n], 0, 0, 0); __builtin_amdgcn_s_setprio(0); } while (0)
#define PG8_WAIT_V(n) asm volatile("s_waitcnt vmcnt(" #n ")" ::: "memory")
#define PG8_WAIT_L(n) asm volatile("s_waitcnt lgkmcnt(" #n ")" ::: "memory")
#define PG8_BAR __builtin_amdgcn_s_barrier()
#define PG8_SCHED __builtin_amdgcn_sched_barrier(0)
    Unit cur, nxt; int ui = 0;
    if (!S.next(0, cur)) return;
    f32x4 acc[2][2][4][2];
#pragma unroll
    for (int a = 0; a < 2; ++a)
#pragma unroll
        for (int b = 0; b < 2; ++b)
#pragma unroll
            for (int m = 0; m < 4; ++m)
#pragma unroll
                for (int n = 0; n < 2; ++n) acc[a][b][m][n] = (f32x4){0.f, 0.f, 0.f, 0.f};
    bf16x8 At[4][2], B0[2][2], B1[2][2];
    const char* cA = (const char*)g.A + (size_t)cur.pm * tstep; const char* cB = (const char*)g.Bt + (size_t)cur.pn * tstep;
    S.a_ready(cur);
    if constexpr (SP2) {
        PG8_STAGE(PG8_SB(0, 0), cB, voffB); PG8_STAGE(PG8_SB(0, 1), cB + hstep, voffB); PG8_STAGE(PG8_SA(0, 0), cA, voffA); PG8_STAGE(PG8_SA(0, 1), cA + hstep, voffA);
        if (wr == 1) PG8_BAR;
        PG8_WAIT_V(2); PG8_BAR;
        PG8_STAGE(PG8_SB(1, 0), cB + kstep, voffB); PG8_STAGE(PG8_SA(1, 0), cA + kstep, voffA); PG8_STAGE(PG8_SB(1, 1), cB + hstep + kstep, voffB);
        PG8_WAIT_V(6); PG8_BAR;
    } else {
        PG8_STAGE(PG8_SB(0, 0), cB, voffB); PG8_STAGE(PG8_SA(0, 0), cA, voffA); PG8_STAGE(PG8_SB(0, 1), cB + hstep, voffB); PG8_STAGE(PG8_SA(0, 1), cA + hstep, voffA);
        if (wr == 1) PG8_BAR;
        PG8_WAIT_V(4); PG8_BAR;
        PG8_STAGE(PG8_SB(1, 0), cB + kstep, voffB); PG8_STAGE(PG8_SA(1, 0), cA + kstep, voffA); PG8_STAGE(PG8_SB(1, 1), cB + hstep + kstep, voffB);
        PG8_WAIT_V(6); PG8_BAR;
    }
    for (;;) {
        const bool has_next = S.next(ui + 1, nxt);
        const char* nA = has_next ? (const char*)g.A + (size_t)nxt.pm * tstep : cA; const char* nB = has_next ? (const char*)g.Bt + (size_t)nxt.pn * tstep : cB;
#pragma unroll 1
        for (int t = 0; t < nt; t += 2) {
            const bool last = (t == nt - 2);
            const char* a1 = cA + (size_t)(t + 1) * kstep;
            const char* a2 = last ? nA : cA + (size_t)(t + 2) * kstep; const char* b2 = last ? nB : cB + (size_t)(t + 2) * kstep;
            const char* a3 = a2 + kstep; const char* b3 = b2 + kstep;
            if (last && has_next) S.a_ready(nxt);
            if constexpr (SP2) {
            PG8_LDB(B0, 0, 0); PG8_LDB(B1, 0, 1); PG8_SCHED; PG8_LDA(At, 0, 0); PG8_STAGE(PG8_SA(1, 1), a1 + hstep, voffA);
            PG8_WAIT_V(8); PG8_WAIT_L(0); PG8_BAR; PG8_MMA(0, 0, At, B0); PG8_MMA(0, 1, At, B1); PG8_BAR; PG8_SCHED;
            PG8_LDA(At, 0, 1); PG8_STAGE(PG8_SB(0, 0), b2, voffB); PG8_STAGE(PG8_SB(0, 1), b2 + hstep, voffB); PG8_STAGE(PG8_SA(0, 0), a2, voffA);
            PG8_WAIT_V(8); PG8_WAIT_L(0); PG8_BAR; PG8_MMA(1, 0, At, B0); PG8_MMA(1, 1, At, B1); PG8_BAR; PG8_SCHED;
            PG8_LDB(B0, 1, 0); PG8_LDB(B1, 1, 1); PG8_SCHED; PG8_LDA(At, 1, 0); PG8_STAGE(PG8_SA(0, 1), a2 + hstep, voffA);
            PG8_WAIT_V(8); PG8_WAIT_L(0); PG8_BAR; PG8_MMA(0, 0, At, B0); PG8_MMA(0, 1, At, B1); PG8_BAR; PG8_SCHED;
            PG8_LDA(At, 1, 1); PG8_STAGE(PG8_SB(1, 0), b3, voffB); PG8_STAGE(PG8_SB(1, 1), b3 + hstep, voffB); PG8_STAGE(PG8_SA(1, 0), a3, voffA);
            PG8_WAIT_V(8); PG8_WAIT_L(0); PG8_BAR; PG8_MMA(1, 0, At, B0); PG8_MMA(1, 1, At, B1); PG8_BAR; PG8_SCHED;
            } else {
            PG8_LDB(B0, 0, 0); PG8_SCHED; PG8_LDA(At, 0, 0); PG8_STAGE(PG8_SA(1, 1), a1 + hstep, voffA);
            PG8_WAIT_L(8); PG8_BAR; PG8_WAIT_L(0); PG8_MMA(0, 0, At, B0); PG8_BAR; PG8_SCHED;
            PG8_LDB(B1, 0, 1); PG8_STAGE(PG8_SB(0, 0), b2, voffB);
            PG8_BAR; PG8_WAIT_L(0); PG8_MMA(0, 1, At, B1); PG8_BAR;
            PG8_LDA(At, 0, 1); PG8_STAGE(PG8_SA(0, 0), a2, voffA);
            PG8_BAR; PG8_WAIT_L(0); PG8_MMA(1, 0, At, B0); PG8_BAR; PG8_SCHED;
            PG8_STAGE(PG8_SB(0, 1), b2 + hstep, voffB);
            PG8_WAIT_V(6); PG8_BAR; PG8_MMA(1, 1, At, B1); PG8_BAR;
            PG8_LDB(B0, 1, 0); PG8_SCHED; PG8_LDA(At, 1, 0); PG8_STAGE(PG8_SA(0, 1), a2 + hstep, voffA);
            PG8_WAIT_L(8); PG8_BAR; PG8_WAIT_L(0); PG8_MMA(0, 0, At, B0); PG8_BAR; PG8_SCHED;
            PG8_LDB(B1, 1, 1); PG8_STAGE(PG8_SB(1, 0), b3, voffB);
            PG8_BAR; PG8_WAIT_L(0); PG8_MMA(0, 1, At, B1); PG8_BAR;
            PG8_LDA(At, 1, 1); PG8_STAGE(PG8_SA(1, 0), a3, voffA);
            PG8_BAR; PG8_WAIT_L(0); PG8_MMA(1, 0, At, B0); PG8_BAR; PG8_SCHED;
            PG8_STAGE(PG8_SB(1, 1), b3 + hstep, voffB);
            PG8_WAIT_V(6); PG8_BAR; PG8_MMA(1, 1, At, B1); PG8_BAR;
            }
        }
        if constexpr (ALIGN_EPI) { if (wr == 0) PG8_BAR; }
        if constexpr (!Epi::AFTER_DRAIN) { E(acc, cur, wr, wc, fr, fq); S.done(cur); }
        if (!has_next) break;
#pragma unroll
        for (int a = 0; a < 2; ++a)
#pragma unroll
            for (int b = 0; b < 2; ++b)
#pragma unroll
                for (int m = 0; m < 4; ++m)
#pragma unroll
                    for (int n = 0; n < 2; ++n) acc[a][b][m][n] = (f32x4){0.f, 0.f, 0.f, 0.f};
        cur = nxt; cA = nA; cB = nB; ++ui;
        if constexpr (ALIGN_EPI) { if (wr == 1) PG8_BAR; }
    }
    PG8_WAIT_V(0);
    if constexpr (!ALIGN_EPI) { if (wr == 0) PG8_BAR; }
    PG8_BAR;
    if constexpr (Epi::AFTER_DRAIN) { E.fused(acc, cur, wr, wc, fr, fq, lds, wid, lane); S.done(cur); }
#undef PG8_SA
#undef PG8_SB
#undef PG8_STAGE
#undef PG8_LDA
#undef PG8_LDB
#undef PG8_MMA
#undef PG8_WAIT_V
#undef PG8_WAIT_L
#undef PG8_BAR
#undef PG8_SCHED
}
}

#define LAS __attribute__((address_space(3)))
using pg8::bf16_t; using pg8::f32x4; using pg8::u32x4; using pg8::Unit; using pg8::cvt_pk_bf16;
typedef unsigned u32x2 __attribute__((ext_vector_type(2)));
typedef float f32x2 __attribute__((ext_vector_type(2)));

#ifndef MK_LAUNCHES
#define MK_LAUNCHES 1
#endif
constexpr int SEQ = 8192, DM = 2048, CW = 1024, NIN = 9216, DFF = 5632, PLE = 256;
constexpr float EPS = 1e-6f, LN_EPS = 1e-5f;
constexpr int NWAVES = 8, NTHR = 512, NPHASE = 9;
constexpr int LDS_BYTES = 147456;
constexpr size_t MiB = 1u << 20;
constexpr size_t WS_RSTD1 = 0, WS_SSQ2 = 64 * 1024, WS_SSQ3 = 128 * 1024, WS_SSQ4 = 192 * 1024;
constexpr size_t WS_WIN = 2 * MiB, WS_WOA = 38 * MiB, WS_WPW = 42 * MiB, WS_WO = 46 * MiB, WS_WGU = 54 * MiB, WS_WDN = 98 * MiB, WS_WPG = 120 * MiB, WS_WPP = 128 * MiB;
constexpr size_t WS_R0 = 130 * MiB;
constexpr size_t WS_Q = 162 * MiB, WS_AB = 178 * MiB, WS_U = 194 * MiB;
constexpr size_t WS_SGA = 210 * MiB, WS_SGB = 242 * MiB;
constexpr size_t WS_YA = 274 * MiB, WS_VB = 290 * MiB;
constexpr size_t WS_H1B = 162 * MiB;
constexpr size_t WS_F = 194 * MiB;
constexpr size_t WS_PLE = 162 * MiB;
constexpr size_t WS_PB = 306 * MiB;
constexpr size_t WS_END = 310 * MiB;

__device__ __forceinline__ float sigm(float x) { return __builtin_amdgcn_rcpf(1.f + __expf(-x)); }
__device__ __forceinline__ f32x4 sig4(f32x4 v) { return (f32x4){sigm(v[0]), sigm(v[1]), sigm(v[2]), sigm(v[3])}; }
__device__ __forceinline__ float bf_lo(unsigned w) { return __uint_as_float(w << 16); }
__device__ __forceinline__ float bf_hi(unsigned w) { return __uint_as_float(w & 0xffff0000u); }
__device__ __forceinline__ void st_bf16x8(bf16_t* p, f32x4 v0, f32x4 v1) {
    u32x4 w; w.x = cvt_pk_bf16(v0[0], v0[1]); w.y = cvt_pk_bf16(v0[2], v0[3]); w.z = cvt_pk_bf16(v1[0], v1[1]); w.w = cvt_pk_bf16(v1[2], v1[3]); *(u32x4*)p = w; }
__device__ __forceinline__ void ld_bf16x8(const bf16_t* p, f32x4& v0, f32x4& v1) {
    const u32x4 w = *(const u32x4*)p; v0 = (f32x4){bf_lo(w.x), bf_hi(w.x), bf_lo(w.y), bf_hi(w.y)}; v1 = (f32x4){bf_lo(w.z), bf_hi(w.z), bf_lo(w.w), bf_hi(w.w)}; }
__device__ __forceinline__ float dot4(f32x4 a) { return (a[0] * a[0] + a[1] * a[1]) + (a[2] * a[2] + a[3] * a[3]); }
__device__ __forceinline__ float wave_sum(float v) {
#pragma unroll
    for (int o = 1; o < 64; o <<= 1) v += __shfl_xor(v, o);
    return v;
}

struct EpiProj {
    static constexpr bool PERM = true, AFTER_DRAIN = false;
    const float* rstd; const float* bglu; bf16_t *Qo, *ABo, *Uo, *SA, *SB;
    __device__ __forceinline__ void operator()(const f32x4 (&acc)[2][2][4][2], const Unit& u, int wr, int wc, int fr, int fq) const {
        const int pn = u.pn, row0 = u.pm * 256 + wr * 64 + fr, cl = wc * 32 + 8 * fq;
        if (pn < 8) {
#pragma unroll
            for (int ai = 0; ai < 2; ++ai)
#pragma unroll
                for (int m = 0; m < 4; ++m) { const int row = row0 + ai * 128 + m * 16; const float r = rstd[row], r2 = r * r;
                    st_bf16x8(Qo + (size_t)row * CW + pn * 128 + cl, acc[ai][0][m][0] * acc[ai][1][m][0] * r2, acc[ai][0][m][1] * acc[ai][1][m][1] * r2); }
        } else if (pn < 12) {
#pragma unroll
            for (int ai = 0; ai < 2; ++ai)
#pragma unroll
                for (int m = 0; m < 4; ++m) { const int row = row0 + ai * 128 + m * 16; const float r = rstd[row];
#pragma unroll
                    for (int bj = 0; bj < 2; ++bj) st_bf16x8(ABo + (size_t)row * CW + (pn - 8) * 256 + bj * 128 + cl, acc[ai][bj][m][0] * r, acc[ai][bj][m][1] * r); }
        } else if (pn < 20) {
            const int ch = (pn - 12) * 128 + cl;
            const f32x4 bv0 = *(const f32x4*)(bglu + ch), bv1 = *(const f32x4*)(bglu + ch + 4), bg0 = *(const f32x4*)(bglu + CW + ch), bg1 = *(const f32x4*)(bglu + CW + ch + 4);
#pragma unroll
            for (int ai = 0; ai < 2; ++ai)
#pragma unroll
                for (int m = 0; m < 4; ++m) { const int row = row0 + ai * 128 + m * 16; const float r = rstd[row];
                    const f32x4 v0 = acc[ai][0][m][0] * r + bv0, v1 = acc[ai][0][m][1] * r + bv1, g0 = acc[ai][1][m][0] * r + bg0, g1 = acc[ai][1][m][1] * r + bg1;
                    st_bf16x8(Uo + (size_t)row * CW + ch, v0 * sig4(g0), v1 * sig4(g1)); }
        } else {
            bf16_t* S = pn < 28 ? SA : SB; const int cb = ((pn - 20) & 7) * 256 + cl;
#pragma unroll
            for (int ai = 0; ai < 2; ++ai)
#pragma unroll
                for (int m = 0; m < 4; ++m) { const int row = row0 + ai * 128 + m * 16; const float r = rstd[row];
#pragma unroll
                    for (int bj = 0; bj < 2; ++bj) st_bf16x8(S + (size_t)row * DM + cb + bj * 128, sig4(acc[ai][bj][m][0] * r), sig4(acc[ai][bj][m][1] * r)); }
        }
    }
};
struct EpiM1 {
    static constexpr bool PERM = true, AFTER_DRAIN = false;
    const bf16_t* SG; float* M1;
    __device__ __forceinline__ void operator()(const f32x4 (&acc)[2][2][4][2], const Unit& u, int wr, int wc, int fr, int fq) const {
        const int row0 = u.pm * 256 + wr * 64 + fr, c0 = u.pn * 256 + wc * 32 + 8 * fq;
#pragma unroll
        for (int ai = 0; ai < 2; ++ai)
#pragma unroll
            for (int m = 0; m < 4; ++m)
#pragma unroll
                for (int bj = 0; bj < 2; ++bj) { const size_t off = (size_t)(row0 + ai * 128 + m * 16) * DM + c0 + bj * 128; f32x4 g0, g1; ld_bf16x8(SG + off, g0, g1);
                    *(f32x4*)(M1 + off) = g0 * acc[ai][bj][m][0]; *(f32x4*)(M1 + off + 4) = g1 * acc[ai][bj][m][1]; }
    }
};
struct EpiM {
    static constexpr bool PERM = true, AFTER_DRAIN = false;
    const bf16_t* SG; const float* M1; const float* bias; bf16_t* Mo;
    __device__ __forceinline__ void operator()(const f32x4 (&acc)[2][2][4][2], const Unit& u, int wr, int wc, int fr, int fq) const {
        const int row0 = u.pm * 256 + wr * 64 + fr, c0 = u.pn * 256 + wc * 32 + 8 * fq;
        f32x4 bv[2][2];
#pragma unroll
        for (int bj = 0; bj < 2; ++bj) { bv[bj][0] = *(const f32x4*)(bias + c0 + bj * 128); bv[bj][1] = *(const f32x4*)(bias + c0 + bj * 128 + 4); }
#pragma unroll
        for (int ai = 0; ai < 2; ++ai)
#pragma unroll
            for (int m = 0; m < 4; ++m)
#pragma unroll
                for (int bj = 0; bj < 2; ++bj) { const size_t off = (size_t)(row0 + ai * 128 + m * 16) * DM + c0 + bj * 128; f32x4 g0, g1; ld_bf16x8(SG + off, g0, g1);
                    const f32x4 a0 = *(const f32x4*)(M1 + off), a1 = *(const f32x4*)(M1 + off + 4);
                    st_bf16x8(Mo + off, a0 + g0 * (acc[ai][bj][m][0] + bv[bj][0]), a1 + g1 * (acc[ai][bj][m][1] + bv[bj][1])); }
    }
};
template <bool GATED, bool WB16> struct EpiRes {
    static constexpr bool PERM = true, AFTER_DRAIN = false;
    const float* base; float* out; bf16_t* ob; float* ssq_out; const float* ssq_in; const float* ple;
    __device__ __forceinline__ void operator()(const f32x4 (&acc)[2][2][4][2], const Unit& u, int wr, int wc, int fr, int fq) const {
        const int row0 = u.pm * 256 + wr * 64 + fr, c0 = u.pn * 256 + wc * 32 + 8 * fq;
#pragma unroll
        for (int ai = 0; ai < 2; ++ai)
#pragma unroll
            for (int m = 0; m < 4; ++m) { const int row = row0 + ai * 128 + m * 16; float r = 0.f; if (GATED) r = rsqrtf(ssq_in[row] * (1.0f / DM) + EPS);
                float s = 0.f;
#pragma unroll
                for (int bj = 0; bj < 2; ++bj) { const size_t off = (size_t)row * DM + c0 + bj * 128;
                    const f32x4 b0 = *(const f32x4*)(base + off), b1 = *(const f32x4*)(base + off + 4);
                    f32x4 v0 = acc[ai][bj][m][0], v1 = acc[ai][bj][m][1];
                    if (GATED) { const f32x4 p0 = *(const f32x4*)(ple + off), p1 = *(const f32x4*)(ple + off + 4); v0 = sig4(v0 * r) * p0; v1 = sig4(v1 * r) * p1; }
                    const f32x4 h0 = b0 + v0, h1 = b1 + v1;
                    *(f32x4*)(out + off) = h0; *(f32x4*)(out + off + 4) = h1;
                    if (WB16) st_bf16x8(ob + off, h0, h1);
                    s += dot4(h0) + dot4(h1); }
                s += __shfl_xor(s, 16); s += __shfl_xor(s, 32);
                if (fq == 0) unsafeAtomicAdd(ssq_out + row, s);
                if (GATED ? (m & 1) : (m == 3)) asm volatile("" ::: "memory"); }
    }
};
struct EpiSwiglu {
    static constexpr bool PERM = true, AFTER_DRAIN = false;
    const float* ssq_in; bf16_t* F;
    __device__ __forceinline__ void operator()(const f32x4 (&acc)[2][2][4][2], const Unit& u, int wr, int wc, int fr, int fq) const {
        const int row0 = u.pm * 256 + wr * 64 + fr, ch = u.pn * 128 + wc * 32 + 8 * fq;
#pragma unroll
        for (int ai = 0; ai < 2; ++ai)
#pragma unroll
            for (int m = 0; m < 4; ++m) { const int row = row0 + ai * 128 + m * 16; const float r = rsqrtf(ssq_in[row] * (1.0f / DM) + EPS);
                const f32x4 g0 = acc[ai][0][m][0] * r, g1 = acc[ai][0][m][1] * r, u0 = acc[ai][1][m][0] * r, u1 = acc[ai][1][m][1] * r;
                st_bf16x8(F + (size_t)row * DFF + ch, g0 * sig4(g0) * u0, g1 * sig4(g1) * u1); }
    }
};
struct EpiPle {
    static constexpr bool PERM = true, AFTER_DRAIN = false;
    float* O;
    __device__ __forceinline__ void operator()(const f32x4 (&acc)[2][2][4][2], const Unit& u, int wr, int wc, int fr, int fq) const {
        const int row0 = u.pm * 256 + wr * 64 + fr, c0 = u.pn * 256 + wc * 32 + 8 * fq;
#pragma unroll
        for (int ai = 0; ai < 2; ++ai)
#pragma unroll
            for (int m = 0; m < 4; ++m)
#pragma unroll
                for (int bj = 0; bj < 2; ++bj) { const size_t off = (size_t)(row0 + ai * 128 + m * 16) * DM + c0 + bj * 128;
                    *(f32x4*)(O + off) = acc[ai][bj][m][0]; *(f32x4*)(O + off + 4) = acc[ai][bj][m][1]; }
    }
};

__device__ __forceinline__ int win_dest(int n0) {
    if (n0 < 1024) return 256 * (n0 >> 7) + (n0 & 127);
    if (n0 < 2048) return 2048 + (n0 - 1024);
    if (n0 < 3072) { const int c = n0 - 2048; return 256 * (c >> 7) + 128 + (c & 127); }
    if (n0 < 4096) { const int c = n0 - 3072; return 3072 + 256 * (c >> 7) + (c & 127); }
    if (n0 < 5120) { const int c = n0 - 4096; return 3072 + 256 * (c >> 7) + 128 + (c & 127); }
    return n0;
}
__device__ __forceinline__ void tr_item(const float* W, int K, int N, const float* g, bf16_t* WT, int mode, int item, LAS float* scr, int lane) {
    const int nblk = N >> 6, kb = item / nblk, nb = item - kb * nblk, k0 = kb << 6, n0 = nb << 6;
    int d0 = n0;
    if (mode == 1) d0 = win_dest(n0); else if (mode == 2) d0 = 256 * (n0 >> 7) + (n0 & 127); else if (mode == 3) d0 = 256 * (n0 >> 7) + 128 + (n0 & 127);
    const int kr = lane >> 4, col = 4 * (lane & 15);
    f32x4 v[16];
#pragma unroll
    for (int i = 0; i < 16; ++i) v[i] = *(const f32x4*)(W + (size_t)(k0 + 4 * i + kr) * N + n0 + col);
    if (g) {
#pragma unroll
        for (int i = 0; i < 16; ++i) v[i] = v[i] * g[k0 + 4 * i + kr];
    }
#pragma unroll
    for (int i = 0; i < 16; ++i) { LAS float* s = scr + (4 * i + kr) * 65 + col; s[0] = v[i][0]; s[1] = v[i][1]; s[2] = v[i][2]; s[3] = v[i][3]; }
    asm volatile("s_waitcnt lgkmcnt(0)" ::: "memory");
    const int c = lane & 7;
#pragma unroll
    for (int j = 0; j < 8; ++j) { const int n = (lane >> 3) + 8 * j; const LAS float* s = scr + (8 * c) * 65 + n;
        u32x4 o; o.x = cvt_pk_bf16(s[0], s[65]); o.y = cvt_pk_bf16(s[2 * 65], s[3 * 65]); o.z = cvt_pk_bf16(s[4 * 65], s[5 * 65]); o.w = cvt_pk_bf16(s[6 * 65], s[7 * 65]);
        *(u32x4*)(WT + (size_t)(d0 + n) * K + k0 + 8 * c) = o; }
    asm volatile("s_waitcnt lgkmcnt(0)" ::: "memory");
}

struct Args { const float* in[22]; float* out; unsigned char* ws; int ph_lo, ph_hi, coop, pad; };

__global__ void __launch_bounds__(NTHR, 2) fwd_kernel(Args a) {
    extern __shared__ __attribute__((aligned(16))) unsigned char lds_raw[];
    LAS unsigned char* lds = (LAS unsigned char*)lds_raw;
    cg::grid_group grid = cg::this_grid();
    const int tid = threadIdx.x, lane = tid & 63, wave = __builtin_amdgcn_readfirstlane(tid >> 6);
    const int G = gridDim.x, bx = blockIdx.x;
    unsigned char* ws = a.ws;
    const int lo = a.ph_lo, hi = a.ph_hi;
#ifndef PHMASK
#define PHMASK 0x1ff
#endif
#define IN(k) (lo <= (k) && (k) < hi && ((PHMASK >> (k)) & 1))
#define SEAM(k) do { if (lo <= (k) && (k) + 1 < hi) grid.sync(); } while (0)
#define rstd1 ((float*)(ws + WS_RSTD1))
#define ssq2 ((float*)(ws + WS_SSQ2))
#define ssq3 ((float*)(ws + WS_SSQ3))
#define ssq4 ((float*)(ws + WS_SSQ4))
#define Win ((bf16_t*)(ws + WS_WIN))
#define Woa ((bf16_t*)(ws + WS_WOA))
#define Wpw ((bf16_t*)(ws + WS_WPW))
#define Wo ((bf16_t*)(ws + WS_WO))
#define Wgu ((bf16_t*)(ws + WS_WGU))
#define Wdn ((bf16_t*)(ws + WS_WDN))
#define Wpg ((bf16_t*)(ws + WS_WPG))
#define Wpp ((bf16_t*)(ws + WS_WPP))
#define XB ((bf16_t*)(ws + WS_R0))
#define MB ((bf16_t*)(ws + WS_R0))
#define H2B ((bf16_t*)(ws + WS_R0))
#define Qb ((bf16_t*)(ws + WS_Q))
#define ABb ((bf16_t*)(ws + WS_AB))
#define Ub ((bf16_t*)(ws + WS_U))
#define SGA ((bf16_t*)(ws + WS_SGA))
#define SGB ((bf16_t*)(ws + WS_SGB))
#define YA ((bf16_t*)(ws + WS_YA))
#define VB ((bf16_t*)(ws + WS_VB))
#define H1B ((bf16_t*)(ws + WS_H1B))
#define Fb ((bf16_t*)(ws + WS_F))
#define PLEb ((float*)(ws + WS_PLE))
#define PB ((bf16_t*)(ws + WS_PB))
    float* out = a.out;

    if (IN(0)) {
        LAS float* scr = (LAS float*)(lds + wave * 16640);
        const int gw = bx * NWAVES + wave, NGW = G * NWAVES;
        constexpr int I0 = 32 * 144, I1 = 16 * 32, I2 = 16 * 32, I3 = 32 * 32, I4 = 32 * 88, I5 = 32 * 88, I6 = 88 * 32, I7 = 32 * 32, I8 = 4 * 32;
        constexpr int NITEMS = I0 + I1 + I2 + I3 + I4 + I5 + I6 + I7 + I8;
        for (int it = gw; it < NITEMS; it += NGW) {
            int r = it;
            if (r < I0) { tr_item(a.in[3], DM, NIN, a.in[2], Win, 1, r, scr, lane); continue; } r -= I0;
            if (r < I1) { tr_item(a.in[5], CW, DM, nullptr, Woa, 0, r, scr, lane); continue; } r -= I1;
            if (r < I2) { tr_item(a.in[11], CW, DM, nullptr, Wpw, 0, r, scr, lane); continue; } r -= I2;
            if (r < I3) { tr_item(a.in[13], DM, DM, nullptr, Wo, 0, r, scr, lane); continue; } r -= I3;
            if (r < I4) { tr_item(a.in[15], DM, DFF, a.in[14], Wgu, 2, r, scr, lane); continue; } r -= I4;
            if (r < I5) { tr_item(a.in[16], DM, DFF, a.in[14], Wgu, 3, r, scr, lane); continue; } r -= I5;
            if (r < I6) { tr_item(a.in[17], DFF, DM, nullptr, Wdn, 0, r, scr, lane); continue; } r -= I6;
            if (r < I7) { tr_item(a.in[19], DM, DM, a.in[18], Wpg, 0, r, scr, lane); continue; } r -= I7;
            tr_item(a.in[20], PLE, DM, nullptr, Wpp, 0, r, scr, lane);
        }
        for (int row = gw; row < SEQ; row += NGW) {
            const f32x4* xr = (const f32x4*)(a.in[0] + (size_t)row * DM) + lane; f32x4 v[8]; float s = 0.f;
#pragma unroll
            for (int j = 0; j < 8; ++j) { v[j] = xr[64 * j]; s += dot4(v[j]); }
            s = wave_sum(s);
            if (lane == 0) rstd1[row] = rsqrtf(s * (1.0f / DM) + EPS);
            u32x2* o = (u32x2*)(XB + (size_t)row * DM) + lane;
#pragma unroll
            for (int j = 0; j < 8; ++j) { u32x2 w; w.x = cvt_pk_bf16(v[j][0], v[j][1]); w.y = cvt_pk_bf16(v[j][2], v[j][3]); o[64 * j] = w; }
        }
        for (int c = gw; c < SEQ * PLE / 512; c += NGW) {
            const f32x4* pr = (const f32x4*)(a.in[1] + (size_t)c * 512) + 2 * lane; const f32x4 v0 = pr[0], v1 = pr[1];
            st_bf16x8(PB + (size_t)c * 512 + 8 * lane, v0, v1);
        }
        for (int i = bx * NTHR + tid; i < SEQ; i += G * NTHR) { ssq2[i] = 0.f; ssq3[i] = 0.f; ssq4[i] = 0.f; }
        __syncthreads();
    }
    SEAM(0);
    if (IN(1)) {
        pg8::Gemm g{XB, Win, SEQ, NIN, DM}; pg8::StaticOrder S; S.init(SEQ, NIN, G, bx);
        EpiProj E{rstd1, a.in[6], Qb, ABb, Ub, SGA, SGB};
        pg8::gemm_phase<EpiProj, pg8::StaticOrder, true, true>(lds, g, S, E);
    }
    SEAM(1);
    if (IN(2)) {
        const int c0 = 2 * tid;
        float wa0[3], wa1[3], wb0[31], wb1[31];
#pragma unroll
        for (int k = 0; k < 3; ++k) { const f32x2 w = *(const f32x2*)(a.in[4] + k * CW + c0); wa0[k] = w.x; wa1[k] = w.y; }
#pragma unroll
        for (int k = 0; k < 31; ++k) { const f32x2 w = *(const f32x2*)(a.in[7] + k * CW + c0); wb0[k] = w.x; wb1[k] = w.y; }
        const f32x2 cb = *(const f32x2*)(a.in[8] + c0), lg = *(const f32x2*)(a.in[9] + c0), lb = *(const f32x2*)(a.in[10] + c0);
        LAS float* P = (LAS float*)lds; LAS float* St = (LAS float*)(lds + 65536);
        for (int tile = bx; tile < SEQ / 16; tile += G) {
            const int t0 = tile * 16;
            {
                float q0[18], q1[18];
#pragma unroll
                for (int j = 0; j < 18; ++j) { const int ts = t0 - 2 + j; unsigned w = 0u; if (ts >= 0) w = *(const unsigned*)(Qb + (size_t)ts * CW + c0); q0[j] = bf_lo(w); q1[j] = bf_hi(w); }
#pragma unroll
                for (int i = 0; i < 16; ++i) { const unsigned w = *(const unsigned*)(ABb + (size_t)(t0 + i) * CW + c0);
                    const float y0 = bf_lo(w) * (wa0[0] * q0[i] + wa0[1] * q0[i + 1] + wa0[2] * q0[i + 2]);
                    const float y1 = bf_hi(w) * (wa1[0] * q1[i] + wa1[1] * q1[i + 1] + wa1[2] * q1[i + 2]);
                    *(unsigned*)(YA + (size_t)(t0 + i) * CW + c0) = cvt_pk_bf16(y0, y1); }
            }
            float acc0[16], acc1[16];
#pragma unroll
            for (int i = 0; i < 16; ++i) { acc0[i] = cb.x; acc1[i] = cb.y; }
#pragma unroll
            for (int s = 0; s < 46; ++s) { const int ts = t0 - 30 + s; unsigned w = 0u; if (ts >= 0) w = *(const unsigned*)(Ub + (size_t)ts * CW + c0);
                const float u0 = bf_lo(w), u1 = bf_hi(w);
#pragma unroll
                for (int i = 0; i < 16; ++i) { const int k = s - i; if (k >= 0 && k <= 30) { acc0[i] += wb0[k] * u0; acc1[i] += wb1[k] * u1; } } }
#pragma unroll
            for (int i = 0; i < 16; ++i) { P[(2 * i) * NTHR + tid] = acc0[i] + acc1[i]; P[(2 * i + 1) * NTHR + tid] = acc0[i] * acc0[i] + acc1[i] * acc1[i]; }
            __syncthreads();
#pragma unroll
            for (int r = 0; r < 4; ++r) { const int row = 4 * wave + r; float s = 0.f;
#pragma unroll
                for (int j = 0; j < 8; ++j) s += P[row * NTHR + lane + 64 * j];
                s = wave_sum(s); if (lane == 0) St[row] = s; }
            __syncthreads();
#pragma unroll
            for (int i = 0; i < 16; ++i) { const float mean = St[2 * i] * (1.0f / CW), var = St[2 * i + 1] * (1.0f / CW) - mean * mean, rs = rsqrtf(fmaxf(var, 0.f) + LN_EPS);
                const float v0 = (acc0[i] - mean) * rs * lg.x + lb.x, v1 = (acc1[i] - mean) * rs * lg.y + lb.y;
                *(unsigned*)(VB + (size_t)(t0 + i) * CW + c0) = cvt_pk_bf16(v0 * sigm(v0), v1 * sigm(v1)); }
        }
        __syncthreads();
    }
    SEAM(2);
    if (IN(3)) {
        pg8::StaticOrder S; S.init(SEQ, DM, G, bx);
        { pg8::Gemm g{YA, Woa, SEQ, DM, CW}; EpiM1 E{SGA, out}; pg8::gemm_phase<EpiM1, pg8::StaticOrder, true, true>(lds, g, S, E); }
        { pg8::Gemm g{VB, Wpw, SEQ, DM, CW}; EpiM E{SGB, out, a.in[12], MB}; pg8::gemm_phase<EpiM, pg8::StaticOrder, true, true>(lds, g, S, E); }
    }
    SEAM(3);
    if (IN(4)) {
        pg8::Gemm g{MB, Wo, SEQ, DM, DM}; pg8::StaticOrder S; S.init(SEQ, DM, G, bx);
        EpiRes<false, true> E{a.in[0], out, H1B, ssq2, nullptr, nullptr};
        pg8::gemm_phase<EpiRes<false, true>, pg8::StaticOrder, true, true>(lds, g, S, E);
    }
    SEAM(4);
    if (IN(5)) {
        pg8::Gemm g{H1B, Wgu, SEQ, 2 * DFF, DM}; pg8::StaticOrder S; S.init(SEQ, 2 * DFF, G, bx);
        EpiSwiglu E{ssq2, Fb};
        pg8::gemm_phase<EpiSwiglu, pg8::StaticOrder, true, true>(lds, g, S, E);
    }
    SEAM(5);
    if (IN(6)) {
        pg8::Gemm g{Fb, Wdn, SEQ, DM, DFF}; pg8::StaticOrder S; S.init(SEQ, DM, G, bx);
        EpiRes<false, true> E{out, out, H2B, ssq3, nullptr, nullptr};
        pg8::gemm_phase<EpiRes<false, true>, pg8::StaticOrder, true, true>(lds, g, S, E);
    }
    SEAM(6);
    if (IN(7)) {
        pg8::StaticOrder S; S.init(SEQ, DM, G, bx);
        { pg8::Gemm g{PB, Wpp, SEQ, DM, PLE}; EpiPle E{PLEb}; pg8::gemm_phase<EpiPle, pg8::StaticOrder, true, true>(lds, g, S, E); }
        { pg8::Gemm g{H2B, Wpg, SEQ, DM, DM}; EpiRes<true, false> E{out, out, nullptr, ssq4, ssq3, PLEb};
          pg8::gemm_phase<EpiRes<true, false>, pg8::StaticOrder, true, true>(lds, g, S, E); }
    }
    SEAM(7);
    if (IN(8)) {
        const int gw = bx * NWAVES + wave, NGW = G * NWAVES;
        const f32x4* gf = (const f32x4*)a.in[21] + lane;
        for (int row = gw; row < SEQ; row += NGW) {
            f32x4* o = (f32x4*)(out + (size_t)row * DM) + lane; const float r = rsqrtf(ssq4[row] * (1.0f / DM) + EPS);
#pragma unroll
            for (int j = 0; j < 8; ++j) o[64 * j] = o[64 * j] * r * gf[64 * j];
        }
    }
#undef IN
#undef SEAM
}

extern "C" void kernel_launch(void* const* d_in, const int* in_sizes, int n_in, void* d_out, int out_size, void* d_ws, size_t ws_size, hipStream_t stream) {
    static int grid = 0;
    if (grid == 0) {
        if (n_in != 22 || out_size != SEQ * DM || ws_size < WS_END) { fprintf(stderr, "kernel_launch: unexpected shapes (n_in %d, out %d, ws %zu)\n", n_in, out_size, ws_size); grid = -1; return; }
        int dev = 0, cus = 0, per_cu = 0;
        if (hipGetDevice(&dev) != hipSuccess || hipDeviceGetAttribute(&cus, hipDeviceAttributeMultiprocessorCount, dev) != hipSuccess) { grid = -1; return; }
        if (hipFuncSetAttribute((const void*)fwd_kernel, hipFuncAttributeMaxDynamicSharedMemorySize, LDS_BYTES) != hipSuccess) { fprintf(stderr, "kernel_launch: hipFuncSetAttribute failed\n"); grid = -1; return; }
        if (hipOccupancyMaxActiveBlocksPerMultiprocessor(&per_cu, (const void*)fwd_kernel, NTHR, LDS_BYTES) != hipSuccess || per_cu < 1) { fprintf(stderr, "kernel_launch: occupancy query says %d\n", per_cu); per_cu = 1; }
        (void)hipGetLastError();
        grid = cus;
    }
    if (grid < 0) return;
    Args a{};
    for (int i = 0; i < 22; ++i) a.in[i] = (const float*)d_in[i];
    a.out = (float*)d_out; a.ws = (unsigned char*)d_ws;
#if MK_LAUNCHES == 1
    a.ph_lo = 0; a.ph_hi = NPHASE; a.coop = 1;
    void* args[] = {&a};
    hipError_t e = hipLaunchCooperativeKernel((const void*)fwd_kernel, dim3(grid), dim3(NTHR), args, LDS_BYTES, stream);
    if (e != hipSuccess) fprintf(stderr, "kernel_launch: cooperative launch failed: %s (grid %d)\n", hipGetErrorString(e), grid);
#else
    for (int ph = 0; ph < NPHASE; ++ph) { a.ph_lo = ph; a.ph_hi = ph + 1; a.coop = 0; hipLaunchKernelGGL(fwd_kernel, dim3(grid), dim3(NTHR), LDS_BYTES, stream, a); }
#endif
}
```

```cpp
#include <hip/hip_runtime.h>
#include <hip/hip_cooperative_groups.h>
#include <cstdio>
#include <cstdint>
namespace cg = cooperative_groups;
namespace pg8 {
#define PG8_LAS __attribute__((address_space(3)))
typedef unsigned short bf16_t;
typedef short bf16x8 __attribute__((ext_vector_type(8)));
typedef float f32x4 __attribute__((ext_vector_type(4)));
typedef unsigned u32x4 __attribute__((ext_vector_type(4)));
constexpr int BM = 256, BK = 64, HALF = 128, HTB = HALF * BK * 2  , STAGE_BYTES = 8 * HTB, NXCD = 8, WGM = 8;

__host__ __device__ __forceinline__ int lds_byte(int r, int c) { const int st = (r >> 4) * 2 + (c >> 5), rr = r & 15, cc = c & 31, ob = rr * 64 + cc * 2; return st * 1024 + (ob ^ (((ob >> 9) & 1) << 5)); }
__host__ __device__ __forceinline__ void stage_rc(int b, int& R, int& C) { const int st = b / 1024, sb = b % 1024, swz = sb ^ (((sb >> 9) & 1) << 5); R = (st >> 1) * 16 + swz / 64; C = (st & 1) * 32 + (swz % 64) / 2; }
__host__ __device__ __forceinline__ int perm32(int rho) { const int n = rho >> 4, i = rho & 15; return 8 * (i >> 2) + 4 * n + (i & 3); }

struct Unit { int pm, pn; };
struct Gemm { const bf16_t* A; const bf16_t* Bt; int M, N, K; };

struct StaticOrder {
    int nM, nN, nwg, G, c;
    __host__ __device__ void init(int M, int N, int G_, int c_) { nM = M / BM; nN = N / BM; nwg = nM * nN; G = G_; c = c_; }
    __host__ __device__ bool next(int i, Unit& u) const {
        const long L = (long)i * G + c; if (L >= nwg) return false;
        int wgid = (int)L; { const int q = nwg / NXCD, r = nwg % NXCD, xcd = wgid % NXCD, off = wgid / NXCD; wgid = (xcd < r ? xcd * (q + 1) : r * (q + 1) + (xcd - r) * q) + off; }
        const int nig = WGM * nN, gid = wgid / nig, fm = gid * WGM, gsz = (nM - fm) < WGM ? (nM - fm) : WGM;
        u.pm = fm + ((wgid % nig) % gsz); u.pn = (wgid % nig) / gsz; return true;
    }
    __device__ __forceinline__ void a_ready(const Unit&) const {}
    __device__ __forceinline__ void done(const Unit&) const {}
};

__device__ __forceinline__ unsigned cvt_pk_bf16(float lo, float hi) { unsigned r; asm volatile("v_cvt_pk_bf16_f32 %0, %1, %2" : "=v"(r) : "v"(lo), "v"(hi)); return r; }
typedef float f32x2 __attribute__((ext_vector_type(2)));
template <class Epi, class Sched, bool ALIGN_EPI = false, bool SP2 = false>
__device__ __forceinline__ void gemm_phase(PG8_LAS unsigned char* lds, const Gemm g, const Sched& S, const Epi& E) {
    const int tid = threadIdx.x, wid = __builtin_amdgcn_readfirstlane(tid >> 6), lane = tid & 63, wr = wid >> 2, wc = wid & 3, fr = lane & 15, fq = lane >> 4;
    const int K = g.K, nt = K / BK;
    unsigned voffA[2], voffB[2];
#pragma unroll
    for (int i = 0; i < 2; ++i) { int R, C; stage_rc(tid * 16 + i * 8192, R, C); const int Rb = Epi::PERM ? ((R & ~31) + perm32(R & 31)) : R;
        voffA[i] = (unsigned)(R * K + C) * 2u; voffB[i] = (unsigned)(Rb * K + C) * 2u; }
    const size_t kstep = (size_t)(BK * 2);
    const size_t hstep = (size_t)HALF * K * 2;
    const size_t tstep = 2 * hstep;
    const unsigned ldsw = (unsigned)wid * 1024u;
    const int aoff = lds_byte(wr * 64 + fr, fq * 8), boff = lds_byte(wc * 32 + fr, fq * 8);
#define PG8_SA(b, h) (((b) * 2 + (h)) * HTB)
#define PG8_SB(b, h) ((4 + (b) * 2 + (h)) * HTB)
#define PG8_STAGE(bufoff, gbase, voff) do { _Pragma("unroll") for (int _i = 0; _i < 2; ++_i) \
        __builtin_amdgcn_global_load_lds((const unsigned*)((const char*)(gbase) + (voff)[_i]), (PG8_LAS unsigned*)(lds + (bufoff) + ldsw + _i * 8192), 16, 0, 0); } while (0)
#define PG8_LDA(dst, b, h) do { _Pragma("unroll") for (int m = 0; m < 4; ++m) _Pragma("unroll") for (int k = 0; k < 2; ++k) dst[m][k] = *(const PG8_LAS bf16x8*)(lds + PG8_SA(b, h) + aoff + m * 2048 + k * 1024); } while (0)
#define PG8_LDB(dst, b, h) do { _Pragma("unroll") for (int n = 0; n < 2; ++n) _Pragma("unroll") for (int k = 0; k < 2; ++k) dst[n][k] = *(const PG8_LAS bf16x8*)(lds + PG8_SB(b, h) + boff + n * 2048 + k * 1024); } while (0)
#define PG8_MMA(ai, bj, At, Bt) do { __builtin_amdgcn_s_setprio(1); _Pragma("unroll") for (int m = 0; m < 4; ++m) _Pragma("unroll") for (int n = 0; n < 2; ++n) _Pragma("unroll") for (int k = 0; k < 2; ++k) \
        acc[ai][bj][m][n] = __builtin_amdgcn_mfma_f32_16x16x32_bf16(Bt[n][k], At[m][k], acc[ai][bj][m][n], 0, 0, 0); __builtin_amdgcn_s_setprio(0); } while (0)
#define PG8_WAIT_V(n) asm volatile("s_waitcnt vmcnt(" #n ")" ::: "memory")
#define PG8_WAIT_L(n) asm volatile("s_waitcnt lgkmcnt(" #n ")" ::: "memory")
#define PG8_BAR __builtin_amdgcn_s_barrier()
#define PG8_SCHED __builtin_amdgcn_sched_barrier(0)
    Unit cur, nxt; int ui = 0;
    if (!S.next(0, cur)) return;
    f32x4 acc[2][2][4][2];
#pragma unroll
    for (int a = 0; a < 2; ++a)
#pragma unroll
        for (int b = 0; b < 2; ++b)
#pragma unroll
            for (int m = 0; m < 4; ++m)
#pragma unroll
                for (int n = 0; n < 2; ++n) acc[a][b][m][n] = (f32x4){0.f, 0.f, 0.f, 0.f};
    bf16x8 At[4][2], B0[2][2], B1[2][2];
    const char* cA = (const char*)g.A + (size_t)cur.pm * tstep; const char* cB = (const char*)g.Bt + (size_t)cur.pn * tstep;
    S.a_ready(cur);
    if constexpr (SP2) {
        PG8_STAGE(PG8_SB(0, 0), cB, voffB); PG8_STAGE(PG8_SB(0, 1), cB + hstep, voffB); PG8_STAGE(PG8_SA(0, 0), cA, voffA); PG8_STAGE(PG8_SA(0, 1), cA + hstep, voffA);
        if (wr == 1) PG8_BAR;
        PG8_WAIT_V(2); PG8_BAR;
        PG8_STAGE(PG8_SB(1, 0), cB + kstep, voffB); PG8_STAGE(PG8_SA(1, 0), cA + kstep, voffA); PG8_STAGE(PG8_SB(1, 1), cB + hstep + kstep, voffB);
        PG8_WAIT_V(6); PG8_BAR;
    } else {
        PG8_STAGE(PG8_SB(0, 0), cB, voffB); PG8_STAGE(PG8_SA(0, 0), cA, voffA); PG8_STAGE(PG8_SB(0, 1), cB + hstep, voffB); PG8_STAGE(PG8_SA(0, 1), cA + hstep, voffA);
        if (wr == 1) PG8_BAR;
        PG8_WAIT_V(4); PG8_BAR;
        PG8_STAGE(PG8_SB(1, 0), cB + kstep, voffB); PG8_STAGE(PG8_SA(1, 0), cA + kstep, voffA); PG8_STAGE(PG8_SB(1, 1), cB + hstep + kstep, voffB);
        PG8_WAIT_V(6); PG8_BAR;
    }
    for (;;) {
        const bool has_next = S.next(ui + 1, nxt);
        const char* nA = has_next ? (const char*)g.A + (size_t)nxt.pm * tstep : cA; const char* nB = has_next ? (const char*)g.Bt + (size_t)nxt.pn * tstep : cB;
#pragma unroll 1
        for (int t = 0; t < nt; t += 2) {
            const bool last = (t == nt - 2);
            const char* a1 = cA + (size_t)(t + 1) * kstep;
            const char* a2 = last ? nA : cA + (size_t)(t + 2) * kstep; const char* b2 = last ? nB : cB + (size_t)(t + 2) * kstep;
            const char* a3 = a2 + kstep; const char* b3 = b2 + kstep;
            if (last && has_next) S.a_ready(nxt);
            if constexpr (SP2) {
            PG8_LDB(B0, 0, 0); PG8_LDB(B1, 0, 1); PG8_SCHED; PG8_LDA(At, 0, 0); PG8_STAGE(PG8_SA(1, 1), a1 + hstep, voffA);
            PG8_WAIT_V(8); PG8_WAIT_L(0); PG8_BAR; PG8_MMA(0, 0, At, B0); PG8_MMA(0, 1, At, B1); PG8_BAR; PG8_SCHED;
            PG8_LDA(At, 0, 1); PG8_STAGE(PG8_SB(0, 0), b2, voffB); PG8_STAGE(PG8_SB(0, 1), b2 + hstep, voffB); PG8_STAGE(PG8_SA(0, 0), a2, voffA);
            PG8_WAIT_V(8); PG8_WAIT_L(0); PG8_BAR; PG8_MMA(1, 0, At, B0); PG8_MMA(1, 1, At, B1); PG8_BAR; PG8_SCHED;
            PG8_LDB(B0, 1, 0); PG8_LDB(B1, 1, 1); PG8_SCHED; PG8_LDA(At, 1, 0); PG8_STAGE(PG8_SA(0, 1), a2 + hstep, voffA);
            PG8_WAIT_V(8); PG8_WAIT_L(0); PG8_BAR; PG8_MMA(0, 0, At, B0); PG8_MMA(0, 1, At, B1); PG8_BAR; PG8_SCHED;
            PG8_LDA(At, 1, 1); PG8_STAGE(PG8_SB(1, 0), b3, voffB); PG8_STAGE(PG8_SB(1, 1), b3 + hstep, voffB); PG8_STAGE(PG8_SA(1, 0), a3, voffA);
            PG8_WAIT_V(8); PG8_WAIT_L(0); PG8_BAR; PG8_MMA(1, 0, At, B0); PG8_MMA(1, 1, At, B1); PG8_BAR; PG8_SCHED;
            } else {
            PG8_LDB(B0, 0, 0); PG8_SCHED; PG8_LDA(At, 0, 0); PG8_STAGE(PG8_SA(1, 1), a1 + hstep, voffA);
            PG8_WAIT_L(8); PG8_BAR; PG8_WAIT_L(0); PG8_MMA(0, 0, At, B0); PG8_BAR; PG8_SCHED;
            PG8_LDB(B1, 0, 1); PG8_STAGE(PG8_SB(0, 0), b2, voffB);
            PG8_BAR; PG8_WAIT_L(0); PG8_MMA(0, 1, At, B1); PG8_BAR;
            PG8_LDA(At, 0, 1); PG8_STAGE(PG8_SA(0, 0), a2, voffA);
            PG8_BAR; PG8_WAIT_L(0); PG8_MMA(1, 0, At, B0); PG8_BAR; PG8_SCHED;
            PG8_STAGE(PG8_SB(0, 1), b2 + hstep, voffB);
            PG8_WAIT_V(6); PG8_BAR; PG8_MMA(1, 1, At, B1); PG8_BAR;
            PG8_LDB(B0, 1, 0); PG8_SCHED; PG8_LDA(At, 1, 0); PG8_STAGE(PG8_SA(0, 1), a2 + hstep, voffA);
            PG8_WAIT_L(8); PG8_BAR; PG8_WAIT_L(0); PG8_MMA(0, 0, At, B0); PG8_BAR; PG8_SCHED;
            PG8_LDB(B1, 1, 1); PG8_STAGE(PG8_SB(1, 0), b3, voffB);
            PG8_BAR; PG8_WAIT_L(0); PG8_MMA(0, 1, At, B1); PG8_BAR;
            PG8_LDA(At, 1, 1); PG8_STAGE(PG8_SA(1, 0), a3, voffA);
            PG8_BAR; PG8_WAIT_L(0); PG8_MMA(1, 0, At, B0); PG8_BAR; PG8_SCHED;
            PG8_STAGE(PG8_SB(1, 1), b3 + hstep, voffB);
            PG8_WAIT_V(6); PG8_BAR; PG8_MMA(1, 1, At, B1); PG8_BAR;
            }
        }
        if constexpr (ALIGN_EPI) { if (wr == 0) PG8_BAR; }
        if constexpr (!Epi::AFTER_DRAIN) { E(acc, cur, wr, wc, fr, fq); S.done(cur); }
        if (!has_next) break;
#pragma unroll
        for (int a = 0; a < 2; ++a)
#pragma unroll
            for (int b = 0; b < 2; ++b)
#pragma unroll
                for (int m = 0; m < 4; ++m)
#pragma unroll
                    for (int n = 0; n < 2; ++n) acc[a][b][m][n] = (f32x4){0.f, 0.f, 0.f, 0.f};
        cur = nxt; cA = nA; cB = nB; ++ui;
        if constexpr (ALIGN_EPI) { if (wr == 1) PG8_BAR; }
    }
    PG8_WAIT_V(0);
    if constexpr (!ALIGN_EPI) { if (wr == 0) PG8_BAR; }
    PG8_BAR;
    if constexpr (Epi::AFTER_DRAIN) { E.fused(acc, cur, wr, wc, fr, fq, lds, wid, lane); S.done(cur); }
#undef PG8_SA
#undef PG8_SB
#undef PG8_STAGE
#undef PG8_LDA
#undef PG8_LDB
#undef PG8_MMA
#undef PG8_WAIT_V
#undef PG8_WAIT_L
#undef PG8_BAR
#undef PG8_SCHED
}
}

#define LAS __attribute__((address_space(3)))
using pg8::bf16_t; using pg8::f32x4; using pg8::u32x4; using pg8::Unit; using pg8::cvt_pk_bf16;
typedef unsigned u32x2 __attribute__((ext_vector_type(2)));
typedef float f32x2 __attribute__((ext_vector_type(2)));

#ifndef MK_LAUNCHES
#define MK_LAUNCHES 1
#endif
constexpr int SEQ = 8192, DM = 2048, CW = 1024, NIN = 9216, DFF = 5632, PLE = 256;
constexpr float EPS = 1e-6f, LN_EPS = 1e-5f;
constexpr int NWAVES = 8, NTHR = 512, NPHASE = 9;
constexpr int LDS_BYTES = 147456;
constexpr size_t MiB = 1u << 20;
constexpr size_t WS_RSTD1 = 0, WS_SSQ2 = 64 * 1024, WS_SSQ3 = 128 * 1024, WS_SSQ4 = 192 * 1024;
constexpr size_t WS_WIN = 2 * MiB, WS_WOA = 38 * MiB, WS_WPW = 42 * MiB, WS_WO = 46 * MiB, WS_WGU = 54 * MiB, WS_WDN = 98 * MiB, WS_WPG = 120 * MiB, WS_WPP = 128 * MiB;
constexpr size_t WS_R0 = 130 * MiB;
constexpr size_t WS_Q = 162 * MiB, WS_AB = 178 * MiB, WS_U = 194 * MiB;
constexpr size_t WS_SGA = 210 * MiB, WS_SGB = 242 * MiB;
constexpr size_t WS_YA = 274 * MiB, WS_VB = 290 * MiB;
constexpr size_t WS_H1B = 162 * MiB;
constexpr size_t WS_F = 194 * MiB;
constexpr size_t WS_PB = 306 * MiB;
constexpr size_t WS_END = 310 * MiB;

__device__ __forceinline__ float sigm(float x) { return __builtin_amdgcn_rcpf(1.f + __expf(-x)); }
__device__ __forceinline__ f32x4 sig4(f32x4 v) { return (f32x4){sigm(v[0]), sigm(v[1]), sigm(v[2]), sigm(v[3])}; }
__device__ __forceinline__ float bf_lo(unsigned w) { return __uint_as_float(w << 16); }
__device__ __forceinline__ float bf_hi(unsigned w) { return __uint_as_float(w & 0xffff0000u); }
__device__ __forceinline__ void st_bf16x8(bf16_t* p, f32x4 v0, f32x4 v1) {
    u32x4 w; w.x = cvt_pk_bf16(v0[0], v0[1]); w.y = cvt_pk_bf16(v0[2], v0[3]); w.z = cvt_pk_bf16(v1[0], v1[1]); w.w = cvt_pk_bf16(v1[2], v1[3]); *(u32x4*)p = w; }
__device__ __forceinline__ void ld_bf16x8(const bf16_t* p, f32x4& v0, f32x4& v1) {
    const u32x4 w = *(const u32x4*)p; v0 = (f32x4){bf_lo(w.x), bf_hi(w.x), bf_lo(w.y), bf_hi(w.y)}; v1 = (f32x4){bf_lo(w.z), bf_hi(w.z), bf_lo(w.w), bf_hi(w.w)}; }
__device__ __forceinline__ float dot4(f32x4 a) { return (a[0] * a[0] + a[1] * a[1]) + (a[2] * a[2] + a[3] * a[3]); }
__device__ __forceinline__ float wave_sum(float v) {
#pragma unroll
    for (int o = 1; o < 64; o <<= 1) v += __shfl_xor(v, o);
    return v;
}

struct EpiProj {
    static constexpr bool PERM = true, AFTER_DRAIN = false;
    const float* rstd; const float* bglu; bf16_t *Qo, *ABo, *Uo, *SA, *SB;
    __device__ __forceinline__ void operator()(const f32x4 (&acc)[2][2][4][2], const Unit& u, int wr, int wc, int fr, int fq) const {
        const int pn = u.pn, row0 = u.pm * 256 + wr * 64 + fr, cl = wc * 32 + 8 * fq;
        if (pn < 8) {
#pragma unroll
            for (int ai = 0; ai < 2; ++ai)
#pragma unroll
                for (int m = 0; m < 4; ++m) { const int row = row0 + ai * 128 + m * 16; const float r = rstd[row], r2 = r * r;
                    st_bf16x8(Qo + (size_t)row * CW + pn * 128 + cl, acc[ai][0][m][0] * acc[ai][1][m][0] * r2, acc[ai][0][m][1] * acc[ai][1][m][1] * r2); }
        } else if (pn < 12) {
#pragma unroll
            for (int ai = 0; ai < 2; ++ai)
#pragma unroll
                for (int m = 0; m < 4; ++m) { const int row = row0 + ai * 128 + m * 16; const float r = rstd[row];
#pragma unroll
                    for (int bj = 0; bj < 2; ++bj) st_bf16x8(ABo + (size_t)row * CW + (pn - 8) * 256 + bj * 128 + cl, acc[ai][bj][m][0] * r, acc[ai][bj][m][1] * r); }
        } else if (pn < 20) {
            const int ch = (pn - 12) * 128 + cl;
            const f32x4 bv0 = *(const f32x4*)(bglu + ch), bv1 = *(const f32x4*)(bglu + ch + 4), bg0 = *(const f32x4*)(bglu + CW + ch), bg1 = *(const f32x4*)(bglu + CW + ch + 4);
#pragma unroll
            for (int ai = 0; ai < 2; ++ai)
#pragma unroll
                for (int m = 0; m < 4; ++m) { const int row = row0 + ai * 128 + m * 16; const float r = rstd[row];
                    const f32x4 v0 = acc[ai][0][m][0] * r + bv0, v1 = acc[ai][0][m][1] * r + bv1, g0 = acc[ai][1][m][0] * r + bg0, g1 = acc[ai][1][m][1] * r + bg1;
                    st_bf16x8(Uo + (size_t)row * CW + ch, v0 * sig4(g0), v1 * sig4(g1)); }
        } else {
            bf16_t* S = pn < 28 ? SA : SB; const int cb = ((pn - 20) & 7) * 256 + cl;
#pragma unroll
            for (int ai = 0; ai < 2; ++ai)
#pragma unroll
                for (int m = 0; m < 4; ++m) { const int row = row0 + ai * 128 + m * 16; const float r = rstd[row];
#pragma unroll
                    for (int bj = 0; bj < 2; ++bj) st_bf16x8(S + (size_t)row * DM + cb + bj * 128, sig4(acc[ai][bj][m][0] * r), sig4(acc[ai][bj][m][1] * r)); }
        }
    }
};
struct EpiM1 {
    static constexpr bool PERM = true, AFTER_DRAIN = false;
    const bf16_t* SG; float* M1;
    __device__ __forceinline__ void operator()(const f32x4 (&acc)[2][2][4][2], const Unit& u, int wr, int wc, int fr, int fq) const {
        const int row0 = u.pm * 256 + wr * 64 + fr, c0 = u.pn * 256 + wc * 32 + 8 * fq;
#pragma unroll
        for (int ai = 0; ai < 2; ++ai)
#pragma unroll
            for (int m = 0; m < 4; ++m)
#pragma unroll
                for (int bj = 0; bj < 2; ++bj) { const size_t off = (size_t)(row0 + ai * 128 + m * 16) * DM + c0 + bj * 128; f32x4 g0, g1; ld_bf16x8(SG + off, g0, g1);
                    *(f32x4*)(M1 + off) = g0 * acc[ai][bj][m][0]; *(f32x4*)(M1 + off + 4) = g1 * acc[ai][bj][m][1]; }
    }
};
struct EpiM {
    static constexpr bool PERM = true, AFTER_DRAIN = false;
    const bf16_t* SG; const float* M1; const float* bias; bf16_t* Mo;
    __device__ __forceinline__ void operator()(const f32x4 (&acc)[2][2][4][2], const Unit& u, int wr, int wc, int fr, int fq) const {
        const int row0 = u.pm * 256 + wr * 64 + fr, c0 = u.pn * 256 + wc * 32 + 8 * fq;
        f32x4 bv[2][2];
#pragma unroll
        for (int bj = 0; bj < 2; ++bj) { bv[bj][0] = *(const f32x4*)(bias + c0 + bj * 128); bv[bj][1] = *(const f32x4*)(bias + c0 + bj * 128 + 4); }
#pragma unroll
        for (int ai = 0; ai < 2; ++ai)
#pragma unroll
            for (int m = 0; m < 4; ++m)
#pragma unroll
                for (int bj = 0; bj < 2; ++bj) { const size_t off = (size_t)(row0 + ai * 128 + m * 16) * DM + c0 + bj * 128; f32x4 g0, g1; ld_bf16x8(SG + off, g0, g1);
                    const f32x4 a0 = *(const f32x4*)(M1 + off), a1 = *(const f32x4*)(M1 + off + 4);
                    st_bf16x8(Mo + off, a0 + g0 * (acc[ai][bj][m][0] + bv[bj][0]), a1 + g1 * (acc[ai][bj][m][1] + bv[bj][1])); }
    }
};
template <bool GATED, bool WB16> struct EpiRes {
    static constexpr bool PERM = true, AFTER_DRAIN = false;
    const float* base; float* out; bf16_t* ob; float* ssq_out; const float* ssq_in; const bf16_t* ple;
    __device__ __forceinline__ void operator()(const f32x4 (&acc)[2][2][4][2], const Unit& u, int wr, int wc, int fr, int fq) const {
        const int row0 = u.pm * 256 + wr * 64 + fr, c0 = u.pn * 256 + wc * 32 + 8 * fq;
#pragma unroll
        for (int ai = 0; ai < 2; ++ai)
#pragma unroll
            for (int m = 0; m < 4; ++m) { const int row = row0 + ai * 128 + m * 16; float r = 0.f; if (GATED) r = rsqrtf(ssq_in[row] * (1.0f / DM) + EPS);
                float s = 0.f;
#pragma unroll
                for (int bj = 0; bj < 2; ++bj) { const size_t off = (size_t)row * DM + c0 + bj * 128;
                    const f32x4 b0 = *(const f32x4*)(base + off), b1 = *(const f32x4*)(base + off + 4);
                    f32x4 v0 = acc[ai][bj][m][0], v1 = acc[ai][bj][m][1];
                    if (GATED) { f32x4 p0, p1; ld_bf16x8(ple + off, p0, p1); v0 = sig4(v0 * r) * p0; v1 = sig4(v1 * r) * p1; }
                    const f32x4 h0 = b0 + v0, h1 = b1 + v1;
                    *(f32x4*)(out + off) = h0; *(f32x4*)(out + off + 4) = h1;
                    if (WB16) st_bf16x8(ob + off, h0, h1);
                    s += dot4(h0) + dot4(h1); }
                s += __shfl_xor(s, 16); s += __shfl_xor(s, 32);
                if (fq == 0) unsafeAtomicAdd(ssq_out + row, s);
                if (GATED ? (m & 1) : (m == 3)) asm volatile("" ::: "memory"); }
    }
};
struct EpiSwiglu {
    static constexpr bool PERM = true, AFTER_DRAIN = false;
    const float* ssq_in; bf16_t* F;
    __device__ __forceinline__ void operator()(const f32x4 (&acc)[2][2][4][2], const Unit& u, int wr, int wc, int fr, int fq) const {
        const int row0 = u.pm * 256 + wr * 64 + fr, ch = u.pn * 128 + wc * 32 + 8 * fq;
#pragma unroll
        for (int ai = 0; ai < 2; ++ai)
#pragma unroll
            for (int m = 0; m < 4; ++m) { const int row = row0 + ai * 128 + m * 16; const float r = rsqrtf(ssq_in[row] * (1.0f / DM) + EPS);
                const f32x4 g0 = acc[ai][0][m][0] * r, g1 = acc[ai][0][m][1] * r, u0 = acc[ai][1][m][0] * r, u1 = acc[ai][1][m][1] * r;
                st_bf16x8(F + (size_t)row * DFF + ch, g0 * sig4(g0) * u0, g1 * sig4(g1) * u1); }
    }
};
struct EpiPle {
    static constexpr bool PERM = true, AFTER_DRAIN = false;
    bf16_t* O;
    __device__ __forceinline__ void operator()(const f32x4 (&acc)[2][2][4][2], const Unit& u, int wr, int wc, int fr, int fq) const {
        const int row0 = u.pm * 256 + wr * 64 + fr, c0 = u.pn * 256 + wc * 32 + 8 * fq;
#pragma unroll
        for (int ai = 0; ai < 2; ++ai)
#pragma unroll
            for (int m = 0; m < 4; ++m)
#pragma unroll
                for (int bj = 0; bj < 2; ++bj) st_bf16x8(O + (size_t)(row0 + ai * 128 + m * 16) * DM + c0 + bj * 128, acc[ai][bj][m][0], acc[ai][bj][m][1]);
    }
};

__device__ __forceinline__ int win_dest(int n0) {
    if (n0 < 1024) return 256 * (n0 >> 7) + (n0 & 127);
    if (n0 < 2048) return 2048 + (n0 - 1024);
    if (n0 < 3072) { const int c = n0 - 2048; return 256 * (c >> 7) + 128 + (c & 127); }
    if (n0 < 4096) { const int c = n0 - 3072; return 3072 + 256 * (c >> 7) + (c & 127); }
    if (n0 < 5120) { const int c = n0 - 4096; return 3072 + 256 * (c >> 7) + 128 + (c & 127); }
    return n0;
}
__device__ __forceinline__ void tr_item(const float* W, int K, int N, const float* g, bf16_t* WT, int mode, int item, LAS float* scr, int lane) {
    const int nblk = N >> 6, kb = item / nblk, nb = item - kb * nblk, k0 = kb << 6, n0 = nb << 6;
    int d0 = n0;
    if (mode == 1) d0 = win_dest(n0); else if (mode == 2) d0 = 256 * (n0 >> 7) + (n0 & 127); else if (mode == 3) d0 = 256 * (n0 >> 7) + 128 + (n0 & 127);
    const int kr = lane >> 4, col = 4 * (lane & 15);
    f32x4 v[16];
#pragma unroll
    for (int i = 0; i < 16; ++i) v[i] = *(const f32x4*)(W + (size_t)(k0 + 4 * i + kr) * N + n0 + col);
    if (g) {
#pragma unroll
        for (int i = 0; i < 16; ++i) v[i] = v[i] * g[k0 + 4 * i + kr];
    }
#pragma unroll
    for (int i = 0; i < 16; ++i) { LAS float* s = scr + (4 * i + kr) * 65 + col; s[0] = v[i][0]; s[1] = v[i][1]; s[2] = v[i][2]; s[3] = v[i][3]; }
    asm volatile("s_waitcnt lgkmcnt(0)" ::: "memory");
    const int c = lane & 7;
#pragma unroll
    for (int j = 0; j < 8; ++j) { const int n = (lane >> 3) + 8 * j; const LAS float* s = scr + (8 * c) * 65 + n;
        u32x4 o; o.x = cvt_pk_bf16(s[0], s[65]); o.y = cvt_pk_bf16(s[2 * 65], s[3 * 65]); o.z = cvt_pk_bf16(s[4 * 65], s[5 * 65]); o.w = cvt_pk_bf16(s[6 * 65], s[7 * 65]);
        *(u32x4*)(WT + (size_t)(d0 + n) * K + k0 + 8 * c) = o; }
    asm volatile("s_waitcnt lgkmcnt(0)" ::: "memory");
}

struct Args { const float* in[22]; float* out; unsigned char* ws; int ph_lo, ph_hi, coop, pad; };

__global__ void __launch_bounds__(NTHR, 2) fwd_kernel(Args a) {
    extern __shared__ __attribute__((aligned(16))) unsigned char lds_raw[];
    LAS unsigned char* lds = (LAS unsigned char*)lds_raw;
    cg::grid_group grid = cg::this_grid();
    const int tid = threadIdx.x, lane = tid & 63, wave = __builtin_amdgcn_readfirstlane(tid >> 6);
    const int G = gridDim.x, bx = blockIdx.x;
    unsigned char* ws = a.ws;
    const int lo = a.ph_lo, hi = a.ph_hi;
#ifndef PHMASK
#define PHMASK 0x1ff
#endif
#define IN(k) (lo <= (k) && (k) < hi && ((PHMASK >> (k)) & 1))
#define SEAM(k) do { if (lo <= (k) && (k) + 1 < hi) grid.sync(); } while (0)
#define rstd1 ((float*)(ws + WS_RSTD1))
#define ssq2 ((float*)(ws + WS_SSQ2))
#define ssq3 ((float*)(ws + WS_SSQ3))
#define ssq4 ((float*)(ws + WS_SSQ4))
#define Win ((bf16_t*)(ws + WS_WIN))
#define Woa ((bf16_t*)(ws + WS_WOA))
#define Wpw ((bf16_t*)(ws + WS_WPW))
#define Wo ((bf16_t*)(ws + WS_WO))
#define Wgu ((bf16_t*)(ws + WS_WGU))
#define Wdn ((bf16_t*)(ws + WS_WDN))
#define Wpg ((bf16_t*)(ws + WS_WPG))
#define Wpp ((bf16_t*)(ws + WS_WPP))
#define XB ((bf16_t*)(ws + WS_R0))
#define MB ((bf16_t*)(ws + WS_R0))
#define H2B ((bf16_t*)(ws + WS_H1B))
#define Qb ((bf16_t*)(ws + WS_Q))
#define ABb ((bf16_t*)(ws + WS_AB))
#define Ub ((bf16_t*)(ws + WS_U))
#define SGA ((bf16_t*)(ws + WS_SGA))
#define SGB ((bf16_t*)(ws + WS_SGB))
#define YA ((bf16_t*)(ws + WS_YA))
#define VB ((bf16_t*)(ws + WS_VB))
#define H1B ((bf16_t*)(ws + WS_H1B))
#define Fb ((bf16_t*)(ws + WS_F))
#define PLEB ((bf16_t*)(ws + WS_R0))
#define PB ((bf16_t*)(ws + WS_PB))
    float* out = a.out;

    if (IN(0)) {
        LAS float* scr = (LAS float*)(lds + wave * 16640);
        const int gw = bx * NWAVES + wave, NGW = G * NWAVES;
        constexpr int I0 = 32 * 144;
        for (int it = gw; it < I0; it += NGW) tr_item(a.in[3], DM, NIN, a.in[2], Win, 1, it, scr, lane);
        for (int row = gw; row < SEQ; row += NGW) {
            const f32x4* xr = (const f32x4*)(a.in[0] + (size_t)row * DM) + lane; f32x4 v[8]; float s = 0.f;
#pragma unroll
            for (int j = 0; j < 8; ++j) { v[j] = xr[64 * j]; s += dot4(v[j]); }
            s = wave_sum(s);
            if (lane == 0) rstd1[row] = rsqrtf(s * (1.0f / DM) + EPS);
            u32x2* o = (u32x2*)(XB + (size_t)row * DM) + lane;
#pragma unroll
            for (int j = 0; j < 8; ++j) { u32x2 w; w.x = cvt_pk_bf16(v[j][0], v[j][1]); w.y = cvt_pk_bf16(v[j][2], v[j][3]); o[64 * j] = w; }
        }
        for (int c = gw; c < SEQ * PLE / 512; c += NGW) {
            const f32x4* pr = (const f32x4*)(a.in[1] + (size_t)c * 512) + 2 * lane; const f32x4 v0 = pr[0], v1 = pr[1];
            st_bf16x8(PB + (size_t)c * 512 + 8 * lane, v0, v1);
        }
        for (int i = bx * NTHR + tid; i < SEQ; i += G * NTHR) { ssq2[i] = 0.f; ssq3[i] = 0.f; ssq4[i] = 0.f; }
        __syncthreads();
    }
    SEAM(0);
    if (IN(1)) {
        pg8::Gemm g{XB, Win, SEQ, NIN, DM}; pg8::StaticOrder S; S.init(SEQ, NIN, G, bx);
        EpiProj E{rstd1, a.in[6], Qb, ABb, Ub, SGA, SGB};
        pg8::gemm_phase<EpiProj, pg8::StaticOrder, true, true>(lds, g, S, E);
        const int rem = ((SEQ / 256) * (NIN / 256)) % G;
        if (rem == 0 || bx >= rem) {
            const int NS = rem ? G - rem : G, sb = rem ? bx - rem : bx;
            LAS float* scr = (LAS float*)(lds + wave * 16640);
            constexpr int I1 = 16 * 32, I2 = 16 * 32, I3 = 32 * 32, I4 = 32 * 88, I5 = 32 * 88, I8 = 4 * 32;
            for (int it = sb * NWAVES + wave; it < I1 + I2 + I3 + I4 + I5 + I8; it += NS * NWAVES) {
                int r = it;
                if (r < I8) { tr_item(a.in[20], PLE, DM, nullptr, Wpp, 0, r, scr, lane); continue; } r -= I8;
                if (r < I1) { tr_item(a.in[5], CW, DM, nullptr, Woa, 0, r, scr, lane); continue; } r -= I1;
                if (r < I2) { tr_item(a.in[11], CW, DM, nullptr, Wpw, 0, r, scr, lane); continue; } r -= I2;
                if (r < I3) { tr_item(a.in[13], DM, DM, nullptr, Wo, 0, r, scr, lane); continue; } r -= I3;
                if (r < I4) { tr_item(a.in[15], DM, DFF, a.in[14], Wgu, 2, r, scr, lane); continue; } r -= I4;
                tr_item(a.in[16], DM, DFF, a.in[14], Wgu, 3, r, scr, lane);
            }
            __syncthreads();
        }
    }
    SEAM(1);
    if (IN(2)) {
        const int c0 = 2 * tid;
        float wa0[3], wa1[3], wb0[31], wb1[31];
#pragma unroll
        for (int k = 0; k < 3; ++k) { const f32x2 w = *(const f32x2*)(a.in[4] + k * CW + c0); wa0[k] = w.x; wa1[k] = w.y; }
#pragma unroll
        for (int k = 0; k < 31; ++k) { const f32x2 w = *(const f32x2*)(a.in[7] + k * CW + c0); wb0[k] = w.x; wb1[k] = w.y; }
        const f32x2 cb = *(const f32x2*)(a.in[8] + c0), lg = *(const f32x2*)(a.in[9] + c0), lb = *(const f32x2*)(a.in[10] + c0);
        LAS float* P = (LAS float*)lds; LAS float* St = (LAS float*)(lds + 65536);
        for (int tile = bx; tile < SEQ / 16; tile += G) {
            const int t0 = tile * 16;
            {
                float q0[18], q1[18];
#pragma unroll
                for (int j = 0; j < 18; ++j) { const int ts = t0 - 2 + j; unsigned w = 0u; if (ts >= 0) w = *(const unsigned*)(Qb + (size_t)ts * CW + c0); q0[j] = bf_lo(w); q1[j] = bf_hi(w); }
#pragma unroll
                for (int i = 0; i < 16; ++i) { const unsigned w = *(const unsigned*)(ABb + (size_t)(t0 + i) * CW + c0);
                    const float y0 = bf_lo(w) * (wa0[0] * q0[i] + wa0[1] * q0[i + 1] + wa0[2] * q0[i + 2]);
                    const float y1 = bf_hi(w) * (wa1[0] * q1[i] + wa1[1] * q1[i + 1] + wa1[2] * q1[i + 2]);
                    *(unsigned*)(YA + (size_t)(t0 + i) * CW + c0) = cvt_pk_bf16(y0, y1); }
            }
            float acc0[16], acc1[16];
#pragma unroll
            for (int i = 0; i < 16; ++i) { acc0[i] = cb.x; acc1[i] = cb.y; }
#pragma unroll
            for (int s = 0; s < 46; ++s) { const int ts = t0 - 30 + s; unsigned w = 0u; if (ts >= 0) w = *(const unsigned*)(Ub + (size_t)ts * CW + c0);
                const float u0 = bf_lo(w), u1 = bf_hi(w);
#pragma unroll
                for (int i = 0; i < 16; ++i) { const int k = s - i; if (k >= 0 && k <= 30) { acc0[i] += wb0[k] * u0; acc1[i] += wb1[k] * u1; } } }
#pragma unroll
            for (int i = 0; i < 16; ++i) { P[(2 * i) * NTHR + tid] = acc0[i] + acc1[i]; P[(2 * i + 1) * NTHR + tid] = acc0[i] * acc0[i] + acc1[i] * acc1[i]; }
            __syncthreads();
#pragma unroll
            for (int r = 0; r < 4; ++r) { const int row = 4 * wave + r; float s = 0.f;
#pragma unroll
                for (int j = 0; j < 8; ++j) s += P[row * NTHR + lane + 64 * j];
                s = wave_sum(s); if (lane == 0) St[row] = s; }
            __syncthreads();
#pragma unroll
            for (int i = 0; i < 16; ++i) { const float mean = St[2 * i] * (1.0f / CW), var = St[2 * i + 1] * (1.0f / CW) - mean * mean, rs = rsqrtf(fmaxf(var, 0.f) + LN_EPS);
                const float v0 = (acc0[i] - mean) * rs * lg.x + lb.x, v1 = (acc1[i] - mean) * rs * lg.y + lb.y;
                *(unsigned*)(VB + (size_t)(t0 + i) * CW + c0) = cvt_pk_bf16(v0 * sigm(v0), v1 * sigm(v1)); }
        }
        __syncthreads();
    }
    SEAM(2);
    if (IN(3)) {
        pg8::StaticOrder S; S.init(SEQ, DM, G, bx);
        { pg8::Gemm g{YA, Woa, SEQ, DM, CW}; EpiM1 E{SGA, out}; pg8::gemm_phase<EpiM1, pg8::StaticOrder, true, true>(lds, g, S, E); }
        { pg8::Gemm g{VB, Wpw, SEQ, DM, CW}; EpiM E{SGB, out, a.in[12], MB}; pg8::gemm_phase<EpiM, pg8::StaticOrder, true, true>(lds, g, S, E); }
    }
    SEAM(3);
    if (IN(4)) {
        pg8::Gemm g{MB, Wo, SEQ, DM, DM}; pg8::StaticOrder S; S.init(SEQ, DM, G, bx);
        EpiRes<false, true> E{a.in[0], out, H1B, ssq2, nullptr, nullptr};
        pg8::gemm_phase<EpiRes<false, true>, pg8::StaticOrder, true, true>(lds, g, S, E);
    }
    SEAM(4);
    if (IN(5)) {
        pg8::Gemm g{H1B, Wgu, SEQ, 2 * DFF, DM}; pg8::StaticOrder S; S.init(SEQ, 2 * DFF, G, bx);
        EpiSwiglu E{ssq2, Fb};
        pg8::gemm_phase<EpiSwiglu, pg8::StaticOrder, true, true>(lds, g, S, E);
        const int rem = ((SEQ / 256) * (2 * DFF / 256)) % G;
        if (rem == 0 || bx >= rem) {
            const int NS = rem ? G - rem : G, sb = rem ? bx - rem : bx;
            { pg8::Gemm g2{PB, Wpp, SEQ, DM, PLE}; pg8::StaticOrder S2; S2.init(SEQ, DM, NS, sb); EpiPle E2{PLEB};
              pg8::gemm_phase<EpiPle, pg8::StaticOrder, true, true>(lds, g2, S2, E2); }
            LAS float* scr = (LAS float*)(lds + wave * 16640);
            constexpr int I6 = 88 * 32, I7 = 32 * 32;
            for (int it = sb * NWAVES + wave; it < I6 + I7; it += NS * NWAVES) {
                if (it < I6) tr_item(a.in[17], DFF, DM, nullptr, Wdn, 0, it, scr, lane);
                else tr_item(a.in[19], DM, DM, a.in[18], Wpg, 0, it - I6, scr, lane);
            }
            __syncthreads();
        }
    }
    SEAM(5);
    if (IN(6)) {
        pg8::Gemm g{Fb, Wdn, SEQ, DM, DFF}; pg8::StaticOrder S; S.init(SEQ, DM, G, bx);
        EpiRes<false, true> E{out, out, H2B, ssq3, nullptr, nullptr};
        pg8::gemm_phase<EpiRes<false, true>, pg8::StaticOrder, true, true>(lds, g, S, E);
    }
    SEAM(6);
    if (IN(7)) {
        pg8::StaticOrder S; S.init(SEQ, DM, G, bx);
        { pg8::Gemm g{H2B, Wpg, SEQ, DM, DM}; EpiRes<true, false> E{out, out, nullptr, ssq4, ssq3, PLEB};
          pg8::gemm_phase<EpiRes<true, false>, pg8::StaticOrder, true, true>(lds, g, S, E); }
    }
    SEAM(7);
    if (IN(8)) {
        const int gw = bx * NWAVES + wave, NGW = G * NWAVES;
        const f32x4* gf = (const f32x4*)a.in[21] + lane;
        for (int row = gw; row < SEQ; row += NGW) {
            f32x4* o = (f32x4*)(out + (size_t)row * DM) + lane; const float r = rsqrtf(ssq4[row] * (1.0f / DM) + EPS);
#pragma unroll
            for (int j = 0; j < 8; ++j) o[64 * j] = o[64 * j] * r * gf[64 * j];
        }
    }
#undef IN
#undef SEAM
}

extern "C" void kernel_launch(void* const* d_in, const int* in_sizes, int n_in, void* d_out, int out_size, void* d_ws, size_t ws_size, hipStream_t stream) {
    static int grid = 0;
    if (grid == 0) {
        if (n_in != 22 || out_size != SEQ * DM || ws_size < WS_END) { fprintf(stderr, "kernel_launch: unexpected shapes (n_in %d, out %d, ws %zu)\n", n_in, out_size, ws_size); grid = -1; return; }
        int dev = 0, cus = 0, per_cu = 0;
        if (hipGetDevice(&dev) != hipSuccess || hipDeviceGetAttribute(&cus, hipDeviceAttributeMultiprocessorCount, dev) != hipSuccess) { grid = -1; return; }
        if (hipFuncSetAttribute((const void*)fwd_kernel, hipFuncAttributeMaxDynamicSharedMemorySize, LDS_BYTES) != hipSuccess) { fprintf(stderr, "kernel_launch: hipFuncSetAttribute failed\n"); grid = -1; return; }
        if (hipOccupancyMaxActiveBlocksPerMultiprocessor(&per_cu, (const void*)fwd_kernel, NTHR, LDS_BYTES) != hipSuccess || per_cu < 1) { fprintf(stderr, "kernel_launch: occupancy query says %d\n", per_cu); per_cu = 1; }
        (void)hipGetLastError();
        grid = cus;
    }
    if (grid < 0) return;
    Args a{};
    for (int i = 0; i < 22; ++i) a.in[i] = (const float*)d_in[i];
    a.out = (float*)d_out; a.ws = (unsigned char*)d_ws;
#if MK_LAUNCHES == 1
    a.ph_lo = 0; a.ph_hi = NPHASE; a.coop = 1;
    void* args[] = {&a};
    hipError_t e = hipLaunchCooperativeKernel((const void*)fwd_kernel, dim3(grid), dim3(NTHR), args, LDS_BYTES, stream);
    if (e != hipSuccess) fprintf(stderr, "kernel_launch: cooperative launch failed: %s (grid %d)\n", hipGetErrorString(e), grid);
#else
    for (int ph = 0; ph < NPHASE; ++ph) { a.ph_lo = ph; a.ph_hi = ph + 1; a.coop = 0; hipLaunchKernelGGL(fwd_kernel, dim3(grid), dim3(NTHR), LDS_BYTES, stream, a); }
#endif
}
```

```cpp
#include <hip/hip_runtime.h>
#include <hip/hip_cooperative_groups.h>
#include <cstdio>
#include <cstdint>
namespace cg = cooperative_groups;
namespace pg8 {
#define PG8_LAS __attribute__((address_space(3)))
typedef unsigned short bf16_t;
typedef short bf16x8 __attribute__((ext_vector_type(8)));
typedef float f32x4 __attribute__((ext_vector_type(4)));
typedef unsigned u32x4 __attribute__((ext_vector_type(4)));
constexpr int BM = 256, BK = 64, HALF = 128, HTB = HALF * BK * 2  , STAGE_BYTES = 8 * HTB, NXCD = 8, WGM = 8;

__host__ __device__ __forceinline__ int lds_byte(int r, int c) { const int st = (r >> 4) * 2 + (c >> 5), rr = r & 15, cc = c & 31, ob = rr * 64 + cc * 2; return st * 1024 + (ob ^ (((ob >> 9) & 1) << 5)); }
__host__ __device__ __forceinline__ void stage_rc(int b, int& R, int& C) { const int st = b / 1024, sb = b % 1024, swz = sb ^ (((sb >> 9) & 1) << 5); R = (st >> 1) * 16 + swz / 64; C = (st & 1) * 32 + (swz % 64) / 2; }
__host__ __device__ __forceinline__ int perm32(int rho) { const int n = rho >> 4, i = rho & 15; return 8 * (i >> 2) + 4 * n + (i & 3); }

struct Unit { int pm, pn; };
struct Gemm { const bf16_t* A; const bf16_t* Bt; int M, N, K; };

struct StaticOrder {
    int nM, nN, nwg, G, c;
    __host__ __device__ void init(int M, int N, int G_, int c_) { nM = M / BM; nN = N / BM; nwg = nM * nN; G = G_; c = c_; }
    __host__ __device__ bool next(int i, Unit& u) const {
        const long L = (long)i * G + c; if (L >= nwg) return false;
        int wgid = (int)L; { const int q = nwg / NXCD, r = nwg % NXCD, xcd = wgid % NXCD, off = wgid / NXCD; wgid = (xcd < r ? xcd * (q + 1) : r * (q + 1) + (xcd - r) * q) + off; }
        const int nig = WGM * nN, gid = wgid / nig, fm = gid * WGM, gsz = (nM - fm) < WGM ? (nM - fm) : WGM;
        u.pm = fm + ((wgid % nig) % gsz); u.pn = (wgid % nig) / gsz; return true;
    }
    __device__ __forceinline__ void a_ready(const Unit&) const {}
    __device__ __forceinline__ void done(const Unit&) const {}
};

__device__ __forceinline__ unsigned cvt_pk_bf16(float lo, float hi) { unsigned r; asm volatile("v_cvt_pk_bf16_f32 %0, %1, %2" : "=v"(r) : "v"(lo), "v"(hi)); return r; }
typedef float f32x2 __attribute__((ext_vector_type(2)));
template <class Epi, class Sched, bool ALIGN_EPI = false, bool SP2 = false>
__device__ __forceinline__ void gemm_phase(PG8_LAS unsigned char* lds, const Gemm g, const Sched& S, const Epi& E) {
    const int tid = threadIdx.x, wid = __builtin_amdgcn_readfirstlane(tid >> 6), lane = tid & 63, wr = wid >> 2, wc = wid & 3, fr = lane & 15, fq = lane >> 4;
    const int K = g.K, nt = K / BK;
    unsigned voffA[2], voffB[2];
#pragma unroll
    for (int i = 0; i < 2; ++i) { int R, C; stage_rc(tid * 16 + i * 8192, R, C); const int Rb = Epi::PERM ? ((R & ~31) + perm32(R & 31)) : R;
        voffA[i] = (unsigned)(R * K + C) * 2u; voffB[i] = (unsigned)(Rb * K + C) * 2u; }
    const size_t kstep = (size_t)(BK * 2);
    const size_t hstep = (size_t)HALF * K * 2;
    const size_t tstep = 2 * hstep;
    const unsigned ldsw = (unsigned)wid * 1024u;
    const int aoff = lds_byte(wr * 64 + fr, fq * 8), boff = lds_byte(wc * 32 + fr, fq * 8);
#define PG8_SA(b, h) (((b) * 2 + (h)) * HTB)
#define PG8_SB(b, h) ((4 + (b) * 2 + (h)) * HTB)
#define PG8_STAGE(bufoff, gbase, voff) do { _Pragma("unroll") for (int _i = 0; _i < 2; ++_i) \
        __builtin_amdgcn_global_load_lds((const unsigned*)((const char*)(gbase) + (voff)[_i]), (PG8_LAS unsigned*)(lds + (bufoff) + ldsw + _i * 8192), 16, 0, 0); } while (0)
#define PG8_LDA(dst, b, h) do { _Pragma("unroll") for (int m = 0; m < 4; ++m) _Pragma("unroll") for (int k = 0; k < 2; ++k) dst[m][k] = *(const PG8_LAS bf16x8*)(lds + PG8_SA(b, h) + aoff + m * 2048 + k * 1024); } while (0)
#define PG8_LDB(dst, b, h) do { _Pragma("unroll") for (int n = 0; n < 2; ++n) _Pragma("unroll") for (int k = 0; k < 2; ++k) dst[n][k] = *(const PG8_LAS bf16x8*)(lds + PG8_SB(b, h) + boff + n * 2048 + k * 1024); } while (0)
#define PG8_MMA(ai, bj, At, Bt) do { __builtin_amdgcn_s_setprio(1); _Pragma("unroll") for (int m = 0; m < 4; ++m) _Pragma("unroll") for (int n = 0; n < 2; ++n) _Pragma("unroll") for (int k = 0; k < 2; ++k) \
        acc[ai][bj][m][n] = __builtin_amdgcn_mfma_f32_16x16x32_bf16(Bt[n][k], At[m][k], acc[ai][bj][m][n], 0, 0, 0); __builtin_amdgcn_s_setprio(0); } while (0)
#define PG8_WAIT_V(n) asm volatile("s_waitcnt vmcnt(" #n ")" ::: "memory")
#define PG8_WAIT_L(n) asm volatile("s_waitcnt lgkmcnt(" #n ")" ::: "memory")
#define PG8_BAR __builtin_amdgcn_s_barrier()
#define PG8_SCHED __builtin_amdgcn_sched_barrier(0)
    Unit cur, nxt; int ui = 0;
    if (!S.next(0, cur)) return;
    f32x4 acc[2][2][4][2];
#pragma unroll
    for (int a = 0; a < 2; ++a)
#pragma unroll
        for (int b = 0; b < 2; ++b)
#pragma unroll
            for (int m = 0; m < 4; ++m)
#pragma unroll
                for (int n = 0; n < 2; ++n) acc[a][b][m][n] = (f32x4){0.f, 0.f, 0.f, 0.f};
    bf16x8 At[4][2], B0[2][2], B1[2][2];
    const char* cA = (const char*)g.A + (size_t)cur.pm * tstep; const char* cB = (const char*)g.Bt + (size_t)cur.pn * tstep;
    S.a_ready(cur);
    if constexpr (SP2) {
        PG8_STAGE(PG8_SB(0, 0), cB, voffB); PG8_STAGE(PG8_SB(0, 1), cB + hstep, voffB); PG8_STAGE(PG8_SA(0, 0), cA, voffA); PG8_STAGE(PG8_SA(0, 1), cA + hstep, voffA);
        if (wr == 1) PG8_BAR;
        PG8_WAIT_V(2); PG8_BAR;
        PG8_STAGE(PG8_SB(1, 0), cB + kstep, voffB); PG8_STAGE(PG8_SA(1, 0), cA + kstep, voffA); PG8_STAGE(PG8_SB(1, 1), cB + hstep + kstep, voffB);
        PG8_WAIT_V(6); PG8_BAR;
    } else {
        PG8_STAGE(PG8_SB(0, 0), cB, voffB); PG8_STAGE(PG8_SA(0, 0), cA, voffA); PG8_STAGE(PG8_SB(0, 1), cB + hstep, voffB); PG8_STAGE(PG8_SA(0, 1), cA + hstep, voffA);
        if (wr == 1) PG8_BAR;
        PG8_WAIT_V(4); PG8_BAR;
        PG8_STAGE(PG8_SB(1, 0), cB + kstep, voffB); PG8_STAGE(PG8_SA(1, 0), cA + kstep, voffA); PG8_STAGE(PG8_SB(1, 1), cB + hstep + kstep, voffB);
        PG8_WAIT_V(6); PG8_BAR;
    }
    for (;;) {
        const bool has_next = S.next(ui + 1, nxt);
        const char* nA = has_next ? (const char*)g.A + (size_t)nxt.pm * tstep : cA; const char* nB = has_next ? (const char*)g.Bt + (size_t)nxt.pn * tstep : cB;
#pragma unroll 1
        for (int t = 0; t < nt; t += 2) {
            const bool last = (t == nt - 2);
            const char* a1 = cA + (size_t)(t + 1) * kstep;
            const char* a2 = last ? nA : cA + (size_t)(t + 2) * kstep; const char* b2 = last ? nB : cB + (size_t)(t + 2) * kstep;
            const char* a3 = a2 + kstep; const char* b3 = b2 + kstep;
            if (last && has_next) S.a_ready(nxt);
            if constexpr (SP2) {
            PG8_LDB(B0, 0, 0); PG8_LDB(B1, 0, 1); PG8_SCHED; PG8_LDA(At, 0, 0); PG8_STAGE(PG8_SA(1, 1), a1 + hstep, voffA);
            PG8_WAIT_V(8); PG8_WAIT_L(0); PG8_BAR; PG8_MMA(0, 0, At, B0); PG8_MMA(0, 1, At, B1); PG8_BAR; PG8_SCHED;
            PG8_LDA(At, 0, 1); PG8_STAGE(PG8_SB(0, 0), b2, voffB); PG8_STAGE(PG8_SB(0, 1), b2 + hstep, voffB); PG8_STAGE(PG8_SA(0, 0), a2, voffA);
            PG8_WAIT_V(8); PG8_WAIT_L(0); PG8_BAR; PG8_MMA(1, 0, At, B0); PG8_MMA(1, 1, At, B1); PG8_BAR; PG8_SCHED;
            PG8_LDB(B0, 1, 0); PG8_LDB(B1, 1, 1); PG8_SCHED; PG8_LDA(At, 1, 0); PG8_STAGE(PG8_SA(0, 1), a2 + hstep, voffA);
            PG8_WAIT_V(8); PG8_WAIT_L(0); PG8_BAR; PG8_MMA(0, 0, At, B0); PG8_MMA(0, 1, At, B1); PG8_BAR; PG8_SCHED;
            PG8_LDA(At, 1, 1); PG8_STAGE(PG8_SB(1, 0), b3, voffB); PG8_STAGE(PG8_SB(1, 1), b3 + hstep, voffB); PG8_STAGE(PG8_SA(1, 0), a3, voffA);
            PG8_WAIT_V(8); PG8_WAIT_L(0); PG8_BAR; PG8_MMA(1, 0, At, B0); PG8_MMA(1, 1, At, B1); PG8_BAR; PG8_SCHED;
            } else {
            PG8_LDB(B0, 0, 0); PG8_SCHED; PG8_LDA(At, 0, 0); PG8_STAGE(PG8_SA(1, 1), a1 + hstep, voffA);
            PG8_WAIT_L(8); PG8_BAR; PG8_WAIT_L(0); PG8_MMA(0, 0, At, B0); PG8_BAR; PG8_SCHED;
            PG8_LDB(B1, 0, 1); PG8_STAGE(PG8_SB(0, 0), b2, voffB);
            PG8_BAR; PG8_WAIT_L(0); PG8_MMA(0, 1, At, B1); PG8_BAR;
            PG8_LDA(At, 0, 1); PG8_STAGE(PG8_SA(0, 0), a2, voffA);
            PG8_BAR; PG8_WAIT_L(0); PG8_MMA(1, 0, At, B0); PG8_BAR; PG8_SCHED;
            PG8_STAGE(PG8_SB(0, 1), b2 + hstep, voffB);
            PG8_WAIT_V(6); PG8_BAR; PG8_MMA(1, 1, At, B1); PG8_BAR;
            PG8_LDB(B0, 1, 0); PG8_SCHED; PG8_LDA(At, 1, 0); PG8_STAGE(PG8_SA(0, 1), a2 + hstep, voffA);
            PG8_WAIT_L(8); PG8_BAR; PG8_WAIT_L(0); PG8_MMA(0, 0, At, B0); PG8_BAR; PG8_SCHED;
            PG8_LDB(B1, 1, 1); PG8_STAGE(PG8_SB(1, 0), b3, voffB);
            PG8_BAR; PG8_WAIT_L(0); PG8_MMA(0, 1, At, B1); PG8_BAR;
            PG8_LDA(At, 1, 1); PG8_STAGE(PG8_SA(1, 0), a3, voffA);
            PG8_BAR; PG8_WAIT_L(0); PG8_MMA(1, 0, At, B0); PG8_BAR; PG8_SCHED;
            PG8_STAGE(PG8_SB(1, 1), b3 + hstep, voffB);
            PG8_WAIT_V(6); PG8_BAR; PG8_MMA(1, 1, At, B1); PG8_BAR;
            }
        }
        if constexpr (ALIGN_EPI) { if (wr == 0) PG8_BAR; }
        if constexpr (!Epi::AFTER_DRAIN) { E(acc, cur, wr, wc, fr, fq); S.done(cur); }
        if (!has_next) break;
#pragma unroll
        for (int a = 0; a < 2; ++a)
#pragma unroll
            for (int b = 0; b < 2; ++b)
#pragma unroll
                for (int m = 0; m < 4; ++m)
#pragma unroll
                    for (int n = 0; n < 2; ++n) acc[a][b][m][n] = (f32x4){0.f, 0.f, 0.f, 0.f};
        cur = nxt; cA = nA; cB = nB; ++ui;
        if constexpr (ALIGN_EPI) { if (wr == 1) PG8_BAR; }
    }
    PG8_WAIT_V(0);
    if constexpr (!ALIGN_EPI) { if (wr == 0) PG8_BAR; }
    PG8_BAR;
    if constexpr (Epi::AFTER_DRAIN) { E.fused(acc, cur, wr, wc, fr, fq, lds, wid, lane); S.done(cur); }
#undef PG8_SA
#undef PG8_SB
#undef PG8_STAGE
#undef PG8_LDA
#undef PG8_LDB
#undef PG8_MMA
#undef PG8_WAIT_V
#undef PG8_WAIT_L
#undef PG8_BAR
#undef PG8_SCHED
}
}

#define LAS __attribute__((address_space(3)))
using pg8::bf16_t; using pg8::f32x4; using pg8::u32x4; using pg8::Unit; using pg8::cvt_pk_bf16;
typedef unsigned u32x2 __attribute__((ext_vector_type(2)));
typedef float f32x2 __attribute__((ext_vector_type(2)));

#ifndef MK_LAUNCHES
#define MK_LAUNCHES 1
#endif
constexpr int SEQ = 8192, DM = 2048, CW = 1024, NIN = 9216, DFF = 5632, PLE = 256;
constexpr float EPS = 1e-6f, LN_EPS = 1e-5f;
constexpr int NWAVES = 8, NTHR = 512, NPHASE = 9;
constexpr int LDS_BYTES = 147456;
constexpr size_t MiB = 1u << 20;
constexpr size_t WS_RSTD1 = 0, WS_SSQ2 = 64 * 1024, WS_SSQ3 = 128 * 1024, WS_SSQ4 = 192 * 1024;
constexpr size_t WS_BAR = 256 * 1024, WS_CNT = 512 * 1024;
constexpr int MISC_OFF = 143360;
constexpr size_t WS_WIN = 2 * MiB, WS_WOA = 38 * MiB, WS_WPW = 42 * MiB, WS_WO = 46 * MiB, WS_WGU = 54 * MiB, WS_WDN = 98 * MiB, WS_WPG = 120 * MiB, WS_WPP = 128 * MiB;
constexpr size_t WS_R0 = 130 * MiB;
constexpr size_t WS_Q = 162 * MiB, WS_AB = 178 * MiB, WS_U = 194 * MiB;
constexpr size_t WS_SGA = 210 * MiB, WS_SGB = 242 * MiB;
constexpr size_t WS_YA = 274 * MiB, WS_VB = 290 * MiB;
constexpr size_t WS_H1B = 162 * MiB;
constexpr size_t WS_F = 194 * MiB;
constexpr size_t WS_PB = 306 * MiB;
constexpr size_t WS_END = 310 * MiB;

__device__ __forceinline__ float sigm(float x) { return __builtin_amdgcn_rcpf(1.f + __expf(-x)); }
__device__ __forceinline__ f32x4 sig4(f32x4 v) { return (f32x4){sigm(v[0]), sigm(v[1]), sigm(v[2]), sigm(v[3])}; }
__device__ __forceinline__ float bf_lo(unsigned w) { return __uint_as_float(w << 16); }
__device__ __forceinline__ float bf_hi(unsigned w) { return __uint_as_float(w & 0xffff0000u); }
__device__ __forceinline__ void st_bf16x8(bf16_t* p, f32x4 v0, f32x4 v1) {
    u32x4 w; w.x = cvt_pk_bf16(v0[0], v0[1]); w.y = cvt_pk_bf16(v0[2], v0[3]); w.z = cvt_pk_bf16(v1[0], v1[1]); w.w = cvt_pk_bf16(v1[2], v1[3]); *(u32x4*)p = w; }
__device__ __forceinline__ void ld_bf16x8(const bf16_t* p, f32x4& v0, f32x4& v1) {
    const u32x4 w = *(const u32x4*)p; v0 = (f32x4){bf_lo(w.x), bf_hi(w.x), bf_lo(w.y), bf_hi(w.y)}; v1 = (f32x4){bf_lo(w.z), bf_hi(w.z), bf_lo(w.w), bf_hi(w.w)}; }
__device__ __forceinline__ float dot4(f32x4 a) { return (a[0] * a[0] + a[1] * a[1]) + (a[2] * a[2] + a[3] * a[3]); }
__device__ __forceinline__ float wave_sum(float v) {
#pragma unroll
    for (int o = 1; o < 64; o <<= 1) v += __shfl_xor(v, o);
    return v;
}

struct EpiProj {
    static constexpr bool PERM = true, AFTER_DRAIN = false;
    const float* rstd; const float* bglu; bf16_t *Qo, *ABo, *Uo, *SA, *SB;
    __device__ __forceinline__ void operator()(const f32x4 (&acc)[2][2][4][2], const Unit& u, int wr, int wc, int fr, int fq) const {
        const int pn = u.pn, row0 = u.pm * 256 + wr * 64 + fr, cl = wc * 32 + 8 * fq;
        if (pn < 8) {
#pragma unroll
            for (int ai = 0; ai < 2; ++ai)
#pragma unroll
                for (int m = 0; m < 4; ++m) { const int row = row0 + ai * 128 + m * 16; const float r = rstd[row], r2 = r * r;
                    st_bf16x8(Qo + (size_t)row * CW + pn * 128 + cl, acc[ai][0][m][0] * acc[ai][1][m][0] * r2, acc[ai][0][m][1] * acc[ai][1][m][1] * r2); }
        } else if (pn < 12) {
#pragma unroll
            for (int ai = 0; ai < 2; ++ai)
#pragma unroll
                for (int m = 0; m < 4; ++m) { const int row = row0 + ai * 128 + m * 16; const float r = rstd[row];
#pragma unroll
                    for (int bj = 0; bj < 2; ++bj) st_bf16x8(ABo + (size_t)row * CW + (pn - 8) * 256 + bj * 128 + cl, acc[ai][bj][m][0] * r, acc[ai][bj][m][1] * r); }
        } else if (pn < 20) {
            const int ch = (pn - 12) * 128 + cl;
            const f32x4 bv0 = *(const f32x4*)(bglu + ch), bv1 = *(const f32x4*)(bglu + ch + 4), bg0 = *(const f32x4*)(bglu + CW + ch), bg1 = *(const f32x4*)(bglu + CW + ch + 4);
#pragma unroll
            for (int ai = 0; ai < 2; ++ai)
#pragma unroll
                for (int m = 0; m < 4; ++m) { const int row = row0 + ai * 128 + m * 16; const float r = rstd[row];
                    const f32x4 v0 = acc[ai][0][m][0] * r + bv0, v1 = acc[ai][0][m][1] * r + bv1, g0 = acc[ai][1][m][0] * r + bg0, g1 = acc[ai][1][m][1] * r + bg1;
                    st_bf16x8(Uo + (size_t)row * CW + ch, v0 * sig4(g0), v1 * sig4(g1)); }
        } else {
            bf16_t* S = pn < 28 ? SA : SB; const int cb = ((pn - 20) & 7) * 256 + cl;
#pragma unroll
            for (int ai = 0; ai < 2; ++ai)
#pragma unroll
                for (int m = 0; m < 4; ++m) { const int row = row0 + ai * 128 + m * 16; const float r = rstd[row];
#pragma unroll
                    for (int bj = 0; bj < 2; ++bj) st_bf16x8(S + (size_t)row * DM + cb + bj * 128, sig4(acc[ai][bj][m][0] * r), sig4(acc[ai][bj][m][1] * r)); }
        }
    }
};
struct EpiM1 {
    static constexpr bool PERM = true, AFTER_DRAIN = false;
    const bf16_t* SG; float* M1;
    __device__ __forceinline__ void operator()(const f32x4 (&acc)[2][2][4][2], const Unit& u, int wr, int wc, int fr, int fq) const {
        const int row0 = u.pm * 256 + wr * 64 + fr, c0 = u.pn * 256 + wc * 32 + 8 * fq;
#pragma unroll
        for (int ai = 0; ai < 2; ++ai)
#pragma unroll
            for (int m = 0; m < 4; ++m)
#pragma unroll
                for (int bj = 0; bj < 2; ++bj) { const size_t off = (size_t)(row0 + ai * 128 + m * 16) * DM + c0 + bj * 128; f32x4 g0, g1; ld_bf16x8(SG + off, g0, g1);
                    *(f32x4*)(M1 + off) = g0 * acc[ai][bj][m][0]; *(f32x4*)(M1 + off + 4) = g1 * acc[ai][bj][m][1]; }
    }
};
struct EpiM {
    static constexpr bool PERM = true, AFTER_DRAIN = false;
    const bf16_t* SG; const float* M1; const float* bias; bf16_t* Mo;
    __device__ __forceinline__ void operator()(const f32x4 (&acc)[2][2][4][2], const Unit& u, int wr, int wc, int fr, int fq) const {
        const int row0 = u.pm * 256 + wr * 64 + fr, c0 = u.pn * 256 + wc * 32 + 8 * fq;
        f32x4 bv[2][2];
#pragma unroll
        for (int bj = 0; bj < 2; ++bj) { bv[bj][0] = *(const f32x4*)(bias + c0 + bj * 128); bv[bj][1] = *(const f32x4*)(bias + c0 + bj * 128 + 4); }
#pragma unroll
        for (int ai = 0; ai < 2; ++ai)
#pragma unroll
            for (int m = 0; m < 4; ++m)
#pragma unroll
                for (int bj = 0; bj < 2; ++bj) { const size_t off = (size_t)(row0 + ai * 128 + m * 16) * DM + c0 + bj * 128; f32x4 g0, g1; ld_bf16x8(SG + off, g0, g1);
                    const f32x4 a0 = *(const f32x4*)(M1 + off), a1 = *(const f32x4*)(M1 + off + 4);
                    st_bf16x8(Mo + off, a0 + g0 * (acc[ai][bj][m][0] + bv[bj][0]), a1 + g1 * (acc[ai][bj][m][1] + bv[bj][1])); }
    }
};
template <bool GATED, bool WB16> struct EpiRes {
    static constexpr bool PERM = true, AFTER_DRAIN = false;
    const float* base; float* out; bf16_t* ob; float* ssq_out; const float* ssq_in; const bf16_t* ple;
    __device__ __forceinline__ void operator()(const f32x4 (&acc)[2][2][4][2], const Unit& u, int wr, int wc, int fr, int fq) const {
        const int row0 = u.pm * 256 + wr * 64 + fr, c0 = u.pn * 256 + wc * 32 + 8 * fq;
#pragma unroll
        for (int ai = 0; ai < 2; ++ai)
#pragma unroll
            for (int m = 0; m < 4; ++m) { const int row = row0 + ai * 128 + m * 16; float r = 0.f; if (GATED) r = rsqrtf(ssq_in[row] * (1.0f / DM) + EPS);
                float s = 0.f;
#pragma unroll
                for (int bj = 0; bj < 2; ++bj) { const size_t off = (size_t)row * DM + c0 + bj * 128;
                    const f32x4 b0 = *(const f32x4*)(base + off), b1 = *(const f32x4*)(base + off + 4);
                    f32x4 v0 = acc[ai][bj][m][0], v1 = acc[ai][bj][m][1];
                    if (GATED) { f32x4 p0, p1; ld_bf16x8(ple + off, p0, p1); v0 = sig4(v0 * r) * p0; v1 = sig4(v1 * r) * p1; }
                    const f32x4 h0 = b0 + v0, h1 = b1 + v1;
                    *(f32x4*)(out + off) = h0; *(f32x4*)(out + off + 4) = h1;
                    if (WB16) st_bf16x8(ob + off, h0, h1);
                    s += dot4(h0) + dot4(h1); }
                s += __shfl_xor(s, 16); s += __shfl_xor(s, 32);
                if (fq == 0) unsafeAtomicAdd(ssq_out + row, s);
                if (GATED ? (m & 1) : (m == 3)) asm volatile("" ::: "memory"); }
    }
};
struct EpiSwiglu {
    static constexpr bool PERM = true, AFTER_DRAIN = false;
    const float* ssq_in; bf16_t* F;
    __device__ __forceinline__ void operator()(const f32x4 (&acc)[2][2][4][2], const Unit& u, int wr, int wc, int fr, int fq) const {
        const int row0 = u.pm * 256 + wr * 64 + fr, ch = u.pn * 128 + wc * 32 + 8 * fq;
#pragma unroll
        for (int ai = 0; ai < 2; ++ai)
#pragma unroll
            for (int m = 0; m < 4; ++m) { const int row = row0 + ai * 128 + m * 16; const float r = rsqrtf(ssq_in[row] * (1.0f / DM) + EPS);
                const f32x4 g0 = acc[ai][0][m][0] * r, g1 = acc[ai][0][m][1] * r, u0 = acc[ai][1][m][0] * r, u1 = acc[ai][1][m][1] * r;
                st_bf16x8(F + (size_t)row * DFF + ch, g0 * sig4(g0) * u0, g1 * sig4(g1) * u1); }
    }
};
struct EpiPle {
    static constexpr bool PERM = true, AFTER_DRAIN = false;
    bf16_t* O;
    __device__ __forceinline__ void operator()(const f32x4 (&acc)[2][2][4][2], const Unit& u, int wr, int wc, int fr, int fq) const {
        const int row0 = u.pm * 256 + wr * 64 + fr, c0 = u.pn * 256 + wc * 32 + 8 * fq;
#pragma unroll
        for (int ai = 0; ai < 2; ++ai)
#pragma unroll
            for (int m = 0; m < 4; ++m)
#pragma unroll
                for (int bj = 0; bj < 2; ++bj) st_bf16x8(O + (size_t)(row0 + ai * 128 + m * 16) * DM + c0 + bj * 128, acc[ai][bj][m][0], acc[ai][bj][m][1]);
    }
};

struct EpiFinal {
    static constexpr bool PERM = true, AFTER_DRAIN = true;
    const float* base; float* out; float* ssq_out; const float* ssq_in; const bf16_t* ple; const float* gfin; unsigned* cnt; unsigned want;
    __device__ __forceinline__ void fused(f32x4 (&acc)[2][2][4][2], const Unit& u, int wr, int wc, int fr, int fq, PG8_LAS unsigned char* lds, int wid, int lane) const {
        const int row0 = u.pm * 256 + wr * 64 + fr, c0 = u.pn * 256 + wc * 32 + 8 * fq;
#pragma unroll
        for (int ai = 0; ai < 2; ++ai)
#pragma unroll
            for (int m = 0; m < 4; ++m) { const int row = row0 + ai * 128 + m * 16; const float r = rsqrtf(ssq_in[row] * (1.0f / DM) + EPS);
                float s = 0.f;
#pragma unroll
                for (int bj = 0; bj < 2; ++bj) { const size_t off = (size_t)row * DM + c0 + bj * 128;
                    const f32x4 b0 = *(const f32x4*)(base + off), b1 = *(const f32x4*)(base + off + 4);
                    f32x4 p0, p1; ld_bf16x8(ple + off, p0, p1);
                    const f32x4 h0 = b0 + sig4(acc[ai][bj][m][0] * r) * p0, h1 = b1 + sig4(acc[ai][bj][m][1] * r) * p1;
                    acc[ai][bj][m][0] = h0; acc[ai][bj][m][1] = h1;
                    s += dot4(h0) + dot4(h1); }
                s += __shfl_xor(s, 16); s += __shfl_xor(s, 32);
                if (fq == 0) unsafeAtomicAdd(ssq_out + row, s);
                if (m & 1) asm volatile("" ::: "memory"); }
        asm volatile("s_waitcnt vmcnt(0)" ::: "memory");
        __syncthreads();
        if (threadIdx.x == 0) { unsigned* c = cnt + 64 * u.pm;
            __hip_atomic_fetch_add(c, 1u, __ATOMIC_RELAXED, __HIP_MEMORY_SCOPE_AGENT);
            while (__hip_atomic_load(c, __ATOMIC_RELAXED, __HIP_MEMORY_SCOPE_AGENT) < want) __builtin_amdgcn_s_sleep(2); }
        __syncthreads();
        f32x4 gv[2][2];
#pragma unroll
        for (int bj = 0; bj < 2; ++bj) { gv[bj][0] = *(const f32x4*)(gfin + c0 + bj * 128); gv[bj][1] = *(const f32x4*)(gfin + c0 + bj * 128 + 4); }
#pragma unroll
        for (int ai = 0; ai < 2; ++ai)
#pragma unroll
            for (int m = 0; m < 4; ++m) { const int row = row0 + ai * 128 + m * 16;
                const float rr = rsqrtf(__hip_atomic_load(ssq_out + row, __ATOMIC_RELAXED, __HIP_MEMORY_SCOPE_AGENT) * (1.0f / DM) + EPS);
#pragma unroll
                for (int bj = 0; bj < 2; ++bj) { const size_t off = (size_t)row * DM + c0 + bj * 128;
                    *(f32x4*)(out + off) = acc[ai][bj][m][0] * rr * gv[bj][0]; *(f32x4*)(out + off + 4) = acc[ai][bj][m][1] * rr * gv[bj][1]; } }
    }
};

__device__ __forceinline__ int win_dest(int n0) {
    if (n0 < 1024) return 256 * (n0 >> 7) + (n0 & 127);
    if (n0 < 2048) return 2048 + (n0 - 1024);
    if (n0 < 3072) { const int c = n0 - 2048; return 256 * (c >> 7) + 128 + (c & 127); }
    if (n0 < 4096) { const int c = n0 - 3072; return 3072 + 256 * (c >> 7) + (c & 127); }
    if (n0 < 5120) { const int c = n0 - 4096; return 3072 + 256 * (c >> 7) + 128 + (c & 127); }
    return n0;
}
__device__ __forceinline__ void tr_item(const float* W, int K, int N, const float* g, bf16_t* WT, int mode, int item, LAS float* scr, int lane) {
    const int nblk = N >> 6, kb = item / nblk, nb = item - kb * nblk, k0 = kb << 6, n0 = nb << 6;
    int d0 = n0;
    if (mode == 1) d0 = win_dest(n0); else if (mode == 2) d0 = 256 * (n0 >> 7) + (n0 & 127); else if (mode == 3) d0 = 256 * (n0 >> 7) + 128 + (n0 & 127);
    const int kr = lane >> 4, col = 4 * (lane & 15);
    f32x4 v[16];
#pragma unroll
    for (int i = 0; i < 16; ++i) v[i] = *(const f32x4*)(W + (size_t)(k0 + 4 * i + kr) * N + n0 + col);
    if (g) {
#pragma unroll
        for (int i = 0; i < 16; ++i) v[i] = v[i] * g[k0 + 4 * i + kr];
    }
#pragma unroll
    for (int i = 0; i < 16; ++i) { LAS float* s = scr + (4 * i + kr) * 65 + col; s[0] = v[i][0]; s[1] = v[i][1]; s[2] = v[i][2]; s[3] = v[i][3]; }
    asm volatile("s_waitcnt lgkmcnt(0)" ::: "memory");
    const int c = lane & 7;
#pragma unroll
    for (int j = 0; j < 8; ++j) { const int n = (lane >> 3) + 8 * j; const LAS float* s = scr + (8 * c) * 65 + n;
        u32x4 o; o.x = cvt_pk_bf16(s[0], s[65]); o.y = cvt_pk_bf16(s[2 * 65], s[3 * 65]); o.z = cvt_pk_bf16(s[4 * 65], s[5 * 65]); o.w = cvt_pk_bf16(s[6 * 65], s[7 * 65]);
        *(u32x4*)(WT + (size_t)(d0 + n) * K + k0 + 8 * c) = o; }
    asm volatile("s_waitcnt lgkmcnt(0)" ::: "memory");
}

#ifndef USE_XCDBAR
#define USE_XCDBAR 1
#endif
#ifndef FUSE_P8
#define FUSE_P8 1
#endif
#define XB_TMO      128
#define XB_XCNT(j)  (256  + 64 * (j))
#define XB_XSUB(j)  (1280 + 64 * (j))
#define XB_XGEN(j)  (2304 + 64 * (j))
#define XB_TOP      3328
#define XB_TOPGEN   3392
#define XCD_BAR_WORDS 3456
#define XB_SPIN_CAP (1u << 18)

__device__ __forceinline__ unsigned xb_ld(unsigned* p)              { return __hip_atomic_load(p, __ATOMIC_RELAXED, __HIP_MEMORY_SCOPE_AGENT); }
__device__ __forceinline__ unsigned xb_add(unsigned* p, unsigned v) { return __hip_atomic_fetch_add(p, v, __ATOMIC_RELAXED, __HIP_MEMORY_SCOPE_AGENT); }
__device__ __forceinline__ unsigned xb_xcc_id() { return (unsigned)__builtin_amdgcn_s_getreg((3 << 11) | 20) & 0xFu; }
#define XB_SPIN(cond, bar) do { unsigned _sp = 0; while (cond) { __builtin_amdgcn_s_sleep(1); \
    if ((++_sp & 255u) == 0u) { if (xb_ld(&(bar)[XB_TMO])) break; if (_sp > XB_SPIN_CAP) { atomicAdd(&(bar)[XB_TMO], 1u); break; } } } } while (0)

struct XcdBarrier {
    unsigned* bar; unsigned x;
    volatile LAS unsigned* st;
};

__device__ __forceinline__ XcdBarrier xcd_barrier_post(unsigned* bar, volatile LAS unsigned* st) {
    XcdBarrier b; b.bar = bar; b.x = xb_xcc_id(); b.st = st;
    if (threadIdx.x == 0) (void)xb_add(&bar[XB_XCNT(b.x)], 1u);
    return b;
}
__device__ __forceinline__ void xcd_barrier_complete(unsigned* bar, unsigned x, unsigned& nloc, unsigned& nx) {
    const unsigned G = gridDim.x * gridDim.y * gridDim.z;
    unsigned sum, cnt, mine, sp = 0u;
    for (;;) {
        sum = 0u; cnt = 0u; mine = 0u;
#pragma unroll
        for (unsigned j = 0; j < 16; ++j) { const unsigned c = xb_ld(&bar[XB_XCNT(j)]); sum += c; cnt += (c > 0u) ? 1u : 0u; mine = (j == x) ? c : mine; }
        if (sum == G) break;
        __builtin_amdgcn_s_sleep(1);
        if ((++sp & 255u) == 0u) { if (xb_ld(&bar[XB_TMO])) break; if (sp > XB_SPIN_CAP) { atomicAdd(&bar[XB_TMO], 1u); break; } }
    }
    nloc = mine > 0u ? mine : 1u; nx = cnt > 0u ? cnt : 1u;
}

__device__ __forceinline__ void xcd_barrier(const XcdBarrier& b) {
    asm volatile("s_waitcnt vmcnt(0)" ::: "memory");
    __syncthreads();
    if (threadIdx.x == 0) {
        unsigned* bar = b.bar;
        __builtin_amdgcn_s_waitcnt(0);
        unsigned nloc = b.st[0], nx = b.st[1];
        if (nloc == 0u) { xcd_barrier_complete(bar, b.x, nloc, nx); b.st[0] = nloc; b.st[1] = nx; }
        const unsigned old = xb_add(&bar[XB_XSUB(b.x)], 1u);
        const unsigned gen = old / nloc;
        if (old + 1u == (gen + 1u) * nloc) {
            __builtin_amdgcn_fence(__ATOMIC_RELEASE, "agent");
            asm volatile("s_waitcnt vmcnt(0)" ::: "memory");
            const unsigned og = xb_add(&bar[XB_TOP], 1u);
            const unsigned tg = og / nx;
            if (og + 1u == (tg + 1u) * nx) xb_add(&bar[XB_TOPGEN], 1u);
            else XB_SPIN(xb_ld(&bar[XB_TOPGEN]) == tg, bar);
            __builtin_amdgcn_fence(__ATOMIC_ACQUIRE, "agent");
            xb_add(&bar[XB_XGEN(b.x)], 1u);
            asm volatile("s_waitcnt vmcnt(0)" ::: "memory");
        } else {
            XB_SPIN(xb_ld(&bar[XB_XGEN(b.x)]) == gen, bar);
            __builtin_amdgcn_fence(__ATOMIC_ACQUIRE, "agent");
            asm volatile("s_waitcnt vmcnt(0)" ::: "memory");
        }
    }
    __syncthreads();
}

struct Args { const float* in[22]; float* out; unsigned char* ws; int ph_lo, ph_hi, coop, pad; };

__global__ void __launch_bounds__(NTHR, 2) fwd_kernel(Args a) {
    extern __shared__ __attribute__((aligned(16))) unsigned char lds_raw[];
    LAS unsigned char* lds = (LAS unsigned char*)lds_raw;
    cg::grid_group grid = cg::this_grid();
    const int tid = threadIdx.x, lane = tid & 63, wave = __builtin_amdgcn_readfirstlane(tid >> 6);
    const int G = gridDim.x, bx = blockIdx.x;
    unsigned char* ws = a.ws;
    const int lo = a.ph_lo, hi = a.ph_hi;
#ifndef PHMASK
#define PHMASK 0x1ff
#endif
#define IN(k) (lo <= (k) && (k) < hi && ((PHMASK >> (k)) & 1))
#define SEAM(k) do { if (lo <= (k) && (k) + 1 < hi) { if (USE_XCDBAR && (k) > 0) xcd_barrier(bar); else grid.sync(); \
        if (USE_XCDBAR && (k) == 0) bar = xcd_barrier_post((unsigned*)(ws + WS_BAR), (volatile LAS unsigned*)(lds + MISC_OFF)); } } while (0)
    XcdBarrier bar; bar.bar = (unsigned*)(ws + WS_BAR); bar.x = 0; bar.st = (volatile LAS unsigned*)(lds + MISC_OFF);
    if (tid < 2) ((volatile LAS unsigned*)(lds + MISC_OFF))[tid] = 0u;
    __syncthreads();
#define rstd1 ((float*)(ws + WS_RSTD1))
#define ssq2 ((float*)(ws + WS_SSQ2))
#define ssq3 ((float*)(ws + WS_SSQ3))
#define ssq4 ((float*)(ws + WS_SSQ4))
#define Win ((bf16_t*)(ws + WS_WIN))
#define Woa ((bf16_t*)(ws + WS_WOA))
#define Wpw ((bf16_t*)(ws + WS_WPW))
#define Wo ((bf16_t*)(ws + WS_WO))
#define Wgu ((bf16_t*)(ws + WS_WGU))
#define Wdn ((bf16_t*)(ws + WS_WDN))
#define Wpg ((bf16_t*)(ws + WS_WPG))
#define Wpp ((bf16_t*)(ws + WS_WPP))
#define XB ((bf16_t*)(ws + WS_R0))
#define MB ((bf16_t*)(ws + WS_R0))
#define H2B ((bf16_t*)(ws + WS_H1B))
#define Qb ((bf16_t*)(ws + WS_Q))
#define ABb ((bf16_t*)(ws + WS_AB))
#define Ub ((bf16_t*)(ws + WS_U))
#define SGA ((bf16_t*)(ws + WS_SGA))
#define SGB ((bf16_t*)(ws + WS_SGB))
#define YA ((bf16_t*)(ws + WS_YA))
#define VB ((bf16_t*)(ws + WS_VB))
#define H1B ((bf16_t*)(ws + WS_H1B))
#define Fb ((bf16_t*)(ws + WS_F))
#define PLEB ((bf16_t*)(ws + WS_R0))
#define PB ((bf16_t*)(ws + WS_PB))
    float* out = a.out;

    if (IN(0)) {
        LAS float* scr = (LAS float*)(lds + wave * 16640);
        const int gw = bx * NWAVES + wave, NGW = G * NWAVES;
        constexpr int I0 = 32 * 144;
        for (int it = gw; it < I0; it += NGW) tr_item(a.in[3], DM, NIN, a.in[2], Win, 1, it, scr, lane);
        for (int row = gw; row < SEQ; row += NGW) {
            const f32x4* xr = (const f32x4*)(a.in[0] + (size_t)row * DM) + lane; f32x4 v[8]; float s = 0.f;
#pragma unroll
            for (int j = 0; j < 8; ++j) { v[j] = xr[64 * j]; s += dot4(v[j]); }
            s = wave_sum(s);
            if (lane == 0) rstd1[row] = rsqrtf(s * (1.0f / DM) + EPS);
            u32x2* o = (u32x2*)(XB + (size_t)row * DM) + lane;
#pragma unroll
            for (int j = 0; j < 8; ++j) { u32x2 w; w.x = cvt_pk_bf16(v[j][0], v[j][1]); w.y = cvt_pk_bf16(v[j][2], v[j][3]); o[64 * j] = w; }
        }
        for (int c = gw; c < SEQ * PLE / 512; c += NGW) {
            const f32x4* pr = (const f32x4*)(a.in[1] + (size_t)c * 512) + 2 * lane; const f32x4 v0 = pr[0], v1 = pr[1];
            st_bf16x8(PB + (size_t)c * 512 + 8 * lane, v0, v1);
        }
        for (int i = bx * NTHR + tid; i < SEQ; i += G * NTHR) { ssq2[i] = 0.f; ssq3[i] = 0.f; ssq4[i] = 0.f; }
        if (bx == 0) { for (int i = tid; i < XCD_BAR_WORDS; i += NTHR) ((unsigned*)(ws + WS_BAR))[i] = 0u; if (tid < SEQ / 256) ((unsigned*)(ws + WS_CNT))[64 * tid] = 0u; }
        __syncthreads();
    }
    SEAM(0);
    if (IN(1)) {
        pg8::Gemm g{XB, Win, SEQ, NIN, DM}; pg8::StaticOrder S; S.init(SEQ, NIN, G, bx);
        EpiProj E{rstd1, a.in[6], Qb, ABb, Ub, SGA, SGB};
        pg8::gemm_phase<EpiProj, pg8::StaticOrder, true, true>(lds, g, S, E);
        const int rem = ((SEQ / 256) * (NIN / 256)) % G;
        if (rem == 0 || bx >= rem) {
            const int NS = rem ? G - rem : G, sb = rem ? bx - rem : bx;
            LAS float* scr = (LAS float*)(lds + wave * 16640);
            constexpr int I1 = 16 * 32, I2 = 16 * 32, I3 = 32 * 32, I4 = 32 * 88, I5 = 32 * 88, I8 = 4 * 32;
            for (int it = sb * NWAVES + wave; it < I1 + I2 + I3 + I4 + I5 + I8; it += NS * NWAVES) {
                int r = it;
                if (r < I8) { tr_item(a.in[20], PLE, DM, nullptr, Wpp, 0, r, scr, lane); continue; } r -= I8;
                if (r < I1) { tr_item(a.in[5], CW, DM, nullptr, Woa, 0, r, scr, lane); continue; } r -= I1;
                if (r < I2) { tr_item(a.in[11], CW, DM, nullptr, Wpw, 0, r, scr, lane); continue; } r -= I2;
                if (r < I3) { tr_item(a.in[13], DM, DM, nullptr, Wo, 0, r, scr, lane); continue; } r -= I3;
                if (r < I4) { tr_item(a.in[15], DM, DFF, a.in[14], Wgu, 2, r, scr, lane); continue; } r -= I4;
                tr_item(a.in[16], DM, DFF, a.in[14], Wgu, 3, r, scr, lane);
            }
            __syncthreads();
        }
    }
    SEAM(1);
    if (IN(2)) {
        const int c0 = 2 * tid;
        float wa0[3], wa1[3], wb0[31], wb1[31];
#pragma unroll
        for (int k = 0; k < 3; ++k) { const f32x2 w = *(const f32x2*)(a.in[4] + k * CW + c0); wa0[k] = w.x; wa1[k] = w.y; }
#pragma unroll
        for (int k = 0; k < 31; ++k) { const f32x2 w = *(const f32x2*)(a.in[7] + k * CW + c0); wb0[k] = w.x; wb1[k] = w.y; }
        const f32x2 cb = *(const f32x2*)(a.in[8] + c0), lg = *(const f32x2*)(a.in[9] + c0), lb = *(const f32x2*)(a.in[10] + c0);
        LAS float* P = (LAS float*)lds; LAS float* St = (LAS float*)(lds + 65536);
        for (int tile = bx; tile < SEQ / 16; tile += G) {
            const int t0 = tile * 16;
            {
                float q0[18], q1[18];
#pragma unroll
                for (int j = 0; j < 18; ++j) { const int ts = t0 - 2 + j; unsigned w = 0u; if (ts >= 0) w = *(const unsigned*)(Qb + (size_t)ts * CW + c0); q0[j] = bf_lo(w); q1[j] = bf_hi(w); }
#pragma unroll
                for (int i = 0; i < 16; ++i) { const unsigned w = *(const unsigned*)(ABb + (size_t)(t0 + i) * CW + c0);
                    const float y0 = bf_lo(w) * (wa0[0] * q0[i] + wa0[1] * q0[i + 1] + wa0[2] * q0[i + 2]);
                    const float y1 = bf_hi(w) * (wa1[0] * q1[i] + wa1[1] * q1[i + 1] + wa1[2] * q1[i + 2]);
                    *(unsigned*)(YA + (size_t)(t0 + i) * CW + c0) = cvt_pk_bf16(y0, y1); }
            }
            float acc0[16], acc1[16];
#pragma unroll
            for (int i = 0; i < 16; ++i) { acc0[i] = cb.x; acc1[i] = cb.y; }
#pragma unroll
            for (int s = 0; s < 46; ++s) { const int ts = t0 - 30 + s; unsigned w = 0u; if (ts >= 0) w = *(const unsigned*)(Ub + (size_t)ts * CW + c0);
                const float u0 = bf_lo(w), u1 = bf_hi(w);
#pragma unroll
                for (int i = 0; i < 16; ++i) { const int k = s - i; if (k >= 0 && k <= 30) { acc0[i] += wb0[k] * u0; acc1[i] += wb1[k] * u1; } } }
#pragma unroll
            for (int i = 0; i < 16; ++i) { P[(2 * i) * NTHR + tid] = acc0[i] + acc1[i]; P[(2 * i + 1) * NTHR + tid] = acc0[i] * acc0[i] + acc1[i] * acc1[i]; }
            __syncthreads();
#pragma unroll
            for (int r = 0; r < 4; ++r) { const int row = 4 * wave + r; float s = 0.f;
#pragma unroll
                for (int j = 0; j < 8; ++j) s += P[row * NTHR + lane + 64 * j];
                s = wave_sum(s); if (lane == 0) St[row] = s; }
            __syncthreads();
#pragma unroll
            for (int i = 0; i < 16; ++i) { const float mean = St[2 * i] * (1.0f / CW), var = St[2 * i + 1] * (1.0f / CW) - mean * mean, rs = rsqrtf(fmaxf(var, 0.f) + LN_EPS);
                const float v0 = (acc0[i] - mean) * rs * lg.x + lb.x, v1 = (acc1[i] - mean) * rs * lg.y + lb.y;
                *(unsigned*)(VB + (size_t)(t0 + i) * CW + c0) = cvt_pk_bf16(v0 * sigm(v0), v1 * sigm(v1)); }
        }
        __syncthreads();
    }
    SEAM(2);
    if (IN(3)) {
        pg8::StaticOrder S; S.init(SEQ, DM, G, bx);
        { pg8::Gemm g{YA, Woa, SEQ, DM, CW}; EpiM1 E{SGA, out}; pg8::gemm_phase<EpiM1, pg8::StaticOrder, true, true>(lds, g, S, E); }
        { pg8::Gemm g{VB, Wpw, SEQ, DM, CW}; EpiM E{SGB, out, a.in[12], MB}; pg8::gemm_phase<EpiM, pg8::StaticOrder, true, true>(lds, g, S, E); }
    }
    SEAM(3);
    if (IN(4)) {
        pg8::Gemm g{MB, Wo, SEQ, DM, DM}; pg8::StaticOrder S; S.init(SEQ, DM, G, bx);
        EpiRes<false, true> E{a.in[0], out, H1B, ssq2, nullptr, nullptr};
        pg8::gemm_phase<EpiRes<false, true>, pg8::StaticOrder, true, true>(lds, g, S, E);
    }
    SEAM(4);
    if (IN(5)) {
        pg8::Gemm g{H1B, Wgu, SEQ, 2 * DFF, DM}; pg8::StaticOrder S; S.init(SEQ, 2 * DFF, G, bx);
        EpiSwiglu E{ssq2, Fb};
        pg8::gemm_phase<EpiSwiglu, pg8::StaticOrder, true, true>(lds, g, S, E);
        const int rem = ((SEQ / 256) * (2 * DFF / 256)) % G;
        if (rem == 0 || bx >= rem) {
            const int NS = rem ? G - rem : G, sb = rem ? bx - rem : bx;
            { pg8::Gemm g2{PB, Wpp, SEQ, DM, PLE}; pg8::StaticOrder S2; S2.init(SEQ, DM, NS, sb); EpiPle E2{PLEB};
              pg8::gemm_phase<EpiPle, pg8::StaticOrder, true, true>(lds, g2, S2, E2); }
            LAS float* scr = (LAS float*)(lds + wave * 16640);
            constexpr int I6 = 88 * 32, I7 = 32 * 32;
            for (int it = sb * NWAVES + wave; it < I6 + I7; it += NS * NWAVES) {
                if (it < I6) tr_item(a.in[17], DFF, DM, nullptr, Wdn, 0, it, scr, lane);
                else tr_item(a.in[19], DM, DM, a.in[18], Wpg, 0, it - I6, scr, lane);
            }
            __syncthreads();
        }
    }
    SEAM(5);
    if (IN(6)) {
        pg8::Gemm g{Fb, Wdn, SEQ, DM, DFF}; pg8::StaticOrder S; S.init(SEQ, DM, G, bx);
        EpiRes<false, true> E{out, out, H2B, ssq3, nullptr, nullptr};
        pg8::gemm_phase<EpiRes<false, true>, pg8::StaticOrder, true, true>(lds, g, S, E);
    }
    SEAM(6);
    const bool fuse8 = FUSE_P8 && lo <= 7 && 8 < hi && G == (SEQ / 256) * (DM / 256);
    if (IN(7)) {
        pg8::StaticOrder S; S.init(SEQ, DM, G, bx); pg8::Gemm g{H2B, Wpg, SEQ, DM, DM};
        if (fuse8) { EpiFinal E{out, out, ssq4, ssq3, PLEB, a.in[21], (unsigned*)(ws + WS_CNT), (unsigned)(DM / 256)};
            pg8::gemm_phase<EpiFinal, pg8::StaticOrder, false, true>(lds, g, S, E); }
        else { EpiRes<true, false> E{out, out, nullptr, ssq4, ssq3, PLEB};
            pg8::gemm_phase<EpiRes<true, false>, pg8::StaticOrder, true, true>(lds, g, S, E); }
    }
    if (!fuse8) {
    SEAM(7);
    if (IN(8)) {
        const int gw = bx * NWAVES + wave, NGW = G * NWAVES;
        const f32x4* gf = (const f32x4*)a.in[21] + lane;
        for (int row = gw; row < SEQ; row += NGW) {
            f32x4* o = (f32x4*)(out + (size_t)row * DM) + lane; const float r = rsqrtf(ssq4[row] * (1.0f / DM) + EPS);
#pragma unroll
            for (int j = 0; j < 8; ++j) o[64 * j] = o[64 * j] * r * gf[64 * j];
        }
    }
    }
#undef IN
#undef SEAM
}

extern "C" void kernel_launch(void* const* d_in, const int* in_sizes, int n_in, void* d_out, int out_size, void* d_ws, size_t ws_size, hipStream_t stream) {
    static int grid = 0;
    if (grid == 0) {
        if (n_in != 22 || out_size != SEQ * DM || ws_size < WS_END) { fprintf(stderr, "kernel_launch: unexpected shapes (n_in %d, out %d, ws %zu)\n", n_in, out_size, ws_size); grid = -1; return; }
        int dev = 0, cus = 0, per_cu = 0;
        if (hipGetDevice(&dev) != hipSuccess || hipDeviceGetAttribute(&cus, hipDeviceAttributeMultiprocessorCount, dev) != hipSuccess) { grid = -1; return; }
        if (hipFuncSetAttribute((const void*)fwd_kernel, hipFuncAttributeMaxDynamicSharedMemorySize, LDS_BYTES) != hipSuccess) { fprintf(stderr, "kernel_launch: hipFuncSetAttribute failed\n"); grid = -1; return; }
        if (hipOccupancyMaxActiveBlocksPerMultiprocessor(&per_cu, (const void*)fwd_kernel, NTHR, LDS_BYTES) != hipSuccess || per_cu < 1) { fprintf(stderr, "kernel_launch: occupancy query says %d\n", per_cu); per_cu = 1; }
        (void)hipGetLastError();
        grid = cus;
    }
    if (grid < 0) return;
    Args a{};
    for (int i = 0; i < 22; ++i) a.in[i] = (const float*)d_in[i];
    a.out = (float*)d_out; a.ws = (unsigned char*)d_ws;
#if MK_LAUNCHES == 1
    a.ph_lo = 0; a.ph_hi = NPHASE; a.coop = 1;
    void* args[] = {&a};
    hipError_t e = hipLaunchCooperativeKernel((const void*)fwd_kernel, dim3(grid), dim3(NTHR), args, LDS_BYTES, stream);
    if (e != hipSuccess) fprintf(stderr, "kernel_launch: cooperative launch failed: %s (grid %d)\n", hipGetErrorString(e), grid);
#else
    for (int ph = 0; ph < NPHASE; ++ph) { a.ph_lo = ph; a.ph_hi = ph + 1; a.coop = 0; hipLaunchKernelGGL(fwd_kernel, dim3(grid), dim3(NTHR), LDS_BYTES, stream, a); }
#endif
}
```

```cpp
#include <hip/hip_runtime.h>
#include <hip/hip_cooperative_groups.h>
#include <cstdio>
#include <cstdint>
namespace cg = cooperative_groups;
namespace pg8 {
#define PG8_LAS __attribute__((address_space(3)))
typedef unsigned short bf16_t;
typedef short bf16x8 __attribute__((ext_vector_type(8)));
typedef float f32x4 __attribute__((ext_vector_type(4)));
typedef unsigned u32x4 __attribute__((ext_vector_type(4)));
constexpr int BM = 256, BK = 64, HALF = 128, HTB = HALF * BK * 2  , STAGE_BYTES = 8 * HTB, NXCD = 8, WGM = 8;

__host__ __device__ __forceinline__ int lds_byte(int r, int c) { const int st = (r >> 4) * 2 + (c >> 5), rr = r & 15, cc = c & 31, ob = rr * 64 + cc * 2; return st * 1024 + (ob ^ (((ob >> 9) & 1) << 5)); }
__host__ __device__ __forceinline__ void stage_rc(int b, int& R, int& C) { const int st = b / 1024, sb = b % 1024, swz = sb ^ (((sb >> 9) & 1) << 5); R = (st >> 1) * 16 + swz / 64; C = (st & 1) * 32 + (swz % 64) / 2; }
__host__ __device__ __forceinline__ int perm32(int rho) { const int n = rho >> 4, i = rho & 15; return 8 * (i >> 2) + 4 * n + (i & 3); }

struct Unit { int pm, pn; };
struct Gemm { const bf16_t* A; const bf16_t* Bt; int M, N, K; };

struct StaticOrder {
    int nM, nN, nwg, G, c;
    __host__ __device__ void init(int M, int N, int G_, int c_) { nM = M / BM; nN = N / BM; nwg = nM * nN; G = G_; c = c_; }
    __host__ __device__ bool next(int i, Unit& u) const {
        const long L = (long)i * G + c; if (L >= nwg) return false;
        int wgid = (int)L; { const int q = nwg / NXCD, r = nwg % NXCD, xcd = wgid % NXCD, off = wgid / NXCD; wgid = (xcd < r ? xcd * (q + 1) : r * (q + 1) + (xcd - r) * q) + off; }
        const int nig = WGM * nN, gid = wgid / nig, fm = gid * WGM, gsz = (nM - fm) < WGM ? (nM - fm) : WGM;
        u.pm = fm + ((wgid % nig) % gsz); u.pn = (wgid % nig) / gsz; return true;
    }
    __device__ __forceinline__ void a_ready(const Unit&) const {}
    __device__ __forceinline__ void done(const Unit&) const {}
};

__device__ __forceinline__ unsigned cvt_pk_bf16(float lo, float hi) { unsigned r; asm volatile("v_cvt_pk_bf16_f32 %0, %1, %2" : "=v"(r) : "v"(lo), "v"(hi)); return r; }
typedef float f32x2 __attribute__((ext_vector_type(2)));
template <class Epi, class Sched, bool ALIGN_EPI = false, bool SP2 = false>
__device__ __forceinline__ void gemm_phase(PG8_LAS unsigned char* lds, const Gemm g, const Sched& S, const Epi& E) {
    const int tid = threadIdx.x, wid = __builtin_amdgcn_readfirstlane(tid >> 6), lane = tid & 63, wr = wid >> 2, wc = wid & 3, fr = lane & 15, fq = lane >> 4;
    const int K = g.K, nt = K / BK;
    unsigned voffA[2], voffB[2];
#pragma unroll
    for (int i = 0; i < 2; ++i) { int R, C; stage_rc(tid * 16 + i * 8192, R, C); const int Rb = Epi::PERM ? ((R & ~31) + perm32(R & 31)) : R;
        voffA[i] = (unsigned)(R * K + C) * 2u; voffB[i] = (unsigned)(Rb * K + C) * 2u; }
    const size_t kstep = (size_t)(BK * 2);
    const size_t hstep = (size_t)HALF * K * 2;
    const size_t tstep = 2 * hstep;
    const unsigned ldsw = (unsigned)wid * 1024u;
    const int aoff = lds_byte(wr * 64 + fr, fq * 8), boff = lds_byte(wc * 32 + fr, fq * 8);
#define PG8_SA(b, h) (((b) * 2 + (h)) * HTB)
#define PG8_SB(b, h) ((4 + (b) * 2 + (h)) * HTB)
#define PG8_STAGE(bufoff, gbase, voff) do { _Pragma("unroll") for (int _i = 0; _i < 2; ++_i) \
        __builtin_amdgcn_global_load_lds((const unsigned*)((const char*)(gbase) + (voff)[_i]), (PG8_LAS unsigned*)(lds + (bufoff) + ldsw + _i * 8192), 16, 0, 0); } while (0)
#define PG8_LDA(dst, b, h) do { _Pragma("unroll") for (int m = 0; m < 4; ++m) _Pragma("unroll") for (int k = 0; k < 2; ++k) dst[m][k] = *(const PG8_LAS bf16x8*)(lds + PG8_SA(b, h) + aoff + m * 2048 + k * 1024); } while (0)
#define PG8_LDB(dst, b, h) do { _Pragma("unroll") for (int n = 0; n < 2; ++n) _Pragma("unroll") for (int k = 0; k < 2; ++k) dst[n][k] = *(const PG8_LAS bf16x8*)(lds + PG8_SB(b, h) + boff + n * 2048 + k * 1024); } while (0)
#define PG8_MMA(ai, bj, At, Bt) do { __builtin_amdgcn_s_setprio(1); _Pragma("unroll") for (int m = 0; m < 4; ++m) _Pragma("unroll") for (int n = 0; n < 2; ++n) _Pragma("unroll") for (int k = 0; k < 2; ++k) \
        acc[ai][bj][m][n] = __builtin_amdgcn_mfma_f32_16x16x32_bf16(Bt[n][k], At[m][k], acc[ai][bj][m][n], 0, 0, 0); __builtin_amdgcn_s_setprio(0); } while (0)
#define PG8_WAIT_V(n) asm volatile("s_waitcnt vmcnt(" #n ")" ::: "memory")
#define PG8_WAIT_L(n) asm volatile("s_waitcnt lgkmcnt(" #n ")" ::: "memory")
#define PG8_BAR __builtin_amdgcn_s_barrier()
#define PG8_SCHED __builtin_amdgcn_sched_barrier(0)
    Unit cur, nxt; int ui = 0;
    if (!S.next(0, cur)) return;
    f32x4 acc[2][2][4][2];
#pragma unroll
    for (int a = 0; a < 2; ++a)
#pragma unroll
        for (int b = 0; b < 2; ++b)
#pragma unroll
            for (int m = 0; m < 4; ++m)
#pragma unroll
                for (int n = 0; n < 2; ++n) acc[a][b][m][n] = (f32x4){0.f, 0.f, 0.f, 0.f};
    bf16x8 At[4][2], B0[2][2], B1[2][2];
    const char* cA = (const char*)g.A + (size_t)cur.pm * tstep; const char* cB = (const char*)g.Bt + (size_t)cur.pn * tstep;
    S.a_ready(cur);
    if constexpr (SP2) {
        PG8_STAGE(PG8_SB(0, 0), cB, voffB); PG8_STAGE(PG8_SB(0, 1), cB + hstep, voffB); PG8_STAGE(PG8_SA(0, 0), cA, voffA); PG8_STAGE(PG8_SA(0, 1), cA + hstep, voffA);
        if (wr == 1) PG8_BAR;
        PG8_WAIT_V(2); PG8_BAR;
        PG8_STAGE(PG8_SB(1, 0), cB + kstep, voffB); PG8_STAGE(PG8_SA(1, 0), cA + kstep, voffA); PG8_STAGE(PG8_SB(1, 1), cB + hstep + kstep, voffB);
        PG8_WAIT_V(6); PG8_BAR;
    } else {
        PG8_STAGE(PG8_SB(0, 0), cB, voffB); PG8_STAGE(PG8_SA(0, 0), cA, voffA); PG8_STAGE(PG8_SB(0, 1), cB + hstep, voffB); PG8_STAGE(PG8_SA(0, 1), cA + hstep, voffA);
        if (wr == 1) PG8_BAR;
        PG8_WAIT_V(4); PG8_BAR;
        PG8_STAGE(PG8_SB(1, 0), cB + kstep, voffB); PG8_STAGE(PG8_SA(1, 0), cA + kstep, voffA); PG8_STAGE(PG8_SB(1, 1), cB + hstep + kstep, voffB);
        PG8_WAIT_V(6); PG8_BAR;
    }
    for (;;) {
        const bool has_next = S.next(ui + 1, nxt);
        const char* nA = has_next ? (const char*)g.A + (size_t)nxt.pm * tstep : cA; const char* nB = has_next ? (const char*)g.Bt + (size_t)nxt.pn * tstep : cB;
#pragma unroll 1
        for (int t = 0; t < nt; t += 2) {
            const bool last = (t == nt - 2);
            const char* a1 = cA + (size_t)(t + 1) * kstep;
            const char* a2 = last ? nA : cA + (size_t)(t + 2) * kstep; const char* b2 = last ? nB : cB + (size_t)(t + 2) * kstep;
            const char* a3 = a2 + kstep; const char* b3 = b2 + kstep;
            if (last && has_next) S.a_ready(nxt);
            if constexpr (SP2) {
            PG8_LDB(B0, 0, 0); PG8_LDB(B1, 0, 1); PG8_SCHED; PG8_LDA(At, 0, 0); PG8_STAGE(PG8_SA(1, 1), a1 + hstep, voffA);
            PG8_WAIT_V(8); PG8_WAIT_L(0); PG8_BAR; PG8_MMA(0, 0, At, B0); PG8_MMA(0, 1, At, B1); PG8_BAR; PG8_SCHED;
            PG8_LDA(At, 0, 1); PG8_STAGE(PG8_SB(0, 0), b2, voffB); PG8_STAGE(PG8_SB(0, 1), b2 + hstep, voffB); PG8_STAGE(PG8_SA(0, 0), a2, voffA);
            PG8_WAIT_V(8); PG8_WAIT_L(0); PG8_BAR; PG8_MMA(1, 0, At, B0); PG8_MMA(1, 1, At, B1); PG8_BAR; PG8_SCHED;
            PG8_LDB(B0, 1, 0); PG8_LDB(B1, 1, 1); PG8_SCHED; PG8_LDA(At, 1, 0); PG8_STAGE(PG8_SA(0, 1), a2 + hstep, voffA);
            PG8_WAIT_V(8); PG8_WAIT_L(0); PG8_BAR; PG8_MMA(0, 0, At, B0); PG8_MMA(0, 1, At, B1); PG8_BAR; PG8_SCHED;
            PG8_LDA(At, 1, 1); PG8_STAGE(PG8_SB(1, 0), b3, voffB); PG8_STAGE(PG8_SB(1, 1), b3 + hstep, voffB); PG8_STAGE(PG8_SA(1, 0), a3, voffA);
            PG8_WAIT_V(8); PG8_WAIT_L(0); PG8_BAR; PG8_MMA(1, 0, At, B0); PG8_MMA(1, 1, At, B1); PG8_BAR; PG8_SCHED;
            } else {
            PG8_LDB(B0, 0, 0); PG8_SCHED; PG8_LDA(At, 0, 0); PG8_STAGE(PG8_SA(1, 1), a1 + hstep, voffA);
            PG8_WAIT_L(8); PG8_BAR; PG8_WAIT_L(0); PG8_MMA(0, 0, At, B0); PG8_BAR; PG8_SCHED;
            PG8_LDB(B1, 0, 1); PG8_STAGE(PG8_SB(0, 0), b2, voffB);
            PG8_BAR; PG8_WAIT_L(0); PG8_MMA(0, 1, At, B1); PG8_BAR;
            PG8_LDA(At, 0, 1); PG8_STAGE(PG8_SA(0, 0), a2, voffA);
            PG8_BAR; PG8_WAIT_L(0); PG8_MMA(1, 0, At, B0); PG8_BAR; PG8_SCHED;
            PG8_STAGE(PG8_SB(0, 1), b2 + hstep, voffB);
            PG8_WAIT_V(6); PG8_BAR; PG8_MMA(1, 1, At, B1); PG8_BAR;
            PG8_LDB(B0, 1, 0); PG8_SCHED; PG8_LDA(At, 1, 0); PG8_STAGE(PG8_SA(0, 1), a2 + hstep, voffA);
            PG8_WAIT_L(8); PG8_BAR; PG8_WAIT_L(0); PG8_MMA(0, 0, At, B0); PG8_BAR; PG8_SCHED;
            PG8_LDB(B1, 1, 1); PG8_STAGE(PG8_SB(1, 0), b3, voffB);
            PG8_BAR; PG8_WAIT_L(0); PG8_MMA(0, 1, At, B1); PG8_BAR;
            PG8_LDA(At, 1, 1); PG8_STAGE(PG8_SA(1, 0), a3, voffA);
            PG8_BAR; PG8_WAIT_L(0); PG8_MMA(1, 0, At, B0); PG8_BAR; PG8_SCHED;
            PG8_STAGE(PG8_SB(1, 1), b3 + hstep, voffB);
            PG8_WAIT_V(6); PG8_BAR; PG8_MMA(1, 1, At, B1); PG8_BAR;
            }
        }
        if constexpr (ALIGN_EPI) { if (wr == 0) PG8_BAR; }
        if constexpr (!Epi::AFTER_DRAIN) { E(acc, cur, wr, wc, fr, fq); S.done(cur); }
        if (!has_next) break;
#pragma unroll
        for (int a = 0; a < 2; ++a)
#pragma unroll
            for (int b = 0; b < 2; ++b)
#pragma unroll
                for (int m = 0; m < 4; ++m)
#pragma unroll
                    for (int n = 0; n < 2; ++n) acc[a][b][m][n] = (f32x4){0.f, 0.f, 0.f, 0.f};
        cur = nxt; cA = nA; cB = nB; ++ui;
        if constexpr (ALIGN_EPI) { if (wr == 1) PG8_BAR; }
    }
    PG8_WAIT_V(0);
    if constexpr (!ALIGN_EPI) { if (wr == 0) PG8_BAR; }
    PG8_BAR;
    if constexpr (Epi::AFTER_DRAIN) { E.fused(acc, cur, wr, wc, fr, fq, lds, wid, lane); S.done(cur); }
#undef PG8_SA
#undef PG8_SB
#undef PG8_STAGE
#undef PG8_LDA
#undef PG8_LDB
#undef PG8_MMA
#undef PG8_WAIT_V
#undef PG8_WAIT_L
#undef PG8_BAR
#undef PG8_SCHED
}
}

#define LAS __attribute__((address_space(3)))
using pg8::bf16_t; using pg8::f32x4; using pg8::u32x4; using pg8::Unit; using pg8::cvt_pk_bf16;
typedef unsigned u32x2 __attribute__((ext_vector_type(2)));
typedef float f32x2 __attribute__((ext_vector_type(2)));

#ifndef MK_LAUNCHES
#define MK_LAUNCHES 1
#endif
constexpr int SEQ = 8192, DM = 2048, CW = 1024, NIN = 9216, DFF = 5632, PLE = 256;
constexpr float EPS = 1e-6f, LN_EPS = 1e-5f;
constexpr int NWAVES = 8, NTHR = 512, NPHASE = 9;
constexpr int LDS_BYTES = 147456;
constexpr size_t MiB = 1u << 20;
constexpr size_t WS_RSTD1 = 0, WS_SSQ2 = 64 * 1024, WS_SSQ3 = 128 * 1024, WS_SSQ4 = 192 * 1024;
constexpr size_t WS_BAR = 256 * 1024, WS_CNT = 272 * 1024, WS_CTL_END = 280 * 1024;
constexpr int MISC_OFF = 143360;
constexpr size_t WS_WIN = 2 * MiB, WS_WOA = 38 * MiB, WS_WPW = 42 * MiB, WS_WO = 46 * MiB, WS_WGU = 54 * MiB, WS_WDN = 98 * MiB, WS_WPG = 120 * MiB, WS_WPP = 128 * MiB;
constexpr size_t WS_R0 = 130 * MiB;
constexpr size_t WS_Q = 162 * MiB, WS_AB = 178 * MiB, WS_U = 194 * MiB;
constexpr size_t WS_SGA = 210 * MiB, WS_SGB = 242 * MiB;
constexpr size_t WS_YA = 274 * MiB, WS_VB = 290 * MiB;
constexpr size_t WS_H1B = 162 * MiB;
constexpr size_t WS_F = 194 * MiB;
constexpr size_t WS_PB = 306 * MiB;
constexpr size_t WS_END = 310 * MiB;

__device__ __forceinline__ float sigm(float x) { return __builtin_amdgcn_rcpf(1.f + __expf(-x)); }
__device__ __forceinline__ f32x4 sig4(f32x4 v) { return (f32x4){sigm(v[0]), sigm(v[1]), sigm(v[2]), sigm(v[3])}; }
__device__ __forceinline__ float bf_lo(unsigned w) { return __uint_as_float(w << 16); }
__device__ __forceinline__ float bf_hi(unsigned w) { return __uint_as_float(w & 0xffff0000u); }
__device__ __forceinline__ void st_bf16x8(bf16_t* p, f32x4 v0, f32x4 v1) {
    u32x4 w; w.x = cvt_pk_bf16(v0[0], v0[1]); w.y = cvt_pk_bf16(v0[2], v0[3]); w.z = cvt_pk_bf16(v1[0], v1[1]); w.w = cvt_pk_bf16(v1[2], v1[3]); *(u32x4*)p = w; }
__device__ __forceinline__ void ld_bf16x8(const bf16_t* p, f32x4& v0, f32x4& v1) {
    const u32x4 w = *(const u32x4*)p; v0 = (f32x4){bf_lo(w.x), bf_hi(w.x), bf_lo(w.y), bf_hi(w.y)}; v1 = (f32x4){bf_lo(w.z), bf_hi(w.z), bf_lo(w.w), bf_hi(w.w)}; }
__device__ __forceinline__ float dot4(f32x4 a) { return (a[0] * a[0] + a[1] * a[1]) + (a[2] * a[2] + a[3] * a[3]); }
__device__ __forceinline__ float wave_sum(float v) {
#pragma unroll
    for (int o = 1; o < 64; o <<= 1) v += __shfl_xor(v, o);
    return v;
}

struct EpiProj {
    static constexpr bool PERM = true, AFTER_DRAIN = false;
    const float* rstd; const float* bglu; bf16_t *Qo, *ABo, *Uo, *SA, *SB;
    __device__ __forceinline__ void operator()(const f32x4 (&acc)[2][2][4][2], const Unit& u, int wr, int wc, int fr, int fq) const {
        const int pn = u.pn, row0 = u.pm * 256 + wr * 64 + fr, cl = wc * 32 + 8 * fq;
        if (pn < 8) {
#pragma unroll
            for (int ai = 0; ai < 2; ++ai)
#pragma unroll
                for (int m = 0; m < 4; ++m) { const int row = row0 + ai * 128 + m * 16; const float r = rstd[row], r2 = r * r;
                    st_bf16x8(Qo + (size_t)row * CW + pn * 128 + cl, acc[ai][0][m][0] * acc[ai][1][m][0] * r2, acc[ai][0][m][1] * acc[ai][1][m][1] * r2); }
        } else if (pn < 12) {
#pragma unroll
            for (int ai = 0; ai < 2; ++ai)
#pragma unroll
                for (int m = 0; m < 4; ++m) { const int row = row0 + ai * 128 + m * 16; const float r = rstd[row];
#pragma unroll
                    for (int bj = 0; bj < 2; ++bj) st_bf16x8(ABo + (size_t)row * CW + (pn - 8) * 256 + bj * 128 + cl, acc[ai][bj][m][0] * r, acc[ai][bj][m][1] * r); }
        } else if (pn < 20) {
            const int ch = (pn - 12) * 128 + cl;
            const f32x4 bv0 = *(const f32x4*)(bglu + ch), bv1 = *(const f32x4*)(bglu + ch + 4), bg0 = *(const f32x4*)(bglu + CW + ch), bg1 = *(const f32x4*)(bglu + CW + ch + 4);
#pragma unroll
            for (int ai = 0; ai < 2; ++ai)
#pragma unroll
                for (int m = 0; m < 4; ++m) { const int row = row0 + ai * 128 + m * 16; const float r = rstd[row];
                    const f32x4 v0 = acc[ai][0][m][0] * r + bv0, v1 = acc[ai][0][m][1] * r + bv1, g0 = acc[ai][1][m][0] * r + bg0, g1 = acc[ai][1][m][1] * r + bg1;
                    st_bf16x8(Uo + (size_t)row * CW + ch, v0 * sig4(g0), v1 * sig4(g1)); }
        } else {
            bf16_t* S = pn < 28 ? SA : SB; const int cb = ((pn - 20) & 7) * 256 + cl;
#pragma unroll
            for (int ai = 0; ai < 2; ++ai)
#pragma unroll
                for (int m = 0; m < 4; ++m) { const int row = row0 + ai * 128 + m * 16; const float r = rstd[row];
#pragma unroll
                    for (int bj = 0; bj < 2; ++bj) st_bf16x8(S + (size_t)row * DM + cb + bj * 128, sig4(acc[ai][bj][m][0] * r), sig4(acc[ai][bj][m][1] * r)); }
        }
    }
};
struct EpiM1 {
    static constexpr bool PERM = true, AFTER_DRAIN = false;
    const bf16_t* SG; float* M1;
    __device__ __forceinline__ void operator()(const f32x4 (&acc)[2][2][4][2], const Unit& u, int wr, int wc, int fr, int fq) const {
        const int row0 = u.pm * 256 + wr * 64 + fr, c0 = u.pn * 256 + wc * 32 + 8 * fq;
#pragma unroll
        for (int ai = 0; ai < 2; ++ai)
#pragma unroll
            for (int m = 0; m < 4; ++m)
#pragma unroll
                for (int bj = 0; bj < 2; ++bj) { const size_t off = (size_t)(row0 + ai * 128 + m * 16) * DM + c0 + bj * 128; f32x4 g0, g1; ld_bf16x8(SG + off, g0, g1);
                    *(f32x4*)(M1 + off) = g0 * acc[ai][bj][m][0]; *(f32x4*)(M1 + off + 4) = g1 * acc[ai][bj][m][1]; }
    }
};
struct EpiM {
    static constexpr bool PERM = true, AFTER_DRAIN = false;
    const bf16_t* SG; const float* M1; const float* bias; bf16_t* Mo;
    __device__ __forceinline__ void operator()(const f32x4 (&acc)[2][2][4][2], const Unit& u, int wr, int wc, int fr, int fq) const {
        const int row0 = u.pm * 256 + wr * 64 + fr, c0 = u.pn * 256 + wc * 32 + 8 * fq;
        f32x4 bv[2][2];
#pragma unroll
        for (int bj = 0; bj < 2; ++bj) { bv[bj][0] = *(const f32x4*)(bias + c0 + bj * 128); bv[bj][1] = *(const f32x4*)(bias + c0 + bj * 128 + 4); }
#pragma unroll
        for (int ai = 0; ai < 2; ++ai)
#pragma unroll
            for (int m = 0; m < 4; ++m)
#pragma unroll
                for (int bj = 0; bj < 2; ++bj) { const size_t off = (size_t)(row0 + ai * 128 + m * 16) * DM + c0 + bj * 128; f32x4 g0, g1; ld_bf16x8(SG + off, g0, g1);
                    const f32x4 a0 = *(const f32x4*)(M1 + off), a1 = *(const f32x4*)(M1 + off + 4);
                    st_bf16x8(Mo + off, a0 + g0 * (acc[ai][bj][m][0] + bv[bj][0]), a1 + g1 * (acc[ai][bj][m][1] + bv[bj][1])); }
    }
};
template <bool GATED, bool WB16> struct EpiRes {
    static constexpr bool PERM = true, AFTER_DRAIN = false;
    const float* base; float* out; bf16_t* ob; float* ssq_out; const float* ssq_in; const bf16_t* ple;
    __device__ __forceinline__ void operator()(const f32x4 (&acc)[2][2][4][2], const Unit& u, int wr, int wc, int fr, int fq) const {
        const int row0 = u.pm * 256 + wr * 64 + fr, c0 = u.pn * 256 + wc * 32 + 8 * fq;
#pragma unroll
        for (int ai = 0; ai < 2; ++ai)
#pragma unroll
            for (int m = 0; m < 4; ++m) { const int row = row0 + ai * 128 + m * 16; float r = 0.f; if (GATED) r = rsqrtf(ssq_in[row] * (1.0f / DM) + EPS);
                float s = 0.f;
#pragma unroll
                for (int bj = 0; bj < 2; ++bj) { const size_t off = (size_t)row * DM + c0 + bj * 128;
                    const f32x4 b0 = *(const f32x4*)(base + off), b1 = *(const f32x4*)(base + off + 4);
                    f32x4 v0 = acc[ai][bj][m][0], v1 = acc[ai][bj][m][1];
                    if (GATED) { f32x4 p0, p1; ld_bf16x8(ple + off, p0, p1); v0 = sig4(v0 * r) * p0; v1 = sig4(v1 * r) * p1; }
                    const f32x4 h0 = b0 + v0, h1 = b1 + v1;
                    *(f32x4*)(out + off) = h0; *(f32x4*)(out + off + 4) = h1;
                    if (WB16) st_bf16x8(ob + off, h0, h1);
                    s += dot4(h0) + dot4(h1); }
                s += __shfl_xor(s, 16); s += __shfl_xor(s, 32);
                if (fq == 0) unsafeAtomicAdd(ssq_out + row, s);
                if (GATED ? (m & 1) : (m == 3)) asm volatile("" ::: "memory"); }
    }
};
struct EpiSwiglu {
    static constexpr bool PERM = true, AFTER_DRAIN = false;
    const float* ssq_in; bf16_t* F;
    __device__ __forceinline__ void operator()(const f32x4 (&acc)[2][2][4][2], const Unit& u, int wr, int wc, int fr, int fq) const {
        const int row0 = u.pm * 256 + wr * 64 + fr, ch = u.pn * 128 + wc * 32 + 8 * fq;
#pragma unroll
        for (int ai = 0; ai < 2; ++ai)
#pragma unroll
            for (int m = 0; m < 4; ++m) { const int row = row0 + ai * 128 + m * 16; const float r = rsqrtf(ssq_in[row] * (1.0f / DM) + EPS);
                const f32x4 g0 = acc[ai][0][m][0] * r, g1 = acc[ai][0][m][1] * r, u0 = acc[ai][1][m][0] * r, u1 = acc[ai][1][m][1] * r;
                st_bf16x8(F + (size_t)row * DFF + ch, g0 * sig4(g0) * u0, g1 * sig4(g1) * u1); }
    }
};
struct EpiPle {
    static constexpr bool PERM = true, AFTER_DRAIN = false;
    bf16_t* O;
    __device__ __forceinline__ void operator()(const f32x4 (&acc)[2][2][4][2], const Unit& u, int wr, int wc, int fr, int fq) const {
        const int row0 = u.pm * 256 + wr * 64 + fr, c0 = u.pn * 256 + wc * 32 + 8 * fq;
#pragma unroll
        for (int ai = 0; ai < 2; ++ai)
#pragma unroll
            for (int m = 0; m < 4; ++m)
#pragma unroll
                for (int bj = 0; bj < 2; ++bj) st_bf16x8(O + (size_t)(row0 + ai * 128 + m * 16) * DM + c0 + bj * 128, acc[ai][bj][m][0], acc[ai][bj][m][1]);
    }
};

struct EpiFinal {
    static constexpr bool PERM = true, AFTER_DRAIN = true;
    const float* base; float* out; float* ssq_out; const float* ssq_in; const bf16_t* ple; const float* gfin; unsigned* cnt; unsigned want;
    __device__ __forceinline__ void fused(f32x4 (&acc)[2][2][4][2], const Unit& u, int wr, int wc, int fr, int fq, PG8_LAS unsigned char* lds, int wid, int lane) const {
        const int row0 = u.pm * 256 + wr * 64 + fr, c0 = u.pn * 256 + wc * 32 + 8 * fq;
#pragma unroll
        for (int ai = 0; ai < 2; ++ai)
#pragma unroll
            for (int m = 0; m < 4; ++m) { const int row = row0 + ai * 128 + m * 16; const float r = rsqrtf(ssq_in[row] * (1.0f / DM) + EPS);
                float s = 0.f;
#pragma unroll
                for (int bj = 0; bj < 2; ++bj) { const size_t off = (size_t)row * DM + c0 + bj * 128;
                    const f32x4 b0 = *(const f32x4*)(base + off), b1 = *(const f32x4*)(base + off + 4);
                    f32x4 p0, p1; ld_bf16x8(ple + off, p0, p1);
                    const f32x4 h0 = b0 + sig4(acc[ai][bj][m][0] * r) * p0, h1 = b1 + sig4(acc[ai][bj][m][1] * r) * p1;
                    acc[ai][bj][m][0] = h0; acc[ai][bj][m][1] = h1;
                    s += dot4(h0) + dot4(h1); }
                s += __shfl_xor(s, 16); s += __shfl_xor(s, 32);
                if (fq == 0) unsafeAtomicAdd(ssq_out + row, s);
                if (m & 1) asm volatile("" ::: "memory"); }
        asm volatile("s_waitcnt vmcnt(0)" ::: "memory");
        __syncthreads();
        if (threadIdx.x == 0) { unsigned* c = cnt + 64 * u.pm;
            __hip_atomic_fetch_add(c, 1u, __ATOMIC_RELAXED, __HIP_MEMORY_SCOPE_AGENT);
            while (__hip_atomic_load(c, __ATOMIC_RELAXED, __HIP_MEMORY_SCOPE_AGENT) < want) __builtin_amdgcn_s_sleep(2); }
        __syncthreads();
        f32x4 gv[2][2];
#pragma unroll
        for (int bj = 0; bj < 2; ++bj) { gv[bj][0] = *(const f32x4*)(gfin + c0 + bj * 128); gv[bj][1] = *(const f32x4*)(gfin + c0 + bj * 128 + 4); }
#pragma unroll
        for (int ai = 0; ai < 2; ++ai)
#pragma unroll
            for (int m = 0; m < 4; ++m) { const int row = row0 + ai * 128 + m * 16;
                const float rr = rsqrtf(__hip_atomic_load(ssq_out + row, __ATOMIC_RELAXED, __HIP_MEMORY_SCOPE_AGENT) * (1.0f / DM) + EPS);
#pragma unroll
                for (int bj = 0; bj < 2; ++bj) { const size_t off = (size_t)row * DM + c0 + bj * 128;
                    *(f32x4*)(out + off) = acc[ai][bj][m][0] * rr * gv[bj][0]; *(f32x4*)(out + off + 4) = acc[ai][bj][m][1] * rr * gv[bj][1]; } }
    }
};

__device__ __forceinline__ int win_dest(int n0) {
    if (n0 < 1024) return 256 * (n0 >> 7) + (n0 & 127);
    if (n0 < 2048) return 2048 + (n0 - 1024);
    if (n0 < 3072) { const int c = n0 - 2048; return 256 * (c >> 7) + 128 + (c & 127); }
    if (n0 < 4096) { const int c = n0 - 3072; return 3072 + 256 * (c >> 7) + (c & 127); }
    if (n0 < 5120) { const int c = n0 - 4096; return 3072 + 256 * (c >> 7) + 128 + (c & 127); }
    return n0;
}
__device__ __forceinline__ void tr_item(const float* W, int K, int N, const float* g, bf16_t* WT, int mode, int item, LAS float* scr, int lane) {
    const int nblk = N >> 6, kb = item / nblk, nb = item - kb * nblk, k0 = kb << 6, n0 = nb << 6;
    int d0 = n0;
    if (mode == 1) d0 = win_dest(n0); else if (mode == 2) d0 = 256 * (n0 >> 7) + (n0 & 127); else if (mode == 3) d0 = 256 * (n0 >> 7) + 128 + (n0 & 127);
    const int kr = lane >> 4, col = 4 * (lane & 15);
    f32x4 v[16];
#pragma unroll
    for (int i = 0; i < 16; ++i) v[i] = *(const f32x4*)(W + (size_t)(k0 + 4 * i + kr) * N + n0 + col);
    if (g) {
#pragma unroll
        for (int i = 0; i < 16; ++i) v[i] = v[i] * g[k0 + 4 * i + kr];
    }
#pragma unroll
    for (int i = 0; i < 16; ++i) { LAS float* s = scr + (4 * i + kr) * 65 + col; s[0] = v[i][0]; s[1] = v[i][1]; s[2] = v[i][2]; s[3] = v[i][3]; }
    asm volatile("s_waitcnt lgkmcnt(0)" ::: "memory");
    const int c = lane & 7;
#pragma unroll
    for (int j = 0; j < 8; ++j) { const int n = (lane >> 3) + 8 * j; const LAS float* s = scr + (8 * c) * 65 + n;
        u32x4 o; o.x = cvt_pk_bf16(s[0], s[65]); o.y = cvt_pk_bf16(s[2 * 65], s[3 * 65]); o.z = cvt_pk_bf16(s[4 * 65], s[5 * 65]); o.w = cvt_pk_bf16(s[6 * 65], s[7 * 65]);
        *(u32x4*)(WT + (size_t)(d0 + n) * K + k0 + 8 * c) = o; }
    asm volatile("s_waitcnt lgkmcnt(0)" ::: "memory");
}

#ifndef USE_XCDBAR
#define USE_XCDBAR 1
#endif
#ifndef FUSE_P8
#define FUSE_P8 1
#endif
#define XB_TMO      128
#define XB_XCNT(j)  (256  + 64 * (j))
#define XB_XSUB(j)  (1280 + 64 * (j))
#define XB_XGEN(j)  (2304 + 64 * (j))
#define XB_TOP      3328
#define XB_TOPGEN   3392
#define XCD_BAR_WORDS 3456
#define XB_SPIN_CAP (1u << 18)

__device__ __forceinline__ unsigned xb_ld(unsigned* p)              { return __hip_atomic_load(p, __ATOMIC_RELAXED, __HIP_MEMORY_SCOPE_AGENT); }
__device__ __forceinline__ unsigned xb_add(unsigned* p, unsigned v) { return __hip_atomic_fetch_add(p, v, __ATOMIC_RELAXED, __HIP_MEMORY_SCOPE_AGENT); }
__device__ __forceinline__ unsigned xb_xcc_id() { return (unsigned)__builtin_amdgcn_s_getreg((3 << 11) | 20) & 0xFu; }
#define XB_SPIN(cond, bar) do { unsigned _sp = 0; while (cond) { __builtin_amdgcn_s_sleep(1); \
    if ((++_sp & 255u) == 0u) { if (xb_ld(&(bar)[XB_TMO])) break; if (_sp > XB_SPIN_CAP) { atomicAdd(&(bar)[XB_TMO], 1u); break; } } } } while (0)

struct XcdBarrier {
    unsigned* bar; unsigned x;
    volatile LAS unsigned* st;
};

__device__ __forceinline__ XcdBarrier xcd_barrier_post(unsigned* bar, volatile LAS unsigned* st) {
    XcdBarrier b; b.bar = bar; b.x = xb_xcc_id(); b.st = st;
    if (threadIdx.x == 0) (void)xb_add(&bar[XB_XCNT(b.x)], 1u);
    return b;
}
__device__ __forceinline__ void xcd_barrier_complete(unsigned* bar, unsigned x, unsigned& nloc, unsigned& nx) {
    const unsigned G = gridDim.x * gridDim.y * gridDim.z;
    unsigned sum, cnt, mine, sp = 0u;
    for (;;) {
        sum = 0u; cnt = 0u; mine = 0u;
#pragma unroll
        for (unsigned j = 0; j < 16; ++j) { const unsigned c = xb_ld(&bar[XB_XCNT(j)]); sum += c; cnt += (c > 0u) ? 1u : 0u; mine = (j == x) ? c : mine; }
        if (sum == G) break;
        __builtin_amdgcn_s_sleep(1);
        if ((++sp & 255u) == 0u) { if (xb_ld(&bar[XB_TMO])) break; if (sp > XB_SPIN_CAP) { atomicAdd(&bar[XB_TMO], 1u); break; } }
    }
    nloc = mine > 0u ? mine : 1u; nx = cnt > 0u ? cnt : 1u;
}

__device__ __forceinline__ void xcd_barrier(const XcdBarrier& b) {
    asm volatile("s_waitcnt vmcnt(0)" ::: "memory");
    __syncthreads();
    if (threadIdx.x == 0) {
        unsigned* bar = b.bar;
        __builtin_amdgcn_s_waitcnt(0);
        unsigned nloc = b.st[0], nx = b.st[1];
        if (nloc == 0u) { xcd_barrier_complete(bar, b.x, nloc, nx); b.st[0] = nloc; b.st[1] = nx; }
        const unsigned old = xb_add(&bar[XB_XSUB(b.x)], 1u);
        const unsigned gen = old / nloc;
        if (old + 1u == (gen + 1u) * nloc) {
            __builtin_amdgcn_fence(__ATOMIC_RELEASE, "agent");
            asm volatile("s_waitcnt vmcnt(0)" ::: "memory");
            const unsigned og = xb_add(&bar[XB_TOP], 1u);
            const unsigned tg = og / nx;
            if (og + 1u == (tg + 1u) * nx) xb_add(&bar[XB_TOPGEN], 1u);
            else XB_SPIN(xb_ld(&bar[XB_TOPGEN]) == tg, bar);
            __builtin_amdgcn_fence(__ATOMIC_ACQUIRE, "agent");
            xb_add(&bar[XB_XGEN(b.x)], 1u);
            asm volatile("s_waitcnt vmcnt(0)" ::: "memory");
        } else {
            XB_SPIN(xb_ld(&bar[XB_XGEN(b.x)]) == gen, bar);
            __builtin_amdgcn_fence(__ATOMIC_ACQUIRE, "agent");
            asm volatile("s_waitcnt vmcnt(0)" ::: "memory");
        }
    }
    __syncthreads();
}

struct Args { const float* in[22]; float* out; unsigned char* ws; int ph_lo, ph_hi, coop, pad; };

__global__ void __launch_bounds__(NTHR, 2) fwd_kernel(Args a) {
    extern __shared__ __attribute__((aligned(16))) unsigned char lds_raw[];
    LAS unsigned char* lds = (LAS unsigned char*)lds_raw;
    cg::grid_group grid = cg::this_grid();
    const int tid = threadIdx.x, lane = tid & 63, wave = __builtin_amdgcn_readfirstlane(tid >> 6);
    const int G = gridDim.x, bx = blockIdx.x;
    unsigned char* ws = a.ws;
    const int lo = a.ph_lo, hi = a.ph_hi;
#ifndef PHMASK
#define PHMASK 0x1ff
#endif
#define IN(k) (lo <= (k) && (k) < hi && ((PHMASK >> (k)) & 1))
#define SEAM(k) do { if (lo <= (k) && (k) + 1 < hi) { if (USE_XCDBAR) xcd_barrier(bar); else grid.sync(); } } while (0)
    if (tid < 2) ((volatile LAS unsigned*)(lds + MISC_OFF))[tid] = 0u;
    __syncthreads();
    XcdBarrier bar; bar.bar = (unsigned*)(ws + WS_BAR); bar.x = 0; bar.st = (volatile LAS unsigned*)(lds + MISC_OFF);
    if (USE_XCDBAR && a.coop) bar = xcd_barrier_post((unsigned*)(ws + WS_BAR), (volatile LAS unsigned*)(lds + MISC_OFF));
    if (a.coop == 2) grid.sync();
#define rstd1 ((float*)(ws + WS_RSTD1))
#define ssq2 ((float*)(ws + WS_SSQ2))
#define ssq3 ((float*)(ws + WS_SSQ3))
#define ssq4 ((float*)(ws + WS_SSQ4))
#define Win ((bf16_t*)(ws + WS_WIN))
#define Woa ((bf16_t*)(ws + WS_WOA))
#define Wpw ((bf16_t*)(ws + WS_WPW))
#define Wo ((bf16_t*)(ws + WS_WO))
#define Wgu ((bf16_t*)(ws + WS_WGU))
#define Wdn ((bf16_t*)(ws + WS_WDN))
#define Wpg ((bf16_t*)(ws + WS_WPG))
#define Wpp ((bf16_t*)(ws + WS_WPP))
#define XB ((bf16_t*)(ws + WS_R0))
#define MB ((bf16_t*)(ws + WS_R0))
#define H2B ((bf16_t*)(ws + WS_H1B))
#define Qb ((bf16_t*)(ws + WS_Q))
#define ABb ((bf16_t*)(ws + WS_AB))
#define Ub ((bf16_t*)(ws + WS_U))
#define SGA ((bf16_t*)(ws + WS_SGA))
#define SGB ((bf16_t*)(ws + WS_SGB))
#define YA ((bf16_t*)(ws + WS_YA))
#define VB ((bf16_t*)(ws + WS_VB))
#define H1B ((bf16_t*)(ws + WS_H1B))
#define Fb ((bf16_t*)(ws + WS_F))
#define PLEB ((bf16_t*)(ws + WS_R0))
#define PB ((bf16_t*)(ws + WS_PB))
    float* out = a.out;

    if (IN(0)) {
        LAS float* scr = (LAS float*)(lds + wave * 16640);
        const int gw = bx * NWAVES + wave, NGW = G * NWAVES;
        constexpr int I0 = 32 * 144;
        for (int it = wave * G + bx; it < I0; it += NGW) tr_item(a.in[3], DM, NIN, a.in[2], Win, 1, it, scr, lane);
        for (int row = gw; row < SEQ; row += NGW) {
            const f32x4* xr = (const f32x4*)(a.in[0] + (size_t)row * DM) + lane; f32x4 v[8]; float s = 0.f;
#pragma unroll
            for (int j = 0; j < 8; ++j) { v[j] = xr[64 * j]; s += dot4(v[j]); }
            s = wave_sum(s);
            if (lane == 0) rstd1[row] = rsqrtf(s * (1.0f / DM) + EPS);
            u32x2* o = (u32x2*)(XB + (size_t)row * DM) + lane;
#pragma unroll
            for (int j = 0; j < 8; ++j) { u32x2 w; w.x = cvt_pk_bf16(v[j][0], v[j][1]); w.y = cvt_pk_bf16(v[j][2], v[j][3]); o[64 * j] = w; }
        }
        for (int c = gw; c < SEQ * PLE / 512; c += NGW) {
            const f32x4* pr = (const f32x4*)(a.in[1] + (size_t)c * 512) + 2 * lane; const f32x4 v0 = pr[0], v1 = pr[1];
            st_bf16x8(PB + (size_t)c * 512 + 8 * lane, v0, v1);
        }
        for (int i = bx * NTHR + tid; i < SEQ; i += G * NTHR) { ssq2[i] = 0.f; ssq3[i] = 0.f; ssq4[i] = 0.f; }
        __syncthreads();
    }
    SEAM(0);
    if (IN(1)) {
        pg8::Gemm g{XB, Win, SEQ, NIN, DM}; pg8::StaticOrder S; S.init(SEQ, NIN, G, bx);
        EpiProj E{rstd1, a.in[6], Qb, ABb, Ub, SGA, SGB};
        pg8::gemm_phase<EpiProj, pg8::StaticOrder, true, true>(lds, g, S, E);
        const int rem = ((SEQ / 256) * (NIN / 256)) % G;
        if (rem == 0 || bx >= rem) {
            const int NS = rem ? G - rem : G, sb = rem ? bx - rem : bx;
            LAS float* scr = (LAS float*)(lds + wave * 16640);
            constexpr int I1 = 16 * 32, I2 = 16 * 32, I3 = 32 * 32, I4 = 32 * 88, I5 = 32 * 88, I8 = 4 * 32;
            for (int it = sb * NWAVES + wave; it < I1 + I2 + I3 + I4 + I5 + I8; it += NS * NWAVES) {
                int r = it;
                if (r < I8) { tr_item(a.in[20], PLE, DM, nullptr, Wpp, 0, r, scr, lane); continue; } r -= I8;
                if (r < I1) { tr_item(a.in[5], CW, DM, nullptr, Woa, 0, r, scr, lane); continue; } r -= I1;
                if (r < I2) { tr_item(a.in[11], CW, DM, nullptr, Wpw, 0, r, scr, lane); continue; } r -= I2;
                if (r < I3) { tr_item(a.in[13], DM, DM, nullptr, Wo, 0, r, scr, lane); continue; } r -= I3;
                if (r < I4) { tr_item(a.in[15], DM, DFF, a.in[14], Wgu, 2, r, scr, lane); continue; } r -= I4;
                tr_item(a.in[16], DM, DFF, a.in[14], Wgu, 3, r, scr, lane);
            }
            __syncthreads();
        }
    }
    SEAM(1);
    if (IN(2)) {
        const int c0 = 2 * tid;
        float wa0[3], wa1[3], wb0[31], wb1[31];
#pragma unroll
        for (int k = 0; k < 3; ++k) { const f32x2 w = *(const f32x2*)(a.in[4] + k * CW + c0); wa0[k] = w.x; wa1[k] = w.y; }
#pragma unroll
        for (int k = 0; k < 31; ++k) { const f32x2 w = *(const f32x2*)(a.in[7] + k * CW + c0); wb0[k] = w.x; wb1[k] = w.y; }
        const f32x2 cb = *(const f32x2*)(a.in[8] + c0), lg = *(const f32x2*)(a.in[9] + c0), lb = *(const f32x2*)(a.in[10] + c0);
        LAS float* P = (LAS float*)lds; LAS float* St = (LAS float*)(lds + 65536);
        for (int tile = bx; tile < SEQ / 16; tile += G) {
            const int t0 = tile * 16;
            {
                float q0[18], q1[18];
#pragma unroll
                for (int j = 0; j < 18; ++j) { const int ts = t0 - 2 + j; unsigned w = 0u; if (ts >= 0) w = *(const unsigned*)(Qb + (size_t)ts * CW + c0); q0[j] = bf_lo(w); q1[j] = bf_hi(w); }
#pragma unroll
                for (int i = 0; i < 16; ++i) { const unsigned w = *(const unsigned*)(ABb + (size_t)(t0 + i) * CW + c0);
                    const float y0 = bf_lo(w) * (wa0[0] * q0[i] + wa0[1] * q0[i + 1] + wa0[2] * q0[i + 2]);
                    const float y1 = bf_hi(w) * (wa1[0] * q1[i] + wa1[1] * q1[i + 1] + wa1[2] * q1[i + 2]);
                    *(unsigned*)(YA + (size_t)(t0 + i) * CW + c0) = cvt_pk_bf16(y0, y1); }
            }
            float acc0[16], acc1[16];
#pragma unroll
            for (int i = 0; i < 16; ++i) { acc0[i] = cb.x; acc1[i] = cb.y; }
#pragma unroll
            for (int s = 0; s < 46; ++s) { const int ts = t0 - 30 + s; unsigned w = 0u; if (ts >= 0) w = *(const unsigned*)(Ub + (size_t)ts * CW + c0);
                const float u0 = bf_lo(w), u1 = bf_hi(w);
#pragma unroll
                for (int i = 0; i < 16; ++i) { const int k = s - i; if (k >= 0 && k <= 30) { acc0[i] += wb0[k] * u0; acc1[i] += wb1[k] * u1; } } }
#pragma unroll
            for (int i = 0; i < 16; ++i) { P[(2 * i) * NTHR + tid] = acc0[i] + acc1[i]; P[(2 * i + 1) * NTHR + tid] = acc0[i] * acc0[i] + acc1[i] * acc1[i]; }
            __syncthreads();
#pragma unroll
            for (int r = 0; r < 4; ++r) { const int row = 4 * wave + r; float s = 0.f;
#pragma unroll
                for (int j = 0; j < 8; ++j) s += P[row * NTHR + lane + 64 * j];
                s = wave_sum(s); if (lane == 0) St[row] = s; }
            __syncthreads();
#pragma unroll
            for (int i = 0; i < 16; ++i) { const float mean = St[2 * i] * (1.0f / CW), var = St[2 * i + 1] * (1.0f / CW) - mean * mean, rs = rsqrtf(fmaxf(var, 0.f) + LN_EPS);
                const float v0 = (acc0[i] - mean) * rs * lg.x + lb.x, v1 = (acc1[i] - mean) * rs * lg.y + lb.y;
                *(unsigned*)(VB + (size_t)(t0 + i) * CW + c0) = cvt_pk_bf16(v0 * sigm(v0), v1 * sigm(v1)); }
        }
        __syncthreads();
    }
    SEAM(2);
    if (IN(3)) {
        pg8::StaticOrder S; S.init(SEQ, DM, G, bx);
        { pg8::Gemm g{YA, Woa, SEQ, DM, CW}; EpiM1 E{SGA, out}; pg8::gemm_phase<EpiM1, pg8::StaticOrder, true, true>(lds, g, S, E); }
        { pg8::Gemm g{VB, Wpw, SEQ, DM, CW}; EpiM E{SGB, out, a.in[12], MB}; pg8::gemm_phase<EpiM, pg8::StaticOrder, true, true>(lds, g, S, E); }
    }
    SEAM(3);
    if (IN(4)) {
        pg8::Gemm g{MB, Wo, SEQ, DM, DM}; pg8::StaticOrder S; S.init(SEQ, DM, G, bx);
        EpiRes<false, true> E{a.in[0], out, H1B, ssq2, nullptr, nullptr};
        pg8::gemm_phase<EpiRes<false, true>, pg8::StaticOrder, true, true>(lds, g, S, E);
    }
    SEAM(4);
    if (IN(5)) {
        pg8::Gemm g{H1B, Wgu, SEQ, 2 * DFF, DM}; pg8::StaticOrder S; S.init(SEQ, 2 * DFF, G, bx);
        EpiSwiglu E{ssq2, Fb};
        pg8::gemm_phase<EpiSwiglu, pg8::StaticOrder, true, true>(lds, g, S, E);
        const int rem = ((SEQ / 256) * (2 * DFF / 256)) % G;
        if (rem == 0 || bx >= rem) {
            const int NS = rem ? G - rem : G, sb = rem ? bx - rem : bx;
            { pg8::Gemm g2{PB, Wpp, SEQ, DM, PLE}; pg8::StaticOrder S2; S2.init(SEQ, DM, NS, sb); EpiPle E2{PLEB};
              pg8::gemm_phase<EpiPle, pg8::StaticOrder, true, true>(lds, g2, S2, E2); }
            LAS float* scr = (LAS float*)(lds + wave * 16640);
            constexpr int I6 = 88 * 32, I7 = 32 * 32;
            for (int it = sb * NWAVES + wave; it < I6 + I7; it += NS * NWAVES) {
                if (it < I6) tr_item(a.in[17], DFF, DM, nullptr, Wdn, 0, it, scr, lane);
                else tr_item(a.in[19], DM, DM, a.in[18], Wpg, 0, it - I6, scr, lane);
            }
            __syncthreads();
        }
    }
    SEAM(5);
    if (IN(6)) {
        pg8::Gemm g{Fb, Wdn, SEQ, DM, DFF}; pg8::StaticOrder S; S.init(SEQ, DM, G, bx);
        EpiRes<false, true> E{out, out, H2B, ssq3, nullptr, nullptr};
        pg8::gemm_phase<EpiRes<false, true>, pg8::StaticOrder, true, true>(lds, g, S, E);
    }
    SEAM(6);
    const bool fuse8 = FUSE_P8 && lo <= 7 && 8 < hi && G == (SEQ / 256) * (DM / 256);
    if (IN(7)) {
        pg8::StaticOrder S; S.init(SEQ, DM, G, bx); pg8::Gemm g{H2B, Wpg, SEQ, DM, DM};
        if (fuse8) { EpiFinal E{out, out, ssq4, ssq3, PLEB, a.in[21], (unsigned*)(ws + WS_CNT), (unsigned)(DM / 256)};
            pg8::gemm_phase<EpiFinal, pg8::StaticOrder, false, true>(lds, g, S, E); }
        else { EpiRes<true, false> E{out, out, nullptr, ssq4, ssq3, PLEB};
            pg8::gemm_phase<EpiRes<true, false>, pg8::StaticOrder, true, true>(lds, g, S, E); }
    }
    if (!fuse8) {
    SEAM(7);
    if (IN(8)) {
        const int gw = bx * NWAVES + wave, NGW = G * NWAVES;
        const f32x4* gf = (const f32x4*)a.in[21] + lane;
        for (int row = gw; row < SEQ; row += NGW) {
            f32x4* o = (f32x4*)(out + (size_t)row * DM) + lane; const float r = rsqrtf(ssq4[row] * (1.0f / DM) + EPS);
#pragma unroll
            for (int j = 0; j < 8; ++j) o[64 * j] = o[64 * j] * r * gf[64 * j];
        }
    }
    }
#undef IN
#undef SEAM
}

extern "C" void kernel_launch(void* const* d_in, const int* in_sizes, int n_in, void* d_out, int out_size, void* d_ws, size_t ws_size, hipStream_t stream) {
    static int grid = 0;
    if (grid == 0) {
        if (n_in != 22 || out_size != SEQ * DM || ws_size < WS_END) { fprintf(stderr, "kernel_launch: unexpected shapes (n_in %d, out %d, ws %zu)\n", n_in, out_size, ws_size); grid = -1; return; }
        int dev = 0, cus = 0, per_cu = 0;
        if (hipGetDevice(&dev) != hipSuccess || hipDeviceGetAttribute(&cus, hipDeviceAttributeMultiprocessorCount, dev) != hipSuccess) { grid = -1; return; }
        if (hipFuncSetAttribute((const void*)fwd_kernel, hipFuncAttributeMaxDynamicSharedMemorySize, LDS_BYTES) != hipSuccess) { fprintf(stderr, "kernel_launch: hipFuncSetAttribute failed\n"); grid = -1; return; }
        if (hipOccupancyMaxActiveBlocksPerMultiprocessor(&per_cu, (const void*)fwd_kernel, NTHR, LDS_BYTES) != hipSuccess || per_cu < 1) { fprintf(stderr, "kernel_launch: occupancy query says %d\n", per_cu); per_cu = 1; }
        (void)hipGetLastError();
        grid = cus;
    }
    if (grid < 0) return;
    Args a{};
    for (int i = 0; i < 22; ++i) a.in[i] = (const float*)d_in[i];
    a.out = (float*)d_out; a.ws = (unsigned char*)d_ws;
#if MK_LAUNCHES == 1
    a.ph_lo = 0; a.ph_hi = NPHASE; a.coop = 1;
    if (hipMemsetAsync((char*)d_ws + WS_BAR, 0, WS_CTL_END - WS_BAR, stream) != hipSuccess) { fprintf(stderr, "kernel_launch: memset of the control words failed\n"); return; }
    void* args[] = {&a};
    hipError_t e = hipLaunchCooperativeKernel((const void*)fwd_kernel, dim3(grid), dim3(NTHR), args, LDS_BYTES, stream);
    if (e != hipSuccess) fprintf(stderr, "kernel_launch: cooperative launch failed: %s (grid %d)\n", hipGetErrorString(e), grid);
#else
    for (int ph = 0; ph < NPHASE; ++ph) { a.ph_lo = ph; a.ph_hi = ph + 1; a.coop = 0; hipLaunchKernelGGL(fwd_kernel, dim3(grid), dim3(NTHR), LDS_BYTES, stream, a); }
#endif
}
```

```cpp
#include <hip/hip_runtime.h>
#include <hip/hip_cooperative_groups.h>
#include <cstdio>
#include <cstdint>
namespace cg = cooperative_groups;
namespace pg8 {
#define PG8_LAS __attribute__((address_space(3)))
typedef unsigned short bf16_t;
typedef short bf16x8 __attribute__((ext_vector_type(8)));
typedef float f32x4 __attribute__((ext_vector_type(4)));
typedef unsigned u32x4 __attribute__((ext_vector_type(4)));
constexpr int BM = 256, BK = 64, HALF = 128, HTB = HALF * BK * 2  , STAGE_BYTES = 8 * HTB, NXCD = 8, WGM = 8;

__host__ __device__ __forceinline__ int lds_byte(int r, int c) { const int st = (r >> 4) * 2 + (c >> 5), rr = r & 15, cc = c & 31, ob = rr * 64 + cc * 2; return st * 1024 + (ob ^ (((ob >> 9) & 1) << 5)); }
__host__ __device__ __forceinline__ void stage_rc(int b, int& R, int& C) { const int st = b / 1024, sb = b % 1024, swz = sb ^ (((sb >> 9) & 1) << 5); R = (st >> 1) * 16 + swz / 64; C = (st & 1) * 32 + (swz % 64) / 2; }
__host__ __device__ __forceinline__ int perm32(int rho) { const int n = rho >> 4, i = rho & 15; return 8 * (i >> 2) + 4 * n + (i & 3); }

struct Unit { int pm, pn; };
struct Gemm { const bf16_t* A; const bf16_t* Bt; int M, N, K; };

struct StaticOrder {
    int nM, nN, nwg, G, c;
    __host__ __device__ void init(int M, int N, int G_, int c_) { nM = M / BM; nN = N / BM; nwg = nM * nN; G = G_; c = c_; }
    __host__ __device__ bool next(int i, Unit& u) const {
        const long L = (long)i * G + c; if (L >= nwg) return false;
        int wgid = (int)L; { const int q = nwg / NXCD, r = nwg % NXCD, xcd = wgid % NXCD, off = wgid / NXCD; wgid = (xcd < r ? xcd * (q + 1) : r * (q + 1) + (xcd - r) * q) + off; }
        const int nig = WGM * nN, gid = wgid / nig, fm = gid * WGM, gsz = (nM - fm) < WGM ? (nM - fm) : WGM;
        u.pm = fm + ((wgid % nig) % gsz); u.pn = (wgid % nig) / gsz; return true;
    }
    __device__ __forceinline__ void a_ready(const Unit&) const {}
    __device__ __forceinline__ void done(const Unit&) const {}
};

__device__ __forceinline__ unsigned cvt_pk_bf16(float lo, float hi) { unsigned r; asm volatile("v_cvt_pk_bf16_f32 %0, %1, %2" : "=v"(r) : "v"(lo), "v"(hi)); return r; }
typedef float f32x2 __attribute__((ext_vector_type(2)));
template <class Epi, class Sched, bool ALIGN_EPI = false, bool SP2 = false>
__device__ __forceinline__ void gemm_phase(PG8_LAS unsigned char* lds, const Gemm g, const Sched& S, const Epi& E) {
    const int tid = threadIdx.x, wid = __builtin_amdgcn_readfirstlane(tid >> 6), lane = tid & 63, wr = wid >> 2, wc = wid & 3, fr = lane & 15, fq = lane >> 4;
    const int K = g.K, nt = K / BK;
    unsigned voffA[2], voffB[2];
#pragma unroll
    for (int i = 0; i < 2; ++i) { int R, C; stage_rc(tid * 16 + i * 8192, R, C); const int Rb = Epi::PERM ? ((R & ~31) + perm32(R & 31)) : R;
        voffA[i] = (unsigned)(R * K + C) * 2u; voffB[i] = (unsigned)(Rb * K + C) * 2u; }
    const size_t kstep = (size_t)(BK * 2);
    const size_t hstep = (size_t)HALF * K * 2;
    const size_t tstep = 2 * hstep;
    const unsigned ldsw = (unsigned)wid * 1024u;
    const int aoff = lds_byte(wr * 64 + fr, fq * 8), boff = lds_byte(wc * 32 + fr, fq * 8);
#define PG8_SA(b, h) (((b) * 2 + (h)) * HTB)
#define PG8_SB(b, h) ((4 + (b) * 2 + (h)) * HTB)
#define PG8_STAGE(bufoff, gbase, voff) do { _Pragma("unroll") for (int _i = 0; _i < 2; ++_i) \
        __builtin_amdgcn_global_load_lds((const unsigned*)((const char*)(gbase) + (voff)[_i]), (PG8_LAS unsigned*)(lds + (bufoff) + ldsw + _i * 8192), 16, 0, 0); } while (0)
#define PG8_LDA(dst, b, h) do { _Pragma("unroll") for (int m = 0; m < 4; ++m) _Pragma("unroll") for (int k = 0; k < 2; ++k) dst[m][k] = *(const PG8_LAS bf16x8*)(lds + PG8_SA(b, h) + aoff + m * 2048 + k * 1024); } while (0)
#define PG8_LDB(dst, b, h) do { _Pragma("unroll") for (int n = 0; n < 2; ++n) _Pragma("unroll") for (int k = 0; k < 2; ++k) dst[n][k] = *(const PG8_LAS bf16x8*)(lds + PG8_SB(b, h) + boff + n * 2048 + k * 1024); } while (0)
#define PG8_MMA(ai, bj, At, Bt) do { __builtin_amdgcn_s_setprio(1); _Pragma("unroll") for (int m = 0; m < 4; ++m) _Pragma("unroll") for (int n = 0; n < 2; ++n) _Pragma("unroll") for (int k = 0; k < 2; ++k) \
        acc[ai][bj][m][n] = __builtin_amdgcn_mfma_f32_16x16x32_bf16(Bt[n][k], At[m][k], acc[ai][bj][m][n], 0, 0, 0); __builtin_amdgcn_s_setprio(0); } while (0)
#define PG8_WAIT_V(n) asm volatile("s_waitcnt vmcnt(" #n ")" ::: "memory")
#define PG8_WAIT_L(n) asm volatile("s_waitcnt lgkmcnt(" #n ")" ::: "memory")
#define PG8_BAR __builtin_amdgcn_s_barrier()
#define PG8_SCHED __builtin_amdgcn_sched_barrier(0)
    Unit cur, nxt; int ui = 0;
    if (!S.next(0, cur)) return;
    f32x4 acc[2][2][4][2];
#pragma unroll
    for (int a = 0; a < 2; ++a)
#pragma unroll
        for (int b = 0; b < 2; ++b)
#pragma unroll
            for (int m = 0; m < 4; ++m)
#pragma unroll
                for (int n = 0; n < 2; ++n) acc[a][b][m][n] = (f32x4){0.f, 0.f, 0.f, 0.f};
    bf16x8 At[4][2], B0[2][2], B1[2][2];
    const char* cA = (const char*)g.A + (size_t)cur.pm * tstep; const char* cB = (const char*)g.Bt + (size_t)cur.pn * tstep;
    S.a_ready(cur);
    if constexpr (SP2) {
        PG8_STAGE(PG8_SB(0, 0), cB, voffB); PG8_STAGE(PG8_SB(0, 1), cB + hstep, voffB); PG8_STAGE(PG8_SA(0, 0), cA, voffA); PG8_STAGE(PG8_SA(0, 1), cA + hstep, voffA);
        if (wr == 1) PG8_BAR;
        PG8_WAIT_V(2); PG8_BAR;
        PG8_STAGE(PG8_SB(1, 0), cB + kstep, voffB); PG8_STAGE(PG8_SA(1, 0), cA + kstep, voffA); PG8_STAGE(PG8_SB(1, 1), cB + hstep + kstep, voffB);
        PG8_WAIT_V(6); PG8_BAR;
    } else {
        PG8_STAGE(PG8_SB(0, 0), cB, voffB); PG8_STAGE(PG8_SA(0, 0), cA, voffA); PG8_STAGE(PG8_SB(0, 1), cB + hstep, voffB); PG8_STAGE(PG8_SA(0, 1), cA + hstep, voffA);
        if (wr == 1) PG8_BAR;
        PG8_WAIT_V(4); PG8_BAR;
        PG8_STAGE(PG8_SB(1, 0), cB + kstep, voffB); PG8_STAGE(PG8_SA(1, 0), cA + kstep, voffA); PG8_STAGE(PG8_SB(1, 1), cB + hstep + kstep, voffB);
        PG8_WAIT_V(6); PG8_BAR;
    }
    for (;;) {
        const bool has_next = S.next(ui + 1, nxt);
        const char* nA = has_next ? (const char*)g.A + (size_t)nxt.pm * tstep : cA; const char* nB = has_next ? (const char*)g.Bt + (size_t)nxt.pn * tstep : cB;
#pragma unroll 1
        for (int t = 0; t < nt; t += 2) {
            const bool last = (t == nt - 2);
            const char* a1 = cA + (size_t)(t + 1) * kstep;
            const char* a2 = last ? nA : cA + (size_t)(t + 2) * kstep; const char* b2 = last ? nB : cB + (size_t)(t + 2) * kstep;
            const char* a3 = a2 + kstep; const char* b3 = b2 + kstep;
            if (last && has_next) S.a_ready(nxt);
            if constexpr (SP2) {
            PG8_LDB(B0, 0, 0); PG8_LDB(B1, 0, 1); PG8_SCHED; PG8_LDA(At, 0, 0); PG8_STAGE(PG8_SA(1, 1), a1 + hstep, voffA);
            PG8_WAIT_V(8); PG8_WAIT_L(0); PG8_BAR; PG8_MMA(0, 0, At, B0); PG8_MMA(0, 1, At, B1); PG8_BAR; PG8_SCHED;
            PG8_LDA(At, 0, 1); PG8_STAGE(PG8_SB(0, 0), b2, voffB); PG8_STAGE(PG8_SB(0, 1), b2 + hstep, voffB); PG8_STAGE(PG8_SA(0, 0), a2, voffA);
            PG8_WAIT_V(8); PG8_WAIT_L(0); PG8_BAR; PG8_MMA(1, 0, At, B0); PG8_MMA(1, 1, At, B1); PG8_BAR; PG8_SCHED;
            PG8_LDB(B0, 1, 0); PG8_LDB(B1, 1, 1); PG8_SCHED; PG8_LDA(At, 1, 0); PG8_STAGE(PG8_SA(0, 1), a2 + hstep, voffA);
            PG8_WAIT_V(8); PG8_WAIT_L(0); PG8_BAR; PG8_MMA(0, 0, At, B0); PG8_MMA(0, 1, At, B1); PG8_BAR; PG8_SCHED;
            PG8_LDA(At, 1, 1); PG8_STAGE(PG8_SB(1, 0), b3, voffB); PG8_STAGE(PG8_SB(1, 1), b3 + hstep, voffB); PG8_STAGE(PG8_SA(1, 0), a3, voffA);
            PG8_WAIT_V(8); PG8_WAIT_L(0); PG8_BAR; PG8_MMA(1, 0, At, B0); PG8_MMA(1, 1, At, B1); PG8_BAR; PG8_SCHED;
            } else {
            PG8_LDB(B0, 0, 0); PG8_SCHED; PG8_LDA(At, 0, 0); PG8_STAGE(PG8_SA(1, 1), a1 + hstep, voffA);
            PG8_WAIT_L(8); PG8_BAR; PG8_WAIT_L(0); PG8_MMA(0, 0, At, B0); PG8_BAR; PG8_SCHED;
            PG8_LDB(B1, 0, 1); PG8_STAGE(PG8_SB(0, 0), b2, voffB);
            PG8_BAR; PG8_WAIT_L(0); PG8_MMA(0, 1, At, B1); PG8_BAR;
            PG8_LDA(At, 0, 1); PG8_STAGE(PG8_SA(0, 0), a2, voffA);
            PG8_BAR; PG8_WAIT_L(0); PG8_MMA(1, 0, At, B0); PG8_BAR; PG8_SCHED;
            PG8_STAGE(PG8_SB(0, 1), b2 + hstep, voffB);
            PG8_WAIT_V(6); PG8_BAR; PG8_MMA(1, 1, At, B1); PG8_BAR;
            PG8_LDB(B0, 1, 0); PG8_SCHED; PG8_LDA(At, 1, 0); PG8_STAGE(PG8_SA(0, 1), a2 + hstep, voffA);
            PG8_WAIT_L(8); PG8_BAR; PG8_WAIT_L(0); PG8_MMA(0, 0, At, B0); PG8_BAR; PG8_SCHED;
            PG8_LDB(B1, 1, 1); PG8_STAGE(PG8_SB(1, 0), b3, voffB);
            PG8_BAR; PG8_WAIT_L(0); PG8_MMA(0, 1, At, B1); PG8_BAR;
            PG8_LDA(At, 1, 1); PG8_STAGE(PG8_SA(1, 0), a3, voffA);
            PG8_BAR; PG8_WAIT_L(0); PG8_MMA(1, 0, At, B0); PG8_BAR; PG8_SCHED;
            PG8_STAGE(PG8_SB(1, 1), b3 + hstep, voffB);
            PG8_WAIT_V(6); PG8_BAR; PG8_MMA(1, 1, At, B1); PG8_BAR;
            }
        }
        if constexpr (ALIGN_EPI) { if (wr == 0) PG8_BAR; }
        if constexpr (!Epi::AFTER_DRAIN) { E(acc, cur, wr, wc, fr, fq); S.done(cur); }
        if (!has_next) break;
#pragma unroll
        for (int a = 0; a < 2; ++a)
#pragma unroll
            for (int b = 0; b < 2; ++b)
#pragma unroll
                for (int m = 0; m < 4; ++m)
#pragma unroll
                    for (int n = 0; n < 2; ++n) acc[a][b][m][n] = (f32x4){0.f, 0.f, 0.f, 0.f};
        cur = nxt; cA = nA; cB = nB; ++ui;
        if constexpr (ALIGN_EPI) { if (wr == 1) PG8_BAR; }
    }
    PG8_WAIT_V(0);
    if constexpr (!ALIGN_EPI) { if (wr == 0) PG8_BAR; }
    PG8_BAR;
    if constexpr (Epi::AFTER_DRAIN) { E.fused(acc, cur, wr, wc, fr, fq, lds, wid, lane); S.done(cur); }
#undef PG8_SA
#undef PG8_SB
#undef PG8_STAGE
#undef PG8_LDA
#undef PG8_LDB
#undef PG8_MMA
#undef PG8_WAIT_V
#undef PG8_WAIT_L
#undef PG8_BAR
#undef PG8_SCHED
}
}

#define LAS __attribute__((address_space(3)))
using pg8::bf16_t; using pg8::f32x4; using pg8::u32x4; using pg8::Unit; using pg8::cvt_pk_bf16;
typedef unsigned u32x2 __attribute__((ext_vector_type(2)));
typedef float f32x2 __attribute__((ext_vector_type(2)));

#ifndef MK_LAUNCHES
#define MK_LAUNCHES 1
#endif
constexpr int SEQ = 8192, DM = 2048, CW = 1024, NIN = 9216, DFF = 5632, PLE = 256;
constexpr float EPS = 1e-6f, LN_EPS = 1e-5f;
constexpr int NWAVES = 8, NTHR = 512, NPHASE = 9;
constexpr int LDS_BYTES = 147456;
constexpr size_t MiB = 1u << 20;
constexpr size_t WS_RSTD1 = 0, WS_SSQ2 = 64 * 1024, WS_SSQ3 = 128 * 1024, WS_SSQ4 = 192 * 1024;
constexpr size_t WS_BAR = 256 * 1024, WS_CNT = 272 * 1024, WS_CTL_END = 280 * 1024;
constexpr int MISC_OFF = 143360;
constexpr size_t WS_WIN = 2 * MiB, WS_WOA = 38 * MiB, WS_WPW = 42 * MiB, WS_WO = 46 * MiB, WS_WGU = 54 * MiB, WS_WDN = 98 * MiB, WS_WPG = 120 * MiB, WS_WPP = 128 * MiB;
constexpr size_t WS_R0 = 130 * MiB;
constexpr size_t WS_Q = 162 * MiB, WS_AB = 178 * MiB, WS_U = 194 * MiB;
constexpr size_t WS_SGA = 210 * MiB, WS_SGB = 242 * MiB;
constexpr size_t WS_YA = 274 * MiB, WS_VB = 290 * MiB;
constexpr size_t WS_H1B = 162 * MiB;
constexpr size_t WS_F = 194 * MiB;
constexpr size_t WS_PB = 306 * MiB;
constexpr size_t WS_END = 310 * MiB;

__device__ __forceinline__ float sigm(float x) { return __builtin_amdgcn_rcpf(1.f + __expf(-x)); }
__device__ __forceinline__ f32x4 sig4(f32x4 v) { return (f32x4){sigm(v[0]), sigm(v[1]), sigm(v[2]), sigm(v[3])}; }
__device__ __forceinline__ float bf_lo(unsigned w) { return __uint_as_float(w << 16); }
__device__ __forceinline__ float bf_hi(unsigned w) { return __uint_as_float(w & 0xffff0000u); }
__device__ __forceinline__ void st_bf16x8(bf16_t* p, f32x4 v0, f32x4 v1) {
    u32x4 w; w.x = cvt_pk_bf16(v0[0], v0[1]); w.y = cvt_pk_bf16(v0[2], v0[3]); w.z = cvt_pk_bf16(v1[0], v1[1]); w.w = cvt_pk_bf16(v1[2], v1[3]); *(u32x4*)p = w; }
__device__ __forceinline__ void ld_bf16x8(const bf16_t* p, f32x4& v0, f32x4& v1) {
    const u32x4 w = *(const u32x4*)p; v0 = (f32x4){bf_lo(w.x), bf_hi(w.x), bf_lo(w.y), bf_hi(w.y)}; v1 = (f32x4){bf_lo(w.z), bf_hi(w.z), bf_lo(w.w), bf_hi(w.w)}; }
__device__ __forceinline__ float dot4(f32x4 a) { return (a[0] * a[0] + a[1] * a[1]) + (a[2] * a[2] + a[3] * a[3]); }
__device__ __forceinline__ float wave_sum(float v) {
#pragma unroll
    for (int o = 1; o < 64; o <<= 1) v += __shfl_xor(v, o);
    return v;
}

struct EpiProj {
    static constexpr bool PERM = true, AFTER_DRAIN = false;
    const float* rstd; const float* bglu; bf16_t *Qo, *ABo, *Uo, *SA, *SB;
    __device__ __forceinline__ void operator()(const f32x4 (&acc)[2][2][4][2], const Unit& u, int wr, int wc, int fr, int fq) const {
        const int pn = u.pn, row0 = u.pm * 256 + wr * 64 + fr, cl = wc * 32 + 8 * fq;
        if (pn < 8) {
#pragma unroll
            for (int ai = 0; ai < 2; ++ai)
#pragma unroll
                for (int m = 0; m < 4; ++m) { const int row = row0 + ai * 128 + m * 16; const float r = rstd[row], r2 = r * r;
                    st_bf16x8(Qo + (size_t)row * CW + pn * 128 + cl, acc[ai][0][m][0] * acc[ai][1][m][0] * r2, acc[ai][0][m][1] * acc[ai][1][m][1] * r2); }
        } else if (pn < 12) {
#pragma unroll
            for (int ai = 0; ai < 2; ++ai)
#pragma unroll
                for (int m = 0; m < 4; ++m) { const int row = row0 + ai * 128 + m * 16; const float r = rstd[row];
#pragma unroll
                    for (int bj = 0; bj < 2; ++bj) st_bf16x8(ABo + (size_t)row * CW + (pn - 8) * 256 + bj * 128 + cl, acc[ai][bj][m][0] * r, acc[ai][bj][m][1] * r); }
        } else if (pn < 20) {
            const int ch = (pn - 12) * 128 + cl;
            const f32x4 bv0 = *(const f32x4*)(bglu + ch), bv1 = *(const f32x4*)(bglu + ch + 4), bg0 = *(const f32x4*)(bglu + CW + ch), bg1 = *(const f32x4*)(bglu + CW + ch + 4);
#pragma unroll
            for (int ai = 0; ai < 2; ++ai)
#pragma unroll
                for (int m = 0; m < 4; ++m) { const int row = row0 + ai * 128 + m * 16; const float r = rstd[row];
                    const f32x4 v0 = acc[ai][0][m][0] * r + bv0, v1 = acc[ai][0][m][1] * r + bv1, g0 = acc[ai][1][m][0] * r + bg0, g1 = acc[ai][1][m][1] * r + bg1;
                    st_bf16x8(Uo + (size_t)row * CW + ch, v0 * sig4(g0), v1 * sig4(g1)); }
        } else {
            bf16_t* S = pn < 28 ? SA : SB; const int cb = ((pn - 20) & 7) * 256 + cl;
#pragma unroll
            for (int ai = 0; ai < 2; ++ai)
#pragma unroll
                for (int m = 0; m < 4; ++m) { const int row = row0 + ai * 128 + m * 16; const float r = rstd[row];
#pragma unroll
                    for (int bj = 0; bj < 2; ++bj) st_bf16x8(S + (size_t)row * DM + cb + bj * 128, sig4(acc[ai][bj][m][0] * r), sig4(acc[ai][bj][m][1] * r)); }
        }
    }
};
struct EpiM1 {
    static constexpr bool PERM = true, AFTER_DRAIN = false;
    const bf16_t* SG; float* M1;
    __device__ __forceinline__ void operator()(const f32x4 (&acc)[2][2][4][2], const Unit& u, int wr, int wc, int fr, int fq) const {
        const int row0 = u.pm * 256 + wr * 64 + fr, c0 = u.pn * 256 + wc * 32 + 8 * fq;
#pragma unroll
        for (int ai = 0; ai < 2; ++ai)
#pragma unroll
            for (int m = 0; m < 4; ++m)
#pragma unroll
                for (int bj = 0; bj < 2; ++bj) { const size_t off = (size_t)(row0 + ai * 128 + m * 16) * DM + c0 + bj * 128; f32x4 g0, g1; ld_bf16x8(SG + off, g0, g1);
                    *(f32x4*)(M1 + off) = g0 * acc[ai][bj][m][0]; *(f32x4*)(M1 + off + 4) = g1 * acc[ai][bj][m][1]; }
    }
};
struct EpiM {
    static constexpr bool PERM = true, AFTER_DRAIN = false;
    const bf16_t* SG; const float* M1; const float* bias; bf16_t* Mo;
    __device__ __forceinline__ void operator()(const f32x4 (&acc)[2][2][4][2], const Unit& u, int wr, int wc, int fr, int fq) const {
        const int row0 = u.pm * 256 + wr * 64 + fr, c0 = u.pn * 256 + wc * 32 + 8 * fq;
        f32x4 bv[2][2];
#pragma unroll
        for (int bj = 0; bj < 2; ++bj) { bv[bj][0] = *(const f32x4*)(bias + c0 + bj * 128); bv[bj][1] = *(const f32x4*)(bias + c0 + bj * 128 + 4); }
#pragma unroll
        for (int ai = 0; ai < 2; ++ai)
#pragma unroll
            for (int m = 0; m < 4; ++m)
#pragma unroll
                for (int bj = 0; bj < 2; ++bj) { const size_t off = (size_t)(row0 + ai * 128 + m * 16) * DM + c0 + bj * 128; f32x4 g0, g1; ld_bf16x8(SG + off, g0, g1);
                    const f32x4 a0 = *(const f32x4*)(M1 + off), a1 = *(const f32x4*)(M1 + off + 4);
                    st_bf16x8(Mo + off, a0 + g0 * (acc[ai][bj][m][0] + bv[bj][0]), a1 + g1 * (acc[ai][bj][m][1] + bv[bj][1])); }
    }
};
template <bool BASE16, bool WF32, bool WB16, bool GATED> struct EpiRes {
    static constexpr bool PERM = true, AFTER_DRAIN = false;
    const float* basef; const bf16_t* baseb; float* out; bf16_t* ob; float* ssq_out; const float* ssq_in; const bf16_t* ple;
    __device__ __forceinline__ void operator()(const f32x4 (&acc)[2][2][4][2], const Unit& u, int wr, int wc, int fr, int fq) const {
        const int row0 = u.pm * 256 + wr * 64 + fr, c0 = u.pn * 256 + wc * 32 + 8 * fq;
#pragma unroll
        for (int ai = 0; ai < 2; ++ai)
#pragma unroll
            for (int m = 0; m < 4; ++m) { const int row = row0 + ai * 128 + m * 16; float r = 0.f; if (GATED) r = rsqrtf(ssq_in[row] * (1.0f / DM) + EPS);
                float s = 0.f;
#pragma unroll
                for (int bj = 0; bj < 2; ++bj) { const size_t off = (size_t)row * DM + c0 + bj * 128;
                    f32x4 b0, b1; if (BASE16) ld_bf16x8(baseb + off, b0, b1); else { b0 = *(const f32x4*)(basef + off); b1 = *(const f32x4*)(basef + off + 4); }
                    f32x4 v0 = acc[ai][bj][m][0], v1 = acc[ai][bj][m][1];
                    if (GATED) { f32x4 p0, p1; ld_bf16x8(ple + off, p0, p1); v0 = sig4(v0 * r) * p0; v1 = sig4(v1 * r) * p1; }
                    const f32x4 h0 = b0 + v0, h1 = b1 + v1;
                    if (WF32) { *(f32x4*)(out + off) = h0; *(f32x4*)(out + off + 4) = h1; }
                    if (WB16) st_bf16x8(ob + off, h0, h1);
                    s += dot4(h0) + dot4(h1); }
                s += __shfl_xor(s, 16); s += __shfl_xor(s, 32);
                if (fq == 0) unsafeAtomicAdd(ssq_out + row, s);
                if (m == 3) asm volatile("" ::: "memory"); }
    }
};
struct EpiSwiglu {
    static constexpr bool PERM = true, AFTER_DRAIN = false;
    const float* ssq_in; bf16_t* F;
    __device__ __forceinline__ void operator()(const f32x4 (&acc)[2][2][4][2], const Unit& u, int wr, int wc, int fr, int fq) const {
        const int row0 = u.pm * 256 + wr * 64 + fr, ch = u.pn * 128 + wc * 32 + 8 * fq;
#pragma unroll
        for (int ai = 0; ai < 2; ++ai)
#pragma unroll
            for (int m = 0; m < 4; ++m) { const int row = row0 + ai * 128 + m * 16; const float r = rsqrtf(ssq_in[row] * (1.0f / DM) + EPS);
                const f32x4 g0 = acc[ai][0][m][0] * r, g1 = acc[ai][0][m][1] * r, u0 = acc[ai][1][m][0] * r, u1 = acc[ai][1][m][1] * r;
                st_bf16x8(F + (size_t)row * DFF + ch, g0 * sig4(g0) * u0, g1 * sig4(g1) * u1); }
    }
};
struct EpiPle {
    static constexpr bool PERM = true, AFTER_DRAIN = false;
    bf16_t* O;
    __device__ __forceinline__ void operator()(const f32x4 (&acc)[2][2][4][2], const Unit& u, int wr, int wc, int fr, int fq) const {
        const int row0 = u.pm * 256 + wr * 64 + fr, c0 = u.pn * 256 + wc * 32 + 8 * fq;
#pragma unroll
        for (int ai = 0; ai < 2; ++ai)
#pragma unroll
            for (int m = 0; m < 4; ++m)
#pragma unroll
                for (int bj = 0; bj < 2; ++bj) st_bf16x8(O + (size_t)(row0 + ai * 128 + m * 16) * DM + c0 + bj * 128, acc[ai][bj][m][0], acc[ai][bj][m][1]);
    }
};

struct EpiFinal {
    static constexpr bool PERM = true, AFTER_DRAIN = true;
    const bf16_t* base; float* out; float* ssq_out; const float* ssq_in; const bf16_t* ple; const float* gfin; unsigned* cnt; unsigned want;
    __device__ __forceinline__ void fused(f32x4 (&acc)[2][2][4][2], const Unit& u, int wr, int wc, int fr, int fq, PG8_LAS unsigned char* lds, int wid, int lane) const {
        const int row0 = u.pm * 256 + wr * 64 + fr, c0 = u.pn * 256 + wc * 32 + 8 * fq;
#pragma unroll
        for (int ai = 0; ai < 2; ++ai)
#pragma unroll
            for (int m = 0; m < 4; ++m) { const int row = row0 + ai * 128 + m * 16; const float r = rsqrtf(ssq_in[row] * (1.0f / DM) + EPS);
                float s = 0.f;
#pragma unroll
                for (int bj = 0; bj < 2; ++bj) { const size_t off = (size_t)row * DM + c0 + bj * 128;
                    f32x4 b0, b1; ld_bf16x8(base + off, b0, b1);
                    f32x4 p0, p1; ld_bf16x8(ple + off, p0, p1);
                    const f32x4 h0 = b0 + sig4(acc[ai][bj][m][0] * r) * p0, h1 = b1 + sig4(acc[ai][bj][m][1] * r) * p1;
                    acc[ai][bj][m][0] = h0; acc[ai][bj][m][1] = h1;
                    s += dot4(h0) + dot4(h1); }
                s += __shfl_xor(s, 16); s += __shfl_xor(s, 32);
                if (fq == 0) unsafeAtomicAdd(ssq_out + row, s);
                if (m & 1) asm volatile("" ::: "memory"); }
        asm volatile("s_waitcnt vmcnt(0)" ::: "memory");
        __syncthreads();
        if (threadIdx.x == 0) { unsigned* c = cnt + 64 * u.pm;
            __hip_atomic_fetch_add(c, 1u, __ATOMIC_RELAXED, __HIP_MEMORY_SCOPE_AGENT);
            while (__hip_atomic_load(c, __ATOMIC_RELAXED, __HIP_MEMORY_SCOPE_AGENT) < want) __builtin_amdgcn_s_sleep(2); }
        __syncthreads();
        f32x4 gv[2][2];
#pragma unroll
        for (int bj = 0; bj < 2; ++bj) { gv[bj][0] = *(const f32x4*)(gfin + c0 + bj * 128); gv[bj][1] = *(const f32x4*)(gfin + c0 + bj * 128 + 4); }
#pragma unroll
        for (int ai = 0; ai < 2; ++ai)
#pragma unroll
            for (int m = 0; m < 4; ++m) { const int row = row0 + ai * 128 + m * 16;
                const float rr = rsqrtf(__hip_atomic_load(ssq_out + row, __ATOMIC_RELAXED, __HIP_MEMORY_SCOPE_AGENT) * (1.0f / DM) + EPS);
#pragma unroll
                for (int bj = 0; bj < 2; ++bj) { const size_t off = (size_t)row * DM + c0 + bj * 128;
                    *(f32x4*)(out + off) = acc[ai][bj][m][0] * rr * gv[bj][0]; *(f32x4*)(out + off + 4) = acc[ai][bj][m][1] * rr * gv[bj][1]; } }
    }
};

__device__ __forceinline__ int win_dest(int n0) {
    if (n0 < 1024) return 256 * (n0 >> 7) + (n0 & 127);
    if (n0 < 2048) return 2048 + (n0 - 1024);
    if (n0 < 3072) { const int c = n0 - 2048; return 256 * (c >> 7) + 128 + (c & 127); }
    if (n0 < 4096) { const int c = n0 - 3072; return 3072 + 256 * (c >> 7) + (c & 127); }
    if (n0 < 5120) { const int c = n0 - 4096; return 3072 + 256 * (c >> 7) + 128 + (c & 127); }
    return n0;
}
__device__ __forceinline__ void tr_item(const float* W, int K, int N, const float* g, bf16_t* WT, int mode, int item, LAS float* scr, int lane) {
    const int nblk = N >> 6, kb = item / nblk, nb = item - kb * nblk, k0 = kb << 6, n0 = nb << 6;
    int d0 = n0;
    if (mode == 1) d0 = win_dest(n0); else if (mode == 2) d0 = 256 * (n0 >> 7) + (n0 & 127); else if (mode == 3) d0 = 256 * (n0 >> 7) + 128 + (n0 & 127);
    const int kr = lane >> 4, col = 4 * (lane & 15);
    f32x4 v[16];
#pragma unroll
    for (int i = 0; i < 16; ++i) v[i] = *(const f32x4*)(W + (size_t)(k0 + 4 * i + kr) * N + n0 + col);
    if (g) {
#pragma unroll
        for (int i = 0; i < 16; ++i) v[i] = v[i] * g[k0 + 4 * i + kr];
    }
#pragma unroll
    for (int i = 0; i < 16; ++i) { LAS float* s = scr + (4 * i + kr) * 65 + col; s[0] = v[i][0]; s[1] = v[i][1]; s[2] = v[i][2]; s[3] = v[i][3]; }
    asm volatile("s_waitcnt lgkmcnt(0)" ::: "memory");
    const int c = lane & 7;
#pragma unroll
    for (int j = 0; j < 8; ++j) { const int n = (lane >> 3) + 8 * j; const LAS float* s = scr + (8 * c) * 65 + n;
        u32x4 o; o.x = cvt_pk_bf16(s[0], s[65]); o.y = cvt_pk_bf16(s[2 * 65], s[3 * 65]); o.z = cvt_pk_bf16(s[4 * 65], s[5 * 65]); o.w = cvt_pk_bf16(s[6 * 65], s[7 * 65]);
        *(u32x4*)(WT + (size_t)(d0 + n) * K + k0 + 8 * c) = o; }
    asm volatile("s_waitcnt lgkmcnt(0)" ::: "memory");
}

#ifndef USE_XCDBAR
#define USE_XCDBAR 1
#endif
#ifndef FUSE_P8
#define FUSE_P8 1
#endif
#define XB_TMO      128
#define XB_XCNT(j)  (256  + 64 * (j))
#define XB_XSUB(j)  (1280 + 64 * (j))
#define XB_XGEN(j)  (2304 + 64 * (j))
#define XB_TOP      3328
#define XB_TOPGEN   3392
#define XCD_BAR_WORDS 3456
#define XB_SPIN_CAP (1u << 18)

__device__ __forceinline__ unsigned xb_ld(unsigned* p)              { return __hip_atomic_load(p, __ATOMIC_RELAXED, __HIP_MEMORY_SCOPE_AGENT); }
__device__ __forceinline__ unsigned xb_add(unsigned* p, unsigned v) { return __hip_atomic_fetch_add(p, v, __ATOMIC_RELAXED, __HIP_MEMORY_SCOPE_AGENT); }
__device__ __forceinline__ unsigned xb_xcc_id() { return (unsigned)__builtin_amdgcn_s_getreg((3 << 11) | 20) & 0xFu; }
#define XB_SPIN(cond, bar) do { unsigned _sp = 0; while (cond) { __builtin_amdgcn_s_sleep(1); \
    if ((++_sp & 255u) == 0u) { if (xb_ld(&(bar)[XB_TMO])) break; if (_sp > XB_SPIN_CAP) { atomicAdd(&(bar)[XB_TMO], 1u); break; } } } } while (0)

struct XcdBarrier {
    unsigned* bar; unsigned x;
    volatile LAS unsigned* st;
};

__device__ __forceinline__ XcdBarrier xcd_barrier_post(unsigned* bar, volatile LAS unsigned* st) {
    XcdBarrier b; b.bar = bar; b.x = xb_xcc_id(); b.st = st;
    if (threadIdx.x == 0) (void)xb_add(&bar[XB_XCNT(b.x)], 1u);
    return b;
}
__device__ __forceinline__ void xcd_barrier_complete(unsigned* bar, unsigned x, unsigned& nloc, unsigned& nx) {
    const unsigned G = gridDim.x * gridDim.y * gridDim.z;
    unsigned sum, cnt, mine, sp = 0u;
    for (;;) {
        sum = 0u; cnt = 0u; mine = 0u;
#pragma unroll
        for (unsigned j = 0; j < 16; ++j) { const unsigned c = xb_ld(&bar[XB_XCNT(j)]); sum += c; cnt += (c > 0u) ? 1u : 0u; mine = (j == x) ? c : mine; }
        if (sum == G) break;
        __builtin_amdgcn_s_sleep(1);
        if ((++sp & 255u) == 0u) { if (xb_ld(&bar[XB_TMO])) break; if (sp > XB_SPIN_CAP) { atomicAdd(&bar[XB_TMO], 1u); break; } }
    }
    nloc = mine > 0u ? mine : 1u; nx = cnt > 0u ? cnt : 1u;
}

__device__ __forceinline__ void xcd_barrier(const XcdBarrier& b) {
    asm volatile("s_waitcnt vmcnt(0)" ::: "memory");
    __syncthreads();
    if (threadIdx.x == 0) {
        unsigned* bar = b.bar;
        __builtin_amdgcn_s_waitcnt(0);
        unsigned nloc = b.st[0], nx = b.st[1];
        if (nloc == 0u) { xcd_barrier_complete(bar, b.x, nloc, nx); b.st[0] = nloc; b.st[1] = nx; }
        const unsigned old = xb_add(&bar[XB_XSUB(b.x)], 1u);
        const unsigned gen = old / nloc;
        if (old + 1u == (gen + 1u) * nloc) {
            __builtin_amdgcn_fence(__ATOMIC_RELEASE, "agent");
            asm volatile("s_waitcnt vmcnt(0)" ::: "memory");
            const unsigned og = xb_add(&bar[XB_TOP], 1u);
            const unsigned tg = og / nx;
            if (og + 1u == (tg + 1u) * nx) xb_add(&bar[XB_TOPGEN], 1u);
            else XB_SPIN(xb_ld(&bar[XB_TOPGEN]) == tg, bar);
            __builtin_amdgcn_fence(__ATOMIC_ACQUIRE, "agent");
            xb_add(&bar[XB_XGEN(b.x)], 1u);
            asm volatile("s_waitcnt vmcnt(0)" ::: "memory");
        } else {
            XB_SPIN(xb_ld(&bar[XB_XGEN(b.x)]) == gen, bar);
            __builtin_amdgcn_fence(__ATOMIC_ACQUIRE, "agent");
            asm volatile("s_waitcnt vmcnt(0)" ::: "memory");
        }
    }
    __syncthreads();
}

struct Args { const float* in[22]; float* out; unsigned char* ws; int ph_lo, ph_hi, coop, pad; };

__global__ void __launch_bounds__(NTHR, 2) fwd_kernel(Args a) {
    extern __shared__ __attribute__((aligned(16))) unsigned char lds_raw[];
    LAS unsigned char* lds = (LAS unsigned char*)lds_raw;
    cg::grid_group grid = cg::this_grid();
    const int tid = threadIdx.x, lane = tid & 63, wave = __builtin_amdgcn_readfirstlane(tid >> 6);
    const int G = gridDim.x, bx = blockIdx.x;
    unsigned char* ws = a.ws;
    const int lo = a.ph_lo, hi = a.ph_hi;
#ifndef PHMASK
#define PHMASK 0x1ff
#endif
#define IN(k) (lo <= (k) && (k) < hi && ((PHMASK >> (k)) & 1))
#define SEAM(k) do { if (lo <= (k) && (k) + 1 < hi) { if (USE_XCDBAR) xcd_barrier(bar); else grid.sync(); } } while (0)
    if (tid < 2) ((volatile LAS unsigned*)(lds + MISC_OFF))[tid] = 0u;
    __syncthreads();
    XcdBarrier bar; bar.bar = (unsigned*)(ws + WS_BAR); bar.x = 0; bar.st = (volatile LAS unsigned*)(lds + MISC_OFF);
    if (USE_XCDBAR && a.coop) bar = xcd_barrier_post((unsigned*)(ws + WS_BAR), (volatile LAS unsigned*)(lds + MISC_OFF));
    if (a.coop == 2) grid.sync();
#define rstd1 ((float*)(ws + WS_RSTD1))
#define ssq2 ((float*)(ws + WS_SSQ2))
#define ssq3 ((float*)(ws + WS_SSQ3))
#define ssq4 ((float*)(ws + WS_SSQ4))
#define Win ((bf16_t*)(ws + WS_WIN))
#define Woa ((bf16_t*)(ws + WS_WOA))
#define Wpw ((bf16_t*)(ws + WS_WPW))
#define Wo ((bf16_t*)(ws + WS_WO))
#define Wgu ((bf16_t*)(ws + WS_WGU))
#define Wdn ((bf16_t*)(ws + WS_WDN))
#define Wpg ((bf16_t*)(ws + WS_WPG))
#define Wpp ((bf16_t*)(ws + WS_WPP))
#define XB ((bf16_t*)(ws + WS_R0))
#define MB ((bf16_t*)(ws + WS_R0))
#define H2B ((bf16_t*)(ws + WS_H1B))
#define Qb ((bf16_t*)(ws + WS_Q))
#define ABb ((bf16_t*)(ws + WS_AB))
#define Ub ((bf16_t*)(ws + WS_U))
#define SGA ((bf16_t*)(ws + WS_SGA))
#define SGB ((bf16_t*)(ws + WS_SGB))
#define YA ((bf16_t*)(ws + WS_YA))
#define VB ((bf16_t*)(ws + WS_VB))
#define H1B ((bf16_t*)(ws + WS_H1B))
#define Fb ((bf16_t*)(ws + WS_F))
#define PLEB ((bf16_t*)(ws + WS_R0))
#define PB ((bf16_t*)(ws + WS_PB))
    float* out = a.out;

    if (IN(0)) {
        LAS float* scr = (LAS float*)(lds + wave * 16640);
        const int gw = bx * NWAVES + wave, NGW = G * NWAVES;
        constexpr int I0 = 32 * 144;
        for (int it = wave * G + bx; it < I0; it += NGW) tr_item(a.in[3], DM, NIN, a.in[2], Win, 1, it, scr, lane);
        for (int row = gw; row < SEQ; row += NGW) {
            const f32x4* xr = (const f32x4*)(a.in[0] + (size_t)row * DM) + lane; f32x4 v[8]; float s = 0.f;
#pragma unroll
            for (int j = 0; j < 8; ++j) { v[j] = xr[64 * j]; s += dot4(v[j]); }
            s = wave_sum(s);
            if (lane == 0) rstd1[row] = rsqrtf(s * (1.0f / DM) + EPS);
            u32x2* o = (u32x2*)(XB + (size_t)row * DM) + lane;
#pragma unroll
            for (int j = 0; j < 8; ++j) { u32x2 w; w.x = cvt_pk_bf16(v[j][0], v[j][1]); w.y = cvt_pk_bf16(v[j][2], v[j][3]); o[64 * j] = w; }
        }
        for (int c = gw; c < SEQ * PLE / 512; c += NGW) {
            const f32x4* pr = (const f32x4*)(a.in[1] + (size_t)c * 512) + 2 * lane; const f32x4 v0 = pr[0], v1 = pr[1];
            st_bf16x8(PB + (size_t)c * 512 + 8 * lane, v0, v1);
        }
        for (int i = bx * NTHR + tid; i < SEQ; i += G * NTHR) { ssq2[i] = 0.f; ssq3[i] = 0.f; ssq4[i] = 0.f; }
        __syncthreads();
    }
    SEAM(0);
    if (IN(1)) {
        pg8::Gemm g{XB, Win, SEQ, NIN, DM}; pg8::StaticOrder S; S.init(SEQ, NIN, G, bx);
        EpiProj E{rstd1, a.in[6], Qb, ABb, Ub, SGA, SGB};
        pg8::gemm_phase<EpiProj, pg8::StaticOrder, true, true>(lds, g, S, E);
        const int rem = ((SEQ / 256) * (NIN / 256)) % G;
        if (rem == 0 || bx >= rem) {
            const int NS = rem ? G - rem : G, sb = rem ? bx - rem : bx;
            LAS float* scr = (LAS float*)(lds + wave * 16640);
            constexpr int I1 = 16 * 32, I2 = 16 * 32, I3 = 32 * 32, I4 = 32 * 88, I5 = 32 * 88, I8 = 4 * 32;
            for (int it = sb * NWAVES + wave; it < I1 + I2 + I3 + I4 + I5 + I8; it += NS * NWAVES) {
                int r = it;
                if (r < I8) { tr_item(a.in[20], PLE, DM, nullptr, Wpp, 0, r, scr, lane); continue; } r -= I8;
                if (r < I1) { tr_item(a.in[5], CW, DM, nullptr, Woa, 0, r, scr, lane); continue; } r -= I1;
                if (r < I2) { tr_item(a.in[11], CW, DM, nullptr, Wpw, 0, r, scr, lane); continue; } r -= I2;
                if (r < I3) { tr_item(a.in[13], DM, DM, nullptr, Wo, 0, r, scr, lane); continue; } r -= I3;
                if (r < I4) { tr_item(a.in[15], DM, DFF, a.in[14], Wgu, 2, r, scr, lane); continue; } r -= I4;
                tr_item(a.in[16], DM, DFF, a.in[14], Wgu, 3, r, scr, lane);
            }
            __syncthreads();
        }
    }
    SEAM(1);
    if (IN(2)) {
        const int c0 = 2 * tid;
        float wa0[3], wa1[3], wb0[31], wb1[31];
#pragma unroll
        for (int k = 0; k < 3; ++k) { const f32x2 w = *(const f32x2*)(a.in[4] + k * CW + c0); wa0[k] = w.x; wa1[k] = w.y; }
#pragma unroll
        for (int k = 0; k < 31; ++k) { const f32x2 w = *(const f32x2*)(a.in[7] + k * CW + c0); wb0[k] = w.x; wb1[k] = w.y; }
        const f32x2 cb = *(const f32x2*)(a.in[8] + c0), lg = *(const f32x2*)(a.in[9] + c0), lb = *(const f32x2*)(a.in[10] + c0);
        LAS float* P = (LAS float*)lds; LAS float* St = (LAS float*)(lds + 65536);
        for (int tile = bx; tile < SEQ / 16; tile += G) {
            const int t0 = tile * 16;
            {
                float q0[18], q1[18];
#pragma unroll
                for (int j = 0; j < 18; ++j) { const int ts = t0 - 2 + j; unsigned w = 0u; if (ts >= 0) w = *(const unsigned*)(Qb + (size_t)ts * CW + c0); q0[j] = bf_lo(w); q1[j] = bf_hi(w); }
#pragma unroll
                for (int i = 0; i < 16; ++i) { const unsigned w = *(const unsigned*)(ABb + (size_t)(t0 + i) * CW + c0);
                    const float y0 = bf_lo(w) * (wa0[0] * q0[i] + wa0[1] * q0[i + 1] + wa0[2] * q0[i + 2]);
                    const float y1 = bf_hi(w) * (wa1[0] * q1[i] + wa1[1] * q1[i + 1] + wa1[2] * q1[i + 2]);
                    *(unsigned*)(YA + (size_t)(t0 + i) * CW + c0) = cvt_pk_bf16(y0, y1); }
            }
            float acc0[16], acc1[16];
#pragma unroll
            for (int i = 0; i < 16; ++i) { acc0[i] = cb.x; acc1[i] = cb.y; }
#pragma unroll
            for (int s = 0; s < 46; ++s) { const int ts = t0 - 30 + s; unsigned w = 0u; if (ts >= 0) w = *(const unsigned*)(Ub + (size_t)ts * CW + c0);
                const float u0 = bf_lo(w), u1 = bf_hi(w);
#pragma unroll
                for (int i = 0; i < 16; ++i) { const int k = s - i; if (k >= 0 && k <= 30) { acc0[i] += wb0[k] * u0; acc1[i] += wb1[k] * u1; } } }
#pragma unroll
            for (int i = 0; i < 16; ++i) { P[(2 * i) * NTHR + tid] = acc0[i] + acc1[i]; P[(2 * i + 1) * NTHR + tid] = acc0[i] * acc0[i] + acc1[i] * acc1[i]; }
            __syncthreads();
#pragma unroll
            for (int r = 0; r < 4; ++r) { const int row = 4 * wave + r; float s = 0.f;
#pragma unroll
                for (int j = 0; j < 8; ++j) s += P[row * NTHR + lane + 64 * j];
                s = wave_sum(s); if (lane == 0) St[row] = s; }
            __syncthreads();
#pragma unroll
            for (int i = 0; i < 16; ++i) { const float mean = St[2 * i] * (1.0f / CW), var = St[2 * i + 1] * (1.0f / CW) - mean * mean, rs = rsqrtf(fmaxf(var, 0.f) + LN_EPS);
                const float v0 = (acc0[i] - mean) * rs * lg.x + lb.x, v1 = (acc1[i] - mean) * rs * lg.y + lb.y;
                *(unsigned*)(VB + (size_t)(t0 + i) * CW + c0) = cvt_pk_bf16(v0 * sigm(v0), v1 * sigm(v1)); }
        }
        __syncthreads();
    }
    SEAM(2);
    if (IN(3)) {
        pg8::StaticOrder S; S.init(SEQ, DM, G, bx);
        { pg8::Gemm g{YA, Woa, SEQ, DM, CW}; EpiM1 E{SGA, out}; pg8::gemm_phase<EpiM1, pg8::StaticOrder, true, true>(lds, g, S, E); }
        { pg8::Gemm g{VB, Wpw, SEQ, DM, CW}; EpiM E{SGB, out, a.in[12], MB}; pg8::gemm_phase<EpiM, pg8::StaticOrder, true, true>(lds, g, S, E); }
    }
    SEAM(3);
    if (IN(4)) {
        pg8::Gemm g{MB, Wo, SEQ, DM, DM}; pg8::StaticOrder S; S.init(SEQ, DM, G, bx);
        EpiRes<false, false, true, false> E{a.in[0], nullptr, nullptr, H1B, ssq2, nullptr, nullptr};
        pg8::gemm_phase<EpiRes<false, false, true, false>, pg8::StaticOrder, true, true>(lds, g, S, E);
    }
    SEAM(4);
    if (IN(5)) {
        pg8::Gemm g{H1B, Wgu, SEQ, 2 * DFF, DM}; pg8::StaticOrder S; S.init(SEQ, 2 * DFF, G, bx);
        EpiSwiglu E{ssq2, Fb};
        pg8::gemm_phase<EpiSwiglu, pg8::StaticOrder, true, true>(lds, g, S, E);
        const int rem = ((SEQ / 256) * (2 * DFF / 256)) % G;
        if (rem == 0 || bx >= rem) {
            const int NS = rem ? G - rem : G, sb = rem ? bx - rem : bx;
            { pg8::Gemm g2{PB, Wpp, SEQ, DM, PLE}; pg8::StaticOrder S2; S2.init(SEQ, DM, NS, sb); EpiPle E2{PLEB};
              pg8::gemm_phase<EpiPle, pg8::StaticOrder, true, true>(lds, g2, S2, E2); }
            LAS float* scr = (LAS float*)(lds + wave * 16640);
            constexpr int I6 = 88 * 32, I7 = 32 * 32;
            for (int it = sb * NWAVES + wave; it < I6 + I7; it += NS * NWAVES) {
                if (it < I6) tr_item(a.in[17], DFF, DM, nullptr, Wdn, 0, it, scr, lane);
                else tr_item(a.in[19], DM, DM, a.in[18], Wpg, 0, it - I6, scr, lane);
            }
            __syncthreads();
        }
    }
    SEAM(5);
    if (IN(6)) {
        pg8::Gemm g{Fb, Wdn, SEQ, DM, DFF}; pg8::StaticOrder S; S.init(SEQ, DM, G, bx);
        EpiRes<true, false, true, false> E{nullptr, H1B, nullptr, H2B, ssq3, nullptr, nullptr};
        pg8::gemm_phase<EpiRes<true, false, true, false>, pg8::StaticOrder, true, true>(lds, g, S, E);
    }
    SEAM(6);
    const bool fuse8 = FUSE_P8 && lo <= 7 && 8 < hi && G == (SEQ / 256) * (DM / 256);
    if (IN(7)) {
        pg8::StaticOrder S; S.init(SEQ, DM, G, bx); pg8::Gemm g{H2B, Wpg, SEQ, DM, DM};
        if (fuse8) { EpiFinal E{H2B, out, ssq4, ssq3, PLEB, a.in[21], (unsigned*)(ws + WS_CNT), (unsigned)(DM / 256)};
            pg8::gemm_phase<EpiFinal, pg8::StaticOrder, false, true>(lds, g, S, E); }
        else { EpiRes<true, true, false, true> E{nullptr, H2B, out, nullptr, ssq4, ssq3, PLEB};
            pg8::gemm_phase<EpiRes<true, true, false, true>, pg8::StaticOrder, true, true>(lds, g, S, E); }
    }
    if (!fuse8) {
    SEAM(7);
    if (IN(8)) {
        const int gw = bx * NWAVES + wave, NGW = G * NWAVES;
        const f32x4* gf = (const f32x4*)a.in[21] + lane;
        for (int row = gw; row < SEQ; row += NGW) {
            f32x4* o = (f32x4*)(out + (size_t)row * DM) + lane; const float r = rsqrtf(ssq4[row] * (1.0f / DM) + EPS);
#pragma unroll
            for (int j = 0; j < 8; ++j) o[64 * j] = o[64 * j] * r * gf[64 * j];
        }
    }
    }
#undef IN
#undef SEAM
}

extern "C" void kernel_launch(void* const* d_in, const int* in_sizes, int n_in, void* d_out, int out_size, void* d_ws, size_t ws_size, hipStream_t stream) {
    static int grid = 0;
    if (grid == 0) {
        if (n_in != 22 || out_size != SEQ * DM || ws_size < WS_END) { fprintf(stderr, "kernel_launch: unexpected shapes (n_in %d, out %d, ws %zu)\n", n_in, out_size, ws_size); grid = -1; return; }
        int dev = 0, cus = 0, per_cu = 0;
        if (hipGetDevice(&dev) != hipSuccess || hipDeviceGetAttribute(&cus, hipDeviceAttributeMultiprocessorCount, dev) != hipSuccess) { grid = -1; return; }
        if (hipFuncSetAttribute((const void*)fwd_kernel, hipFuncAttributeMaxDynamicSharedMemorySize, LDS_BYTES) != hipSuccess) { fprintf(stderr, "kernel_launch: hipFuncSetAttribute failed\n"); grid = -1; return; }
        if (hipOccupancyMaxActiveBlocksPerMultiprocessor(&per_cu, (const void*)fwd_kernel, NTHR, LDS_BYTES) != hipSuccess || per_cu < 1) { fprintf(stderr, "kernel_launch: occupancy query says %d\n", per_cu); per_cu = 1; }
        (void)hipGetLastError();
        grid = cus;
    }
    if (grid < 0) return;
    Args a{};
    for (int i = 0; i < 22; ++i) a.in[i] = (const float*)d_in[i];
    a.out = (float*)d_out; a.ws = (unsigned char*)d_ws;
#if MK_LAUNCHES == 1
    a.ph_lo = 0; a.ph_hi = NPHASE; a.coop = 1;
    if (hipMemsetAsync((char*)d_ws + WS_BAR, 0, WS_CTL_END - WS_BAR, stream) != hipSuccess) { fprintf(stderr, "kernel_launch: memset of the control words failed\n"); return; }
    void* args[] = {&a};
    hipError_t e = hipLaunchCooperativeKernel((const void*)fwd_kernel, dim3(grid), dim3(NTHR), args, LDS_BYTES, stream);
    if (e != hipSuccess) fprintf(stderr, "kernel_launch: cooperative launch failed: %s (grid %d)\n", hipGetErrorString(e), grid);
#else
    for (int ph = 0; ph < NPHASE; ++ph) { a.ph_lo = ph; a.ph_hi = ph + 1; a.coop = 0; hipLaunchKernelGGL(fwd_kernel, dim3(grid), dim3(NTHR), LDS_BYTES, stream, a); }
#endif
}
```

```cpp
#include <hip/hip_runtime.h>
#include <hip/hip_cooperative_groups.h>
#include <cstdio>
#include <cstdint>
namespace cg = cooperative_groups;
namespace pg8 {
#define PG8_LAS __attribute__((address_space(3)))
typedef unsigned short bf16_t;
typedef short bf16x8 __attribute__((ext_vector_type(8)));
typedef float f32x4 __attribute__((ext_vector_type(4)));
typedef unsigned u32x4 __attribute__((ext_vector_type(4)));
constexpr int BM = 256, BK = 64, HALF = 128, HTB = HALF * BK * 2  , STAGE_BYTES = 8 * HTB, NXCD = 8, WGM = 8;

__host__ __device__ __forceinline__ int lds_byte(int r, int c) { const int st = (r >> 4) * 2 + (c >> 5), rr = r & 15, cc = c & 31, ob = rr * 64 + cc * 2; return st * 1024 + (ob ^ (((ob >> 9) & 1) << 5)); }
__host__ __device__ __forceinline__ void stage_rc(int b, int& R, int& C) { const int st = b / 1024, sb = b % 1024, swz = sb ^ (((sb >> 9) & 1) << 5); R = (st >> 1) * 16 + swz / 64; C = (st & 1) * 32 + (swz % 64) / 2; }
__host__ __device__ __forceinline__ int perm32(int rho) { const int n = rho >> 4, i = rho & 15; return 8 * (i >> 2) + 4 * n + (i & 3); }

struct Unit { int pm, pn; };
struct Gemm { const bf16_t* A; const bf16_t* Bt; int M, N, K; };

struct StaticOrder {
    int nM, nN, nwg, G, c;
    __host__ __device__ void init(int M, int N, int G_, int c_) { nM = M / BM; nN = N / BM; nwg = nM * nN; G = G_; c = c_; }
    __host__ __device__ bool next(int i, Unit& u) const {
        const long L = (long)i * G + c; if (L >= nwg) return false;
        int wgid = (int)L; { const int q = nwg / NXCD, r = nwg % NXCD, xcd = wgid % NXCD, off = wgid / NXCD; wgid = (xcd < r ? xcd * (q + 1) : r * (q + 1) + (xcd - r) * q) + off; }
        const int nig = WGM * nN, gid = wgid / nig, fm = gid * WGM, gsz = (nM - fm) < WGM ? (nM - fm) : WGM;
        u.pm = fm + ((wgid % nig) % gsz); u.pn = (wgid % nig) / gsz; return true;
    }
    __device__ __forceinline__ void a_ready(const Unit&) const {}
    __device__ __forceinline__ void done(const Unit&) const {}
};

__device__ __forceinline__ unsigned cvt_pk_bf16(float lo, float hi) { unsigned r; asm volatile("v_cvt_pk_bf16_f32 %0, %1, %2" : "=v"(r) : "v"(lo), "v"(hi)); return r; }
typedef float f32x2 __attribute__((ext_vector_type(2)));
template <class Epi, class Sched, bool ALIGN_EPI = false, bool SP2 = false>
__device__ __forceinline__ void gemm_phase(PG8_LAS unsigned char* lds, const Gemm g, const Sched& S, const Epi& E) {
    const int tid = threadIdx.x, wid = __builtin_amdgcn_readfirstlane(tid >> 6), lane = tid & 63, wr = wid >> 2, wc = wid & 3, fr = lane & 15, fq = lane >> 4;
    const int K = g.K, nt = K / BK;
    unsigned voffA[2], voffB[2];
#pragma unroll
    for (int i = 0; i < 2; ++i) { int R, C; stage_rc(tid * 16 + i * 8192, R, C); const int Rb = Epi::PERM ? ((R & ~31) + perm32(R & 31)) : R;
        voffA[i] = (unsigned)(R * K + C) * 2u; voffB[i] = (unsigned)(Rb * K + C) * 2u; }
    const size_t kstep = (size_t)(BK * 2);
    const size_t hstep = (size_t)HALF * K * 2;
    const size_t tstep = 2 * hstep;
    const unsigned ldsw = (unsigned)wid * 1024u;
    const int aoff = lds_byte(wr * 64 + fr, fq * 8), boff = lds_byte(wc * 32 + fr, fq * 8);
#define PG8_SA(b, h) (((b) * 2 + (h)) * HTB)
#define PG8_SB(b, h) ((4 + (b) * 2 + (h)) * HTB)
#define PG8_STAGE(bufoff, gbase, voff) do { _Pragma("unroll") for (int _i = 0; _i < 2; ++_i) \
        __builtin_amdgcn_global_load_lds((const unsigned*)((const char*)(gbase) + (voff)[_i]), (PG8_LAS unsigned*)(lds + (bufoff) + ldsw + _i * 8192), 16, 0, 0); } while (0)
#define PG8_LDA(dst, b, h) do { _Pragma("unroll") for (int m = 0; m < 4; ++m) _Pragma("unroll") for (int k = 0; k < 2; ++k) dst[m][k] = *(const PG8_LAS bf16x8*)(lds + PG8_SA(b, h) + aoff + m * 2048 + k * 1024); } while (0)
#define PG8_LDB(dst, b, h) do { _Pragma("unroll") for (int n = 0; n < 2; ++n) _Pragma("unroll") for (int k = 0; k < 2; ++k) dst[n][k] = *(const PG8_LAS bf16x8*)(lds + PG8_SB(b, h) + boff + n * 2048 + k * 1024); } while (0)
#define PG8_MMA(ai, bj, At, Bt) do { __builtin_amdgcn_s_setprio(1); _Pragma("unroll") for (int m = 0; m < 4; ++m) _Pragma("unroll") for (int n = 0; n < 2; ++n) _Pragma("unroll") for (int k = 0; k < 2; ++k) \
        acc[ai][bj][m][n] = __builtin_amdgcn_mfma_f32_16x16x32_bf16(Bt[n][k], At[m][k], acc[ai][bj][m][n], 0, 0, 0); __builtin_amdgcn_s_setprio(0); } while (0)
#define PG8_WAIT_V(n) asm volatile("s_waitcnt vmcnt(" #n ")" ::: "memory")
#define PG8_WAIT_L(n) asm volatile("s_waitcnt lgkmcnt(" #n ")" ::: "memory")
#define PG8_BAR __builtin_amdgcn_s_barrier()
#define PG8_SCHED __builtin_amdgcn_sched_barrier(0)
    Unit cur, nxt; int ui = 0;
    if (!S.next(0, cur)) return;
    f32x4 acc[2][2][4][2];
#pragma unroll
    for (int a = 0; a < 2; ++a)
#pragma unroll
        for (int b = 0; b < 2; ++b)
#pragma unroll
            for (int m = 0; m < 4; ++m)
#pragma unroll
                for (int n = 0; n < 2; ++n) acc[a][b][m][n] = (f32x4){0.f, 0.f, 0.f, 0.f};
    bf16x8 At[4][2], B0[2][2], B1[2][2];
    const char* cA = (const char*)g.A + (size_t)cur.pm * tstep; const char* cB = (const char*)g.Bt + (size_t)cur.pn * tstep;
    S.a_ready(cur);
    if constexpr (SP2) {
        PG8_STAGE(PG8_SB(0, 0), cB, voffB); PG8_STAGE(PG8_SB(0, 1), cB + hstep, voffB); PG8_STAGE(PG8_SA(0, 0), cA, voffA); PG8_STAGE(PG8_SA(0, 1), cA + hstep, voffA);
        if (wr == 1) PG8_BAR;
        PG8_WAIT_V(2); PG8_BAR;
        PG8_STAGE(PG8_SB(1, 0), cB + kstep, voffB); PG8_STAGE(PG8_SA(1, 0), cA + kstep, voffA); PG8_STAGE(PG8_SB(1, 1), cB + hstep + kstep, voffB);
        PG8_WAIT_V(6); PG8_BAR;
    } else {
        PG8_STAGE(PG8_SB(0, 0), cB, voffB); PG8_STAGE(PG8_SA(0, 0), cA, voffA); PG8_STAGE(PG8_SB(0, 1), cB + hstep, voffB); PG8_STAGE(PG8_SA(0, 1), cA + hstep, voffA);
        if (wr == 1) PG8_BAR;
        PG8_WAIT_V(4); PG8_BAR;
        PG8_STAGE(PG8_SB(1, 0), cB + kstep, voffB); PG8_STAGE(PG8_SA(1, 0), cA + kstep, voffA); PG8_STAGE(PG8_SB(1, 1), cB + hstep + kstep, voffB);
        PG8_WAIT_V(6); PG8_BAR;
    }
    for (;;) {
        const bool has_next = S.next(ui + 1, nxt);
        const char* nA = has_next ? (const char*)g.A + (size_t)nxt.pm * tstep : cA; const char* nB = has_next ? (const char*)g.Bt + (size_t)nxt.pn * tstep : cB;
#pragma unroll 1
        for (int t = 0; t < nt; t += 2) {
            if constexpr (Epi::MIDT > 0) { if (t == Epi::MIDT) E.mid(acc, cur, wr, wc, fr, fq); }
            const bool last = (t == nt - 2);
            const char* a1 = cA + (size_t)(t + 1) * kstep;
            const char* a2 = last ? nA : cA + (size_t)(t + 2) * kstep; const char* b2 = last ? nB : cB + (size_t)(t + 2) * kstep;
            const char* a3 = a2 + kstep; const char* b3 = b2 + kstep;
            if (last && has_next) S.a_ready(nxt);
            if constexpr (SP2) {
            PG8_LDB(B0, 0, 0); PG8_LDB(B1, 0, 1); PG8_SCHED; PG8_LDA(At, 0, 0); PG8_STAGE(PG8_SA(1, 1), a1 + hstep, voffA);
            PG8_WAIT_V(8); PG8_WAIT_L(0); PG8_BAR; PG8_MMA(0, 0, At, B0); PG8_MMA(0, 1, At, B1); PG8_BAR; PG8_SCHED;
            PG8_LDA(At, 0, 1); PG8_STAGE(PG8_SB(0, 0), b2, voffB); PG8_STAGE(PG8_SB(0, 1), b2 + hstep, voffB); PG8_STAGE(PG8_SA(0, 0), a2, voffA);
            PG8_WAIT_V(8); PG8_WAIT_L(0); PG8_BAR; PG8_MMA(1, 0, At, B0); PG8_MMA(1, 1, At, B1); PG8_BAR; PG8_SCHED;
            PG8_LDB(B0, 1, 0); PG8_LDB(B1, 1, 1); PG8_SCHED; PG8_LDA(At, 1, 0); PG8_STAGE(PG8_SA(0, 1), a2 + hstep, voffA);
            PG8_WAIT_V(8); PG8_WAIT_L(0); PG8_BAR; PG8_MMA(0, 0, At, B0); PG8_MMA(0, 1, At, B1); PG8_BAR; PG8_SCHED;
            PG8_LDA(At, 1, 1); PG8_STAGE(PG8_SB(1, 0), b3, voffB); PG8_STAGE(PG8_SB(1, 1), b3 + hstep, voffB); PG8_STAGE(PG8_SA(1, 0), a3, voffA);
            PG8_WAIT_V(8); PG8_WAIT_L(0); PG8_BAR; PG8_MMA(1, 0, At, B0); PG8_MMA(1, 1, At, B1); PG8_BAR; PG8_SCHED;
            } else {
            PG8_LDB(B0, 0, 0); PG8_SCHED; PG8_LDA(At, 0, 0); PG8_STAGE(PG8_SA(1, 1), a1 + hstep, voffA);
            PG8_WAIT_L(8); PG8_BAR; PG8_WAIT_L(0); PG8_MMA(0, 0, At, B0); PG8_BAR; PG8_SCHED;
            PG8_LDB(B1, 0, 1); PG8_STAGE(PG8_SB(0, 0), b2, voffB);
            PG8_BAR; PG8_WAIT_L(0); PG8_MMA(0, 1, At, B1); PG8_BAR;
            PG8_LDA(At, 0, 1); PG8_STAGE(PG8_SA(0, 0), a2, voffA);
            PG8_BAR; PG8_WAIT_L(0); PG8_MMA(1, 0, At, B0); PG8_BAR; PG8_SCHED;
            PG8_STAGE(PG8_SB(0, 1), b2 + hstep, voffB);
            PG8_WAIT_V(6); PG8_BAR; PG8_MMA(1, 1, At, B1); PG8_BAR;
            PG8_LDB(B0, 1, 0); PG8_SCHED; PG8_LDA(At, 1, 0); PG8_STAGE(PG8_SA(0, 1), a2 + hstep, voffA);
            PG8_WAIT_L(8); PG8_BAR; PG8_WAIT_L(0); PG8_MMA(0, 0, At, B0); PG8_BAR; PG8_SCHED;
            PG8_LDB(B1, 1, 1); PG8_STAGE(PG8_SB(1, 0), b3, voffB);
            PG8_BAR; PG8_WAIT_L(0); PG8_MMA(0, 1, At, B1); PG8_BAR;
            PG8_LDA(At, 1, 1); PG8_STAGE(PG8_SA(1, 0), a3, voffA);
            PG8_BAR; PG8_WAIT_L(0); PG8_MMA(1, 0, At, B0); PG8_BAR; PG8_SCHED;
            PG8_STAGE(PG8_SB(1, 1), b3 + hstep, voffB);
            PG8_WAIT_V(6); PG8_BAR; PG8_MMA(1, 1, At, B1); PG8_BAR;
            }
        }
        if constexpr (ALIGN_EPI) { if (wr == 0) PG8_BAR; }
        if constexpr (!Epi::AFTER_DRAIN) { E(acc, cur, wr, wc, fr, fq); S.done(cur); }
        if (!has_next) break;
#pragma unroll
        for (int a = 0; a < 2; ++a)
#pragma unroll
            for (int b = 0; b < 2; ++b)
#pragma unroll
                for (int m = 0; m < 4; ++m)
#pragma unroll
                    for (int n = 0; n < 2; ++n) acc[a][b][m][n] = (f32x4){0.f, 0.f, 0.f, 0.f};
        cur = nxt; cA = nA; cB = nB; ++ui;
        if constexpr (ALIGN_EPI) { if (wr == 1) PG8_BAR; }
    }
    PG8_WAIT_V(0);
    if constexpr (!ALIGN_EPI) { if (wr == 0) PG8_BAR; }
    PG8_BAR;
    if constexpr (Epi::AFTER_DRAIN) { E.fused(acc, cur, wr, wc, fr, fq, lds, wid, lane); S.done(cur); }
#undef PG8_SA
#undef PG8_SB
#undef PG8_STAGE
#undef PG8_LDA
#undef PG8_LDB
#undef PG8_MMA
#undef PG8_WAIT_V
#undef PG8_WAIT_L
#undef PG8_BAR
#undef PG8_SCHED
}
}

#define LAS __attribute__((address_space(3)))
using pg8::bf16_t; using pg8::f32x4; using pg8::u32x4; using pg8::Unit; using pg8::cvt_pk_bf16;
typedef unsigned u32x2 __attribute__((ext_vector_type(2)));
typedef float f32x2 __attribute__((ext_vector_type(2)));

#ifndef MK_LAUNCHES
#define MK_LAUNCHES 1
#endif
constexpr int SEQ = 8192, DM = 2048, CW = 1024, NIN = 9216, DFF = 5632, PLE = 256;
constexpr float EPS = 1e-6f, LN_EPS = 1e-5f;
constexpr int NWAVES = 8, NTHR = 512, NPHASE = 9;
constexpr int LDS_BYTES = 147456;
constexpr size_t MiB = 1u << 20;
constexpr size_t WS_RSTD1 = 0, WS_SSQ2 = 64 * 1024, WS_SSQ3 = 128 * 1024, WS_SSQ4 = 192 * 1024;
constexpr size_t WS_BAR = 256 * 1024, WS_CNT = 272 * 1024, WS_CTL_END = 280 * 1024;
constexpr int MISC_OFF = 143360;
constexpr size_t WS_WIN = 2 * MiB, WS_WOA = 38 * MiB, WS_WPW = 42 * MiB, WS_WO = 46 * MiB, WS_WGU = 54 * MiB, WS_WDN = 98 * MiB, WS_WPG = 120 * MiB, WS_WPP = 128 * MiB;
constexpr size_t WS_R0 = 130 * MiB;
constexpr size_t WS_Q = 162 * MiB, WS_AB = 178 * MiB, WS_U = 194 * MiB;
constexpr size_t WS_SGA = 210 * MiB, WS_SGB = 242 * MiB;
constexpr size_t WS_YA = 274 * MiB;
constexpr size_t WS_H1B = 162 * MiB;
constexpr size_t WS_F = 194 * MiB;
constexpr size_t WS_PB = 306 * MiB;
constexpr size_t WS_END = 310 * MiB;

__device__ __forceinline__ float sigm(float x) { return __builtin_amdgcn_rcpf(1.f + __expf(-x)); }
__device__ __forceinline__ f32x4 sig4(f32x4 v) { return (f32x4){sigm(v[0]), sigm(v[1]), sigm(v[2]), sigm(v[3])}; }
__device__ __forceinline__ float bf_lo(unsigned w) { return __uint_as_float(w << 16); }
__device__ __forceinline__ float bf_hi(unsigned w) { return __uint_as_float(w & 0xffff0000u); }
__device__ __forceinline__ void st_bf16x8(bf16_t* p, f32x4 v0, f32x4 v1) {
    u32x4 w; w.x = cvt_pk_bf16(v0[0], v0[1]); w.y = cvt_pk_bf16(v0[2], v0[3]); w.z = cvt_pk_bf16(v1[0], v1[1]); w.w = cvt_pk_bf16(v1[2], v1[3]); *(u32x4*)p = w; }
__device__ __forceinline__ void ld_bf16x8(const bf16_t* p, f32x4& v0, f32x4& v1) {
    const u32x4 w = *(const u32x4*)p; v0 = (f32x4){bf_lo(w.x), bf_hi(w.x), bf_lo(w.y), bf_hi(w.y)}; v1 = (f32x4){bf_lo(w.z), bf_hi(w.z), bf_lo(w.w), bf_hi(w.w)}; }
__device__ __forceinline__ float dot4(f32x4 a) { return (a[0] * a[0] + a[1] * a[1]) + (a[2] * a[2] + a[3] * a[3]); }
__device__ __forceinline__ float wave_sum(float v) {
#pragma unroll
    for (int o = 1; o < 64; o <<= 1) v += __shfl_xor(v, o);
    return v;
}

struct EpiProj {
    static constexpr bool PERM = true, AFTER_DRAIN = false; static constexpr int MIDT = 0;
    const float* rstd; const float* bglu; bf16_t *Qo, *ABo, *Uo, *SA, *SB;
    __device__ __forceinline__ void operator()(const f32x4 (&acc)[2][2][4][2], const Unit& u, int wr, int wc, int fr, int fq) const {
        const int pn = u.pn, row0 = u.pm * 256 + wr * 64 + fr, cl = wc * 32 + 8 * fq;
        if (pn < 8) {
#pragma unroll
            for (int ai = 0; ai < 2; ++ai)
#pragma unroll
                for (int m = 0; m < 4; ++m) { const int row = row0 + ai * 128 + m * 16; const float r = rstd[row], r2 = r * r;
                    st_bf16x8(Qo + (size_t)row * CW + pn * 128 + cl, acc[ai][0][m][0] * acc[ai][1][m][0] * r2, acc[ai][0][m][1] * acc[ai][1][m][1] * r2); }
        } else if (pn < 12) {
#pragma unroll
            for (int ai = 0; ai < 2; ++ai)
#pragma unroll
                for (int m = 0; m < 4; ++m) { const int row = row0 + ai * 128 + m * 16; const float r = rstd[row];
#pragma unroll
                    for (int bj = 0; bj < 2; ++bj) st_bf16x8(ABo + (size_t)row * CW + (pn - 8) * 256 + bj * 128 + cl, acc[ai][bj][m][0] * r, acc[ai][bj][m][1] * r); }
        } else if (pn < 20) {
            const int ch = (pn - 12) * 128 + cl;
            const f32x4 bv0 = *(const f32x4*)(bglu + ch), bv1 = *(const f32x4*)(bglu + ch + 4), bg0 = *(const f32x4*)(bglu + CW + ch), bg1 = *(const f32x4*)(bglu + CW + ch + 4);
#pragma unroll
            for (int ai = 0; ai < 2; ++ai)
#pragma unroll
                for (int m = 0; m < 4; ++m) { const int row = row0 + ai * 128 + m * 16; const float r = rstd[row];
                    const f32x4 v0 = acc[ai][0][m][0] * r + bv0, v1 = acc[ai][0][m][1] * r + bv1, g0 = acc[ai][1][m][0] * r + bg0, g1 = acc[ai][1][m][1] * r + bg1;
                    st_bf16x8(Uo + (size_t)row * CW + ch, v0 * sig4(g0), v1 * sig4(g1)); }
        } else {
            const int ch = (pn - 20) * 128 + cl;
#pragma unroll
            for (int ai = 0; ai < 2; ++ai)
#pragma unroll
                for (int m = 0; m < 4; ++m) { const int row = row0 + ai * 128 + m * 16; const float r = rstd[row];
                    f32x4 rt[2], sb[2];
#pragma unroll
                    for (int n = 0; n < 2; ++n)
#pragma unroll
                        for (int e = 0; e < 4; ++e) { const float ga = acc[ai][0][m][n][e] * r, gb = fmaxf(acc[ai][1][m][n][e] * r, -30.f), eb = __expf(-gb);
                            sb[n][e] = __builtin_amdgcn_rcpf(1.f + eb); rt[n][e] = sigm(ga) * (1.f + eb); }
                    st_bf16x8(SA + (size_t)row * DM + ch, rt[0], rt[1]); st_bf16x8(SB + (size_t)row * DM + ch, sb[0], sb[1]); }
        }
    }
};
struct EpiMerge {
    static constexpr bool PERM = true, AFTER_DRAIN = false; static constexpr int MIDT = CW / 64;
    const bf16_t* RT; const bf16_t* SG; const float* bias; bf16_t* Mo;
    __device__ __forceinline__ void mid(f32x4 (&acc)[2][2][4][2], const Unit& u, int wr, int wc, int fr, int fq) const {
        int o = (u.pm * 256 + wr * 64 + fr) * DM + u.pn * 256 + wc * 32 + 8 * fq;
        asm volatile("" : "+v"(o));
        const bf16_t* p = RT + o;
#pragma unroll
        for (int ai = 0; ai < 2; ++ai) {
#pragma unroll
            for (int m = 0; m < 4; ++m)
#pragma unroll
                for (int bj = 0; bj < 2; ++bj) { f32x4 g0, g1; ld_bf16x8(p + (ai * 128 + m * 16) * DM + bj * 128, g0, g1);
                    acc[ai][bj][m][0] = acc[ai][bj][m][0] * g0; acc[ai][bj][m][1] = acc[ai][bj][m][1] * g1; }
            asm volatile("" ::: "memory"); }
    }
    __device__ __forceinline__ void operator()(const f32x4 (&acc)[2][2][4][2], const Unit& u, int wr, int wc, int fr, int fq) const {
        const int row0 = u.pm * 256 + wr * 64 + fr, c0 = u.pn * 256 + wc * 32 + 8 * fq;
        f32x4 bv[2][2];
#pragma unroll
        for (int bj = 0; bj < 2; ++bj) { bv[bj][0] = *(const f32x4*)(bias + c0 + bj * 128); bv[bj][1] = *(const f32x4*)(bias + c0 + bj * 128 + 4); }
#pragma unroll
        for (int ai = 0; ai < 2; ++ai)
#pragma unroll
            for (int m = 0; m < 4; ++m)
#pragma unroll
                for (int bj = 0; bj < 2; ++bj) { const size_t off = (size_t)(row0 + ai * 128 + m * 16) * DM + c0 + bj * 128; f32x4 g0, g1; ld_bf16x8(SG + off, g0, g1);
                    st_bf16x8(Mo + off, g0 * (acc[ai][bj][m][0] + bv[bj][0]), g1 * (acc[ai][bj][m][1] + bv[bj][1])); }
    }
};
template <bool BASE16, bool WF32, bool WB16, bool GATED> struct EpiRes {
    static constexpr bool PERM = true, AFTER_DRAIN = false; static constexpr int MIDT = 0;
    const float* basef; const bf16_t* baseb; float* out; bf16_t* ob; float* ssq_out; const float* ssq_in; const bf16_t* ple;
    __device__ __forceinline__ void operator()(const f32x4 (&acc)[2][2][4][2], const Unit& u, int wr, int wc, int fr, int fq) const {
        const int row0 = u.pm * 256 + wr * 64 + fr, c0 = u.pn * 256 + wc * 32 + 8 * fq;
#pragma unroll
        for (int ai = 0; ai < 2; ++ai)
#pragma unroll
            for (int m = 0; m < 4; ++m) { const int row = row0 + ai * 128 + m * 16; float r = 0.f; if (GATED) r = rsqrtf(ssq_in[row] * (1.0f / DM) + EPS);
                float s = 0.f;
#pragma unroll
                for (int bj = 0; bj < 2; ++bj) { const size_t off = (size_t)row * DM + c0 + bj * 128;
                    f32x4 b0, b1; if (BASE16) ld_bf16x8(baseb + off, b0, b1); else { b0 = *(const f32x4*)(basef + off); b1 = *(const f32x4*)(basef + off + 4); }
                    f32x4 v0 = acc[ai][bj][m][0], v1 = acc[ai][bj][m][1];
                    if (GATED) { f32x4 p0, p1; ld_bf16x8(ple + off, p0, p1); v0 = sig4(v0 * r) * p0; v1 = sig4(v1 * r) * p1; }
                    const f32x4 h0 = b0 + v0, h1 = b1 + v1;
                    if (WF32) { *(f32x4*)(out + off) = h0; *(f32x4*)(out + off + 4) = h1; }
                    if (WB16) st_bf16x8(ob + off, h0, h1);
                    s += dot4(h0) + dot4(h1); }
                s += __shfl_xor(s, 16); s += __shfl_xor(s, 32);
                if (fq == 0) unsafeAtomicAdd(ssq_out + row, s);
                if (m == 3) asm volatile("" ::: "memory"); }
    }
};
struct EpiSwiglu {
    static constexpr bool PERM = true, AFTER_DRAIN = false; static constexpr int MIDT = 0;
    const float* ssq_in; bf16_t* F;
    __device__ __forceinline__ void operator()(const f32x4 (&acc)[2][2][4][2], const Unit& u, int wr, int wc, int fr, int fq) const {
        const int row0 = u.pm * 256 + wr * 64 + fr, ch = u.pn * 128 + wc * 32 + 8 * fq;
#pragma unroll
        for (int ai = 0; ai < 2; ++ai)
#pragma unroll
            for (int m = 0; m < 4; ++m) { const int row = row0 + ai * 128 + m * 16; const float r = rsqrtf(ssq_in[row] * (1.0f / DM) + EPS);
                const f32x4 g0 = acc[ai][0][m][0] * r, g1 = acc[ai][0][m][1] * r, u0 = acc[ai][1][m][0] * r, u1 = acc[ai][1][m][1] * r;
                st_bf16x8(F + (size_t)row * DFF + ch, g0 * sig4(g0) * u0, g1 * sig4(g1) * u1); }
    }
};
struct EpiPle {
    static constexpr bool PERM = true, AFTER_DRAIN = false; static constexpr int MIDT = 0;
    bf16_t* O;
    __device__ __forceinline__ void operator()(const f32x4 (&acc)[2][2][4][2], const Unit& u, int wr, int wc, int fr, int fq) const {
        const int row0 = u.pm * 256 + wr * 64 + fr, c0 = u.pn * 256 + wc * 32 + 8 * fq;
#pragma unroll
        for (int ai = 0; ai < 2; ++ai)
#pragma unroll
            for (int m = 0; m < 4; ++m)
#pragma unroll
                for (int bj = 0; bj < 2; ++bj) st_bf16x8(O + (size_t)(row0 + ai * 128 + m * 16) * DM + c0 + bj * 128, acc[ai][bj][m][0], acc[ai][bj][m][1]);
    }
};

struct EpiFinal {
    static constexpr bool PERM = true, AFTER_DRAIN = true; static constexpr int MIDT = 0;
    const bf16_t* base; float* out; float* ssq_out; const float* ssq_in; const bf16_t* ple; const float* gfin; unsigned* cnt; unsigned want;
    __device__ __forceinline__ void fused(f32x4 (&acc)[2][2][4][2], const Unit& u, int wr, int wc, int fr, int fq, PG8_LAS unsigned char* lds, int wid, int lane) const {
        const int row0 = u.pm * 256 + wr * 64 + fr, c0 = u.pn * 256 + wc * 32 + 8 * fq;
#pragma unroll
        for (int ai = 0; ai < 2; ++ai)
#pragma unroll
            for (int m = 0; m < 4; ++m) { const int row = row0 + ai * 128 + m * 16; const float r = rsqrtf(ssq_in[row] * (1.0f / DM) + EPS);
                float s = 0.f;
#pragma unroll
                for (int bj = 0; bj < 2; ++bj) { const size_t off = (size_t)row * DM + c0 + bj * 128;
                    f32x4 b0, b1; ld_bf16x8(base + off, b0, b1);
                    f32x4 p0, p1; ld_bf16x8(ple + off, p0, p1);
                    const f32x4 h0 = b0 + sig4(acc[ai][bj][m][0] * r) * p0, h1 = b1 + sig4(acc[ai][bj][m][1] * r) * p1;
                    acc[ai][bj][m][0] = h0; acc[ai][bj][m][1] = h1;
                    s += dot4(h0) + dot4(h1); }
                s += __shfl_xor(s, 16); s += __shfl_xor(s, 32);
                if (fq == 0) unsafeAtomicAdd(ssq_out + row, s);
                if (m & 1) asm volatile("" ::: "memory"); }
        asm volatile("s_waitcnt vmcnt(0)" ::: "memory");
        __syncthreads();
        if (threadIdx.x == 0) { unsigned* c = cnt + 64 * u.pm;
            __hip_atomic_fetch_add(c, 1u, __ATOMIC_RELAXED, __HIP_MEMORY_SCOPE_AGENT);
            while (__hip_atomic_load(c, __ATOMIC_RELAXED, __HIP_MEMORY_SCOPE_AGENT) < want) __builtin_amdgcn_s_sleep(2); }
        __syncthreads();
        f32x4 gv[2][2];
#pragma unroll
        for (int bj = 0; bj < 2; ++bj) { gv[bj][0] = *(const f32x4*)(gfin + c0 + bj * 128); gv[bj][1] = *(const f32x4*)(gfin + c0 + bj * 128 + 4); }
#pragma unroll
        for (int ai = 0; ai < 2; ++ai)
#pragma unroll
            for (int m = 0; m < 4; ++m) { const int row = row0 + ai * 128 + m * 16;
                const float rr = rsqrtf(__hip_atomic_load(ssq_out + row, __ATOMIC_RELAXED, __HIP_MEMORY_SCOPE_AGENT) * (1.0f / DM) + EPS);
#pragma unroll
                for (int bj = 0; bj < 2; ++bj) { const size_t off = (size_t)row * DM + c0 + bj * 128;
                    *(f32x4*)(out + off) = acc[ai][bj][m][0] * rr * gv[bj][0]; *(f32x4*)(out + off + 4) = acc[ai][bj][m][1] * rr * gv[bj][1]; } }
    }
};

__device__ __forceinline__ int win_dest(int n0) {
    if (n0 < 1024) return 256 * (n0 >> 7) + (n0 & 127);
    if (n0 < 2048) return 2048 + (n0 - 1024);
    if (n0 < 3072) { const int c = n0 - 2048; return 256 * (c >> 7) + 128 + (c & 127); }
    if (n0 < 4096) { const int c = n0 - 3072; return 3072 + 256 * (c >> 7) + (c & 127); }
    if (n0 < 5120) { const int c = n0 - 4096; return 3072 + 256 * (c >> 7) + 128 + (c & 127); }
    if (n0 < 7168) { const int c = n0 - 5120; return 5120 + 256 * (c >> 7) + (c & 127); }
    { const int c = n0 - 7168; return 5120 + 256 * (c >> 7) + 128 + (c & 127); }
}
__device__ __forceinline__ void tr_item(const float* W, int K, int N, const float* g, bf16_t* WT, int mode, int item, LAS float* scr, int lane, int ldk = 0, int koff = 0) {
    if (ldk == 0) ldk = K;
    const int nblk = N >> 6, kb = item / nblk, nb = item - kb * nblk, k0 = kb << 6, n0 = nb << 6;
    int d0 = n0;
    if (mode == 1) d0 = win_dest(n0); else if (mode == 2) d0 = 256 * (n0 >> 7) + (n0 & 127); else if (mode == 3) d0 = 256 * (n0 >> 7) + 128 + (n0 & 127);
    const int kr = lane >> 4, col = 4 * (lane & 15);
    f32x4 v[16];
#pragma unroll
    for (int i = 0; i < 16; ++i) v[i] = *(const f32x4*)(W + (size_t)(k0 + 4 * i + kr) * N + n0 + col);
    if (g) {
#pragma unroll
        for (int i = 0; i < 16; ++i) v[i] = v[i] * g[k0 + 4 * i + kr];
    }
#pragma unroll
    for (int i = 0; i < 16; ++i) { LAS float* s = scr + (4 * i + kr) * 65 + col; s[0] = v[i][0]; s[1] = v[i][1]; s[2] = v[i][2]; s[3] = v[i][3]; }
    asm volatile("s_waitcnt lgkmcnt(0)" ::: "memory");
    const int c = lane & 7;
#pragma unroll
    for (int j = 0; j < 8; ++j) { const int n = (lane >> 3) + 8 * j; const LAS float* s = scr + (8 * c) * 65 + n;
        u32x4 o; o.x = cvt_pk_bf16(s[0], s[65]); o.y = cvt_pk_bf16(s[2 * 65], s[3 * 65]); o.z = cvt_pk_bf16(s[4 * 65], s[5 * 65]); o.w = cvt_pk_bf16(s[6 * 65], s[7 * 65]);
        *(u32x4*)(WT + (size_t)(d0 + n) * ldk + koff + k0 + 8 * c) = o; }
    asm volatile("s_waitcnt lgkmcnt(0)" ::: "memory");
}

#ifndef USE_XCDBAR
#define USE_XCDBAR 1
#endif
#ifndef FUSE_P8
#define FUSE_P8 1
#endif
#define XB_TMO      128
#define XB_XCNT(j)  (256  + 64 * (j))
#define XB_XSUB(j)  (1280 + 64 * (j))
#define XB_XGEN(j)  (2304 + 64 * (j))
#define XB_TOP      3328
#define XB_TOPGEN   3392
#define XCD_BAR_WORDS 3456
#define XB_SPIN_CAP (1u << 18)

__device__ __forceinline__ unsigned xb_ld(unsigned* p)              { return __hip_atomic_load(p, __ATOMIC_RELAXED, __HIP_MEMORY_SCOPE_AGENT); }
__device__ __forceinline__ unsigned xb_add(unsigned* p, unsigned v) { return __hip_atomic_fetch_add(p, v, __ATOMIC_RELAXED, __HIP_MEMORY_SCOPE_AGENT); }
__device__ __forceinline__ unsigned xb_xcc_id() { return (unsigned)__builtin_amdgcn_s_getreg((3 << 11) | 20) & 0xFu; }
#define XB_SPIN(cond, bar) do { unsigned _sp = 0; while (cond) { __builtin_amdgcn_s_sleep(1); \
    if ((++_sp & 255u) == 0u) { if (xb_ld(&(bar)[XB_TMO])) break; if (_sp > XB_SPIN_CAP) { atomicAdd(&(bar)[XB_TMO], 1u); break; } } } } while (0)

struct XcdBarrier {
    unsigned* bar; unsigned x;
    volatile LAS unsigned* st;
};

__device__ __forceinline__ XcdBarrier xcd_barrier_post(unsigned* bar, volatile LAS unsigned* st) {
    XcdBarrier b; b.bar = bar; b.x = xb_xcc_id(); b.st = st;
    if (threadIdx.x == 0) (void)xb_add(&bar[XB_XCNT(b.x)], 1u);
    return b;
}
__device__ __forceinline__ void xcd_barrier_complete(unsigned* bar, unsigned x, unsigned& nloc, unsigned& nx) {
    const unsigned G = gridDim.x * gridDim.y * gridDim.z;
    unsigned sum, cnt, mine, sp = 0u;
    for (;;) {
        sum = 0u; cnt = 0u; mine = 0u;
#pragma unroll
        for (unsigned j = 0; j < 16; ++j) { const unsigned c = xb_ld(&bar[XB_XCNT(j)]); sum += c; cnt += (c > 0u) ? 1u : 0u; mine = (j == x) ? c : mine; }
        if (sum == G) break;
        __builtin_amdgcn_s_sleep(1);
        if ((++sp & 255u) == 0u) { if (xb_ld(&bar[XB_TMO])) break; if (sp > XB_SPIN_CAP) { atomicAdd(&bar[XB_TMO], 1u); break; } }
    }
    nloc = mine > 0u ? mine : 1u; nx = cnt > 0u ? cnt : 1u;
}

__device__ __forceinline__ void xcd_barrier(const XcdBarrier& b) {
    asm volatile("s_waitcnt vmcnt(0)" ::: "memory");
    __syncthreads();
    if (threadIdx.x == 0) {
        unsigned* bar = b.bar;
        __builtin_amdgcn_s_waitcnt(0);
        unsigned nloc = b.st[0], nx = b.st[1];
        if (nloc == 0u) { xcd_barrier_complete(bar, b.x, nloc, nx); b.st[0] = nloc; b.st[1] = nx; }
        const unsigned old = xb_add(&bar[XB_XSUB(b.x)], 1u);
        const unsigned gen = old / nloc;
        if (old + 1u == (gen + 1u) * nloc) {
            __builtin_amdgcn_fence(__ATOMIC_RELEASE, "agent");
            asm volatile("s_waitcnt vmcnt(0)" ::: "memory");
            const unsigned og = xb_add(&bar[XB_TOP], 1u);
            const unsigned tg = og / nx;
            if (og + 1u == (tg + 1u) * nx) xb_add(&bar[XB_TOPGEN], 1u);
            else XB_SPIN(xb_ld(&bar[XB_TOPGEN]) == tg, bar);
            __builtin_amdgcn_fence(__ATOMIC_ACQUIRE, "agent");
            xb_add(&bar[XB_XGEN(b.x)], 1u);
            asm volatile("s_waitcnt vmcnt(0)" ::: "memory");
        } else {
            XB_SPIN(xb_ld(&bar[XB_XGEN(b.x)]) == gen, bar);
            __builtin_amdgcn_fence(__ATOMIC_ACQUIRE, "agent");
            asm volatile("s_waitcnt vmcnt(0)" ::: "memory");
        }
    }
    __syncthreads();
}

struct Args { const float* in[22]; float* out; unsigned char* ws; int ph_lo, ph_hi, coop, pad; };

__global__ void __launch_bounds__(NTHR, 2) fwd_kernel(Args a) {
    extern __shared__ __attribute__((aligned(16))) unsigned char lds_raw[];
    LAS unsigned char* lds = (LAS unsigned char*)lds_raw;
    cg::grid_group grid = cg::this_grid();
    const int tid = threadIdx.x, lane = tid & 63, wave = __builtin_amdgcn_readfirstlane(tid >> 6);
    const int G = gridDim.x, bx = blockIdx.x;
    unsigned char* ws = a.ws;
    const int lo = a.ph_lo, hi = a.ph_hi;
#ifndef PHMASK
#define PHMASK 0x1ff
#endif
#define IN(k) (lo <= (k) && (k) < hi && ((PHMASK >> (k)) & 1))
#define SEAM(k) do { if (lo <= (k) && (k) + 1 < hi) { if (USE_XCDBAR) xcd_barrier(bar); else grid.sync(); } } while (0)
    if (tid < 2) ((volatile LAS unsigned*)(lds + MISC_OFF))[tid] = 0u;
    __syncthreads();
    XcdBarrier bar; bar.bar = (unsigned*)(ws + WS_BAR); bar.x = 0; bar.st = (volatile LAS unsigned*)(lds + MISC_OFF);
    if (USE_XCDBAR && a.coop) bar = xcd_barrier_post((unsigned*)(ws + WS_BAR), (volatile LAS unsigned*)(lds + MISC_OFF));
    if (a.coop == 2) grid.sync();
#define rstd1 ((float*)(ws + WS_RSTD1))
#define ssq2 ((float*)(ws + WS_SSQ2))
#define ssq3 ((float*)(ws + WS_SSQ3))
#define ssq4 ((float*)(ws + WS_SSQ4))
#define Win ((bf16_t*)(ws + WS_WIN))
#define Woa ((bf16_t*)(ws + WS_WOA))
#define Wo ((bf16_t*)(ws + WS_WO))
#define Wgu ((bf16_t*)(ws + WS_WGU))
#define Wdn ((bf16_t*)(ws + WS_WDN))
#define Wpg ((bf16_t*)(ws + WS_WPG))
#define Wpp ((bf16_t*)(ws + WS_WPP))
#define XB ((bf16_t*)(ws + WS_R0))
#define MB ((bf16_t*)(ws + WS_R0))
#define H2B ((bf16_t*)(ws + WS_H1B))
#define Qb ((bf16_t*)(ws + WS_Q))
#define ABb ((bf16_t*)(ws + WS_AB))
#define Ub ((bf16_t*)(ws + WS_U))
#define SGA ((bf16_t*)(ws + WS_SGA))
#define SGB ((bf16_t*)(ws + WS_SGB))
#define YA ((bf16_t*)(ws + WS_YA))
#define H1B ((bf16_t*)(ws + WS_H1B))
#define Fb ((bf16_t*)(ws + WS_F))
#define PLEB ((bf16_t*)(ws + WS_R0))
#define PB ((bf16_t*)(ws + WS_PB))
    float* out = a.out;

    if (IN(0)) {
        LAS float* scr = (LAS float*)(lds + wave * 16640);
        const int gw = bx * NWAVES + wave, NGW = G * NWAVES;
        constexpr int I0 = 32 * 144;
        for (int it = wave * G + bx; it < I0; it += NGW) tr_item(a.in[3], DM, NIN, a.in[2], Win, 1, it, scr, lane);
        for (int row = gw; row < SEQ; row += NGW) {
            const f32x4* xr = (const f32x4*)(a.in[0] + (size_t)row * DM) + lane; f32x4 v[8]; float s = 0.f;
#pragma unroll
            for (int j = 0; j < 8; ++j) { v[j] = xr[64 * j]; s += dot4(v[j]); }
            s = wave_sum(s);
            if (lane == 0) rstd1[row] = rsqrtf(s * (1.0f / DM) + EPS);
            u32x2* o = (u32x2*)(XB + (size_t)row * DM) + lane;
#pragma unroll
            for (int j = 0; j < 8; ++j) { u32x2 w; w.x = cvt_pk_bf16(v[j][0], v[j][1]); w.y = cvt_pk_bf16(v[j][2], v[j][3]); o[64 * j] = w; }
        }
        for (int c = gw; c < SEQ * PLE / 512; c += NGW) {
            const f32x4* pr = (const f32x4*)(a.in[1] + (size_t)c * 512) + 2 * lane; const f32x4 v0 = pr[0], v1 = pr[1];
            st_bf16x8(PB + (size_t)c * 512 + 8 * lane, v0, v1);
        }
        for (int i = bx * NTHR + tid; i < SEQ; i += G * NTHR) { ssq2[i] = 0.f; ssq3[i] = 0.f; ssq4[i] = 0.f; }
        __syncthreads();
    }
    SEAM(0);
    if (IN(1)) {
        pg8::Gemm g{XB, Win, SEQ, NIN, DM}; pg8::StaticOrder S; S.init(SEQ, NIN, G, bx);
        EpiProj E{rstd1, a.in[6], Qb, ABb, Ub, SGA, SGB};
        pg8::gemm_phase<EpiProj, pg8::StaticOrder, true, true>(lds, g, S, E);
        const int rem = ((SEQ / 256) * (NIN / 256)) % G;
        if (rem == 0 || bx >= rem) {
            const int NS = rem ? G - rem : G, sb = rem ? bx - rem : bx;
            LAS float* scr = (LAS float*)(lds + wave * 16640);
            constexpr int I1 = 16 * 32, I2 = 16 * 32, I3 = 32 * 32, I4 = 32 * 88, I5 = 32 * 88, I8 = 4 * 32;
            for (int it = sb * NWAVES + wave; it < I1 + I2 + I3 + I4 + I5 + I8; it += NS * NWAVES) {
                int r = it;
                if (r < I8) { tr_item(a.in[20], PLE, DM, nullptr, Wpp, 0, r, scr, lane); continue; } r -= I8;
                if (r < I1) { tr_item(a.in[5], CW, DM, nullptr, Woa, 0, r, scr, lane, DM, 0); continue; } r -= I1;
                if (r < I2) { tr_item(a.in[11], CW, DM, nullptr, Woa, 0, r, scr, lane, DM, CW); continue; } r -= I2;
                if (r < I3) { tr_item(a.in[13], DM, DM, nullptr, Wo, 0, r, scr, lane); continue; } r -= I3;
                if (r < I4) { tr_item(a.in[15], DM, DFF, a.in[14], Wgu, 2, r, scr, lane); continue; } r -= I4;
                tr_item(a.in[16], DM, DFF, a.in[14], Wgu, 3, r, scr, lane);
            }
            __syncthreads();
        }
    }
    SEAM(1);
    if (IN(2)) {
        const int c0 = 2 * tid;
        float wa0[3], wa1[3], wb0[31], wb1[31];
#pragma unroll
        for (int k = 0; k < 3; ++k) { const f32x2 w = *(const f32x2*)(a.in[4] + k * CW + c0); wa0[k] = w.x; wa1[k] = w.y; }
#pragma unroll
        for (int k = 0; k < 31; ++k) { const f32x2 w = *(const f32x2*)(a.in[7] + k * CW + c0); wb0[k] = w.x; wb1[k] = w.y; }
        const f32x2 cb = *(const f32x2*)(a.in[8] + c0), lg = *(const f32x2*)(a.in[9] + c0), lb = *(const f32x2*)(a.in[10] + c0);
        LAS float* P = (LAS float*)lds; LAS float* St = (LAS float*)(lds + 65536);
        for (int tile = bx; tile < SEQ / 16; tile += G) {
            const int t0 = tile * 16;
            {
                float q0[18], q1[18];
#pragma unroll
                for (int j = 0; j < 18; ++j) { const int ts = t0 - 2 + j; unsigned w = 0u; if (ts >= 0) w = *(const unsigned*)(Qb + (size_t)ts * CW + c0); q0[j] = bf_lo(w); q1[j] = bf_hi(w); }
#pragma unroll
                for (int i = 0; i < 16; ++i) { const unsigned w = *(const unsigned*)(ABb + (size_t)(t0 + i) * CW + c0);
                    const float y0 = bf_lo(w) * (wa0[0] * q0[i] + wa0[1] * q0[i + 1] + wa0[2] * q0[i + 2]);
                    const float y1 = bf_hi(w) * (wa1[0] * q1[i] + wa1[1] * q1[i + 1] + wa1[2] * q1[i + 2]);
                    *(unsigned*)(YA + (size_t)(t0 + i) * DM + c0) = cvt_pk_bf16(y0, y1); }
            }
            float acc0[16], acc1[16];
#pragma unroll
            for (int i = 0; i < 16; ++i) { acc0[i] = cb.x; acc1[i] = cb.y; }
#pragma unroll
            for (int s = 0; s < 46; ++s) { const int ts = t0 - 30 + s; unsigned w = 0u; if (ts >= 0) w = *(const unsigned*)(Ub + (size_t)ts * CW + c0);
                const float u0 = bf_lo(w), u1 = bf_hi(w);
#pragma unroll
                for (int i = 0; i < 16; ++i) { const int k = s - i; if (k >= 0 && k <= 30) { acc0[i] += wb0[k] * u0; acc1[i] += wb1[k] * u1; } } }
#pragma unroll
            for (int i = 0; i < 16; ++i) { P[(2 * i) * NTHR + tid] = acc0[i] + acc1[i]; P[(2 * i + 1) * NTHR + tid] = acc0[i] * acc0[i] + acc1[i] * acc1[i]; }
            __syncthreads();
#pragma unroll
            for (int r = 0; r < 4; ++r) { const int row = 4 * wave + r; float s = 0.f;
#pragma unroll
                for (int j = 0; j < 8; ++j) s += P[row * NTHR + lane + 64 * j];
                s = wave_sum(s); if (lane == 0) St[row] = s; }
            __syncthreads();
#pragma unroll
            for (int i = 0; i < 16; ++i) { const float mean = St[2 * i] * (1.0f / CW), var = St[2 * i + 1] * (1.0f / CW) - mean * mean, rs = rsqrtf(fmaxf(var, 0.f) + LN_EPS);
                const float v0 = (acc0[i] - mean) * rs * lg.x + lb.x, v1 = (acc1[i] - mean) * rs * lg.y + lb.y;
                *(unsigned*)(YA + (size_t)(t0 + i) * DM + CW + c0) = cvt_pk_bf16(v0 * sigm(v0), v1 * sigm(v1)); }
        }
        __syncthreads();
    }
    SEAM(2);
    if (IN(3)) {
        pg8::StaticOrder S; S.init(SEQ, DM, G, bx);
        { pg8::Gemm g{YA, Woa, SEQ, DM, DM}; EpiMerge E{SGA, SGB, a.in[12], MB}; pg8::gemm_phase<EpiMerge, pg8::StaticOrder, true, true>(lds, g, S, E); }
    }
    SEAM(3);
    if (IN(4)) {
        pg8::Gemm g{MB, Wo, SEQ, DM, DM}; pg8::StaticOrder S; S.init(SEQ, DM, G, bx);
        EpiRes<false, false, true, false> E{a.in[0], nullptr, nullptr, H1B, ssq2, nullptr, nullptr};
        pg8::gemm_phase<EpiRes<false, false, true, false>, pg8::StaticOrder, true, true>(lds, g, S, E);
    }
    SEAM(4);
    if (IN(5)) {
        pg8::Gemm g{H1B, Wgu, SEQ, 2 * DFF, DM}; pg8::StaticOrder S; S.init(SEQ, 2 * DFF, G, bx);
        EpiSwiglu E{ssq2, Fb};
        pg8::gemm_phase<EpiSwiglu, pg8::StaticOrder, true, true>(lds, g, S, E);
        const int rem = ((SEQ / 256) * (2 * DFF / 256)) % G;
        if (rem == 0 || bx >= rem) {
            const int NS = rem ? G - rem : G, sb = rem ? bx - rem : bx;
            { pg8::Gemm g2{PB, Wpp, SEQ, DM, PLE}; pg8::StaticOrder S2; S2.init(SEQ, DM, NS, sb); EpiPle E2{PLEB};
              pg8::gemm_phase<EpiPle, pg8::StaticOrder, true, true>(lds, g2, S2, E2); }
            LAS float* scr = (LAS float*)(lds + wave * 16640);
            constexpr int I6 = 88 * 32, I7 = 32 * 32;
            for (int it = sb * NWAVES + wave; it < I6 + I7; it += NS * NWAVES) {
                if (it < I6) tr_item(a.in[17], DFF, DM, nullptr, Wdn, 0, it, scr, lane);
                else tr_item(a.in[19], DM, DM, a.in[18], Wpg, 0, it - I6, scr, lane);
            }
            __syncthreads();
        }
    }
    SEAM(5);
    if (IN(6)) {
        pg8::Gemm g{Fb, Wdn, SEQ, DM, DFF}; pg8::StaticOrder S; S.init(SEQ, DM, G, bx);
        EpiRes<true, false, true, false> E{nullptr, H1B, nullptr, H2B, ssq3, nullptr, nullptr};
        pg8::gemm_phase<EpiRes<true, false, true, false>, pg8::StaticOrder, true, true>(lds, g, S, E);
    }
    SEAM(6);
    const bool fuse8 = FUSE_P8 && lo <= 7 && 8 < hi && G == (SEQ / 256) * (DM / 256);
    if (IN(7)) {
        pg8::StaticOrder S; S.init(SEQ, DM, G, bx); pg8::Gemm g{H2B, Wpg, SEQ, DM, DM};
        if (fuse8) { EpiFinal E{H2B, out, ssq4, ssq3, PLEB, a.in[21], (unsigned*)(ws + WS_CNT), (unsigned)(DM / 256)};
            pg8::gemm_phase<EpiFinal, pg8::StaticOrder, false, true>(lds, g, S, E); }
        else { EpiRes<true, true, false, true> E{nullptr, H2B, out, nullptr, ssq4, ssq3, PLEB};
            pg8::gemm_phase<EpiRes<true, true, false, true>, pg8::StaticOrder, true, true>(lds, g, S, E); }
    }
    if (!fuse8) {
    SEAM(7);
    if (IN(8)) {
        const int gw = bx * NWAVES + wave, NGW = G * NWAVES;
        const f32x4* gf = (const f32x4*)a.in[21] + lane;
        for (int row = gw; row < SEQ; row += NGW) {
            f32x4* o = (f32x4*)(out + (size_t)row * DM) + lane; const float r = rsqrtf(ssq4[row] * (1.0f / DM) + EPS);
#pragma unroll
            for (int j = 0; j < 8; ++j) o[64 * j] = o[64 * j] * r * gf[64 * j];
        }
    }
    }
#undef IN
#undef SEAM
}

extern "C" void kernel_launch(void* const* d_in, const int* in_sizes, int n_in, void* d_out, int out_size, void* d_ws, size_t ws_size, hipStream_t stream) {
    static int grid = 0;
    if (grid == 0) {
        if (n_in != 22 || out_size != SEQ * DM || ws_size < WS_END) { fprintf(stderr, "kernel_launch: unexpected shapes (n_in %d, out %d, ws %zu)\n", n_in, out_size, ws_size); grid = -1; return; }
        int dev = 0, cus = 0, per_cu = 0;
        if (hipGetDevice(&dev) != hipSuccess || hipDeviceGetAttribute(&cus, hipDeviceAttributeMultiprocessorCount, dev) != hipSuccess) { grid = -1; return; }
        if (hipFuncSetAttribute((const void*)fwd_kernel, hipFuncAttributeMaxDynamicSharedMemorySize, LDS_BYTES) != hipSuccess) { fprintf(stderr, "kernel_launch: hipFuncSetAttribute failed\n"); grid = -1; return; }
        if (hipOccupancyMaxActiveBlocksPerMultiprocessor(&per_cu, (const void*)fwd_kernel, NTHR, LDS_BYTES) != hipSuccess || per_cu < 1) { fprintf(stderr, "kernel_launch: occupancy query says %d\n", per_cu); per_cu = 1; }
        (void)hipGetLastError();
        grid = cus;
    }
    if (grid < 0) return;
    Args a{};
    for (int i = 0; i < 22; ++i) a.in[i] = (const float*)d_in[i];
    a.out = (float*)d_out; a.ws = (unsigned char*)d_ws;
#if MK_LAUNCHES == 1
    a.ph_lo = 0; a.ph_hi = NPHASE; a.coop = 1;
    if (hipMemsetAsync((char*)d_ws + WS_BAR, 0, WS_CTL_END - WS_BAR, stream) != hipSuccess) { fprintf(stderr, "kernel_launch: memset of the control words failed\n"); return; }
    void* args[] = {&a};
    hipError_t e = hipLaunchCooperativeKernel((const void*)fwd_kernel, dim3(grid), dim3(NTHR), args, LDS_BYTES, stream);
    if (e != hipSuccess) fprintf(stderr, "kernel_launch: cooperative launch failed: %s (grid %d)\n", hipGetErrorString(e), grid);
#else
    for (int ph = 0; ph < NPHASE; ++ph) { a.ph_lo = ph; a.ph_hi = ph + 1; a.coop = 0; hipLaunchKernelGGL(fwd_kernel, dim3(grid), dim3(NTHR), LDS_BYTES, stream, a); }
#endif
}
```

```cpp
#include <hip/hip_runtime.h>
#include <hip/hip_cooperative_groups.h>
#include <cstdio>
#include <cstdint>
namespace cg = cooperative_groups;
namespace pg8 {
#define PG8_LAS __attribute__((address_space(3)))
typedef unsigned short bf16_t;
typedef short bf16x8 __attribute__((ext_vector_type(8)));
typedef float f32x4 __attribute__((ext_vector_type(4)));
typedef unsigned u32x4 __attribute__((ext_vector_type(4)));
constexpr int BM = 256, BK = 64, HALF = 128, HTB = HALF * BK * 2  , STAGE_BYTES = 8 * HTB, NXCD = 8, WGM = 8;

__host__ __device__ __forceinline__ int lds_byte(int r, int c) { const int st = (r >> 4) * 2 + (c >> 5), rr = r & 15, cc = c & 31, ob = rr * 64 + cc * 2; return st * 1024 + (ob ^ (((ob >> 9) & 1) << 5)); }
__host__ __device__ __forceinline__ void stage_rc(int b, int& R, int& C) { const int st = b / 1024, sb = b % 1024, swz = sb ^ (((sb >> 9) & 1) << 5); R = (st >> 1) * 16 + swz / 64; C = (st & 1) * 32 + (swz % 64) / 2; }
__host__ __device__ __forceinline__ int perm32(int rho) { const int n = rho >> 4, i = rho & 15; return 8 * (i >> 2) + 4 * n + (i & 3); }

struct Unit { int pm, pn; };
struct Gemm { const bf16_t* A; const bf16_t* Bt; int M, N, K; };

struct StaticOrder {
    int nM, nN, nwg, G, c;
    __host__ __device__ void init(int M, int N, int G_, int c_) { nM = M / BM; nN = N / BM; nwg = nM * nN; G = G_; c = c_; }
    __host__ __device__ bool next(int i, Unit& u) const {
        const long L = (long)i * G + c; if (L >= nwg) return false;
        int wgid = (int)L; { const int q = nwg / NXCD, r = nwg % NXCD, xcd = wgid % NXCD, off = wgid / NXCD; wgid = (xcd < r ? xcd * (q + 1) : r * (q + 1) + (xcd - r) * q) + off; }
        const int nig = WGM * nN, gid = wgid / nig, fm = gid * WGM, gsz = (nM - fm) < WGM ? (nM - fm) : WGM;
        u.pm = fm + ((wgid % nig) % gsz); u.pn = (wgid % nig) / gsz; return true;
    }
    __device__ __forceinline__ void a_ready(const Unit&) const {}
    __device__ __forceinline__ void done(const Unit&) const {}
};

__device__ __forceinline__ unsigned cvt_pk_bf16(float lo, float hi) { unsigned r; asm volatile("v_cvt_pk_bf16_f32 %0, %1, %2" : "=v"(r) : "v"(lo), "v"(hi)); return r; }
typedef float f32x2 __attribute__((ext_vector_type(2)));
template <class Epi, class Sched, bool ALIGN_EPI = false, bool SP2 = false>
__device__ __forceinline__ void gemm_phase(PG8_LAS unsigned char* lds, const Gemm g, const Sched& S, const Epi& E) {
    const int tid = threadIdx.x, wid = __builtin_amdgcn_readfirstlane(tid >> 6), lane = tid & 63, wr = wid >> 2, wc = wid & 3, fr = lane & 15, fq = lane >> 4;
    const int K = g.K, nt = K / BK;
    unsigned voffA[2], voffB[2];
#pragma unroll
    for (int i = 0; i < 2; ++i) { int R, C; stage_rc(tid * 16 + i * 8192, R, C); const int Rb = Epi::PERM ? ((R & ~31) + perm32(R & 31)) : R;
        voffA[i] = (unsigned)(R * K + C) * 2u; voffB[i] = (unsigned)(Rb * K + C) * 2u; }
    const size_t kstep = (size_t)(BK * 2);
    const size_t hstep = (size_t)HALF * K * 2;
    const size_t tstep = 2 * hstep;
    const unsigned ldsw = (unsigned)wid * 1024u;
    const int aoff = lds_byte(wr * 64 + fr, fq * 8), boff = lds_byte(wc * 32 + fr, fq * 8);
#define PG8_SA(b, h) (((b) * 2 + (h)) * HTB)
#define PG8_SB(b, h) ((4 + (b) * 2 + (h)) * HTB)
#define PG8_STAGE(bufoff, gbase, voff) do { _Pragma("unroll") for (int _i = 0; _i < 2; ++_i) \
        __builtin_amdgcn_global_load_lds((const unsigned*)((const char*)(gbase) + (voff)[_i]), (PG8_LAS unsigned*)(lds + (bufoff) + ldsw + _i * 8192), 16, 0, 0); } while (0)
#define PG8_LDA(dst, b, h) do { _Pragma("unroll") for (int m = 0; m < 4; ++m) _Pragma("unroll") for (int k = 0; k < 2; ++k) dst[m][k] = *(const PG8_LAS bf16x8*)(lds + PG8_SA(b, h) + aoff + m * 2048 + k * 1024); } while (0)
#define PG8_LDB(dst, b, h) do { _Pragma("unroll") for (int n = 0; n < 2; ++n) _Pragma("unroll") for (int k = 0; k < 2; ++k) dst[n][k] = *(const PG8_LAS bf16x8*)(lds + PG8_SB(b, h) + boff + n * 2048 + k * 1024); } while (0)
#define PG8_MMA(ai, bj, At, Bt) do { __builtin_amdgcn_s_setprio(1); _Pragma("unroll") for (int m = 0; m < 4; ++m) _Pragma("unroll") for (int n = 0; n < 2; ++n) _Pragma("unroll") for (int k = 0; k < 2; ++k) \
        acc[ai][bj][m][n] = __builtin_amdgcn_mfma_f32_16x16x32_bf16(Bt[n][k], At[m][k], acc[ai][bj][m][n], 0, 0, 0); __builtin_amdgcn_s_setprio(0); } while (0)
#define PG8_WAIT_V(n) asm volatile("s_waitcnt vmcnt(" #n ")" ::: "memory")
#define PG8_WAIT_L(n) asm volatile("s_waitcnt lgkmcnt(" #n ")" ::: "memory")
#define PG8_BAR __builtin_amdgcn_s_barrier()
#define PG8_SCHED __builtin_amdgcn_sched_barrier(0)
    Unit cur, nxt; int ui = 0;
    if (!S.next(0, cur)) return;
    f32x4 acc[2][2][4][2];
#pragma unroll
    for (int a = 0; a < 2; ++a)
#pragma unroll
        for (int b = 0; b < 2; ++b)
#pragma unroll
            for (int m = 0; m < 4; ++m)
#pragma unroll
                for (int n = 0; n < 2; ++n) acc[a][b][m][n] = (f32x4){0.f, 0.f, 0.f, 0.f};
    bf16x8 At[4][2], B0[2][2], B1[2][2];
    const char* cA = (const char*)g.A + (size_t)cur.pm * tstep; const char* cB = (const char*)g.Bt + (size_t)cur.pn * tstep;
    S.a_ready(cur);
    if constexpr (SP2) {
        PG8_STAGE(PG8_SB(0, 0), cB, voffB); PG8_STAGE(PG8_SB(0, 1), cB + hstep, voffB); PG8_STAGE(PG8_SA(0, 0), cA, voffA); PG8_STAGE(PG8_SA(0, 1), cA + hstep, voffA);
        if (wr == 1) PG8_BAR;
        PG8_WAIT_V(2); PG8_BAR;
        PG8_STAGE(PG8_SB(1, 0), cB + kstep, voffB); PG8_STAGE(PG8_SA(1, 0), cA + kstep, voffA); PG8_STAGE(PG8_SB(1, 1), cB + hstep + kstep, voffB);
        PG8_WAIT_V(6); PG8_BAR;
    } else {
        PG8_STAGE(PG8_SB(0, 0), cB, voffB); PG8_STAGE(PG8_SA(0, 0), cA, voffA); PG8_STAGE(PG8_SB(0, 1), cB + hstep, voffB); PG8_STAGE(PG8_SA(0, 1), cA + hstep, voffA);
        if (wr == 1) PG8_BAR;
        PG8_WAIT_V(4); PG8_BAR;
        PG8_STAGE(PG8_SB(1, 0), cB + kstep, voffB); PG8_STAGE(PG8_SA(1, 0), cA + kstep, voffA); PG8_STAGE(PG8_SB(1, 1), cB + hstep + kstep, voffB);
        PG8_WAIT_V(6); PG8_BAR;
    }
    for (;;) {
        const bool has_next = S.next(ui + 1, nxt);
        const char* nA = has_next ? (const char*)g.A + (size_t)nxt.pm * tstep : cA; const char* nB = has_next ? (const char*)g.Bt + (size_t)nxt.pn * tstep : cB;
#pragma unroll 1
        for (int t = 0; t < nt; t += 2) {
            if constexpr (Epi::MIDT > 0) { if (t == Epi::MIDT) E.mid(acc, cur, wr, wc, fr, fq); }
            const bool last = (t == nt - 2);
            const char* a1 = cA + (size_t)(t + 1) * kstep;
            const char* a2 = last ? nA : cA + (size_t)(t + 2) * kstep; const char* b2 = last ? nB : cB + (size_t)(t + 2) * kstep;
            const char* a3 = a2 + kstep; const char* b3 = b2 + kstep;
            if (last && has_next) S.a_ready(nxt);
            if constexpr (SP2) {
            PG8_LDB(B0, 0, 0); PG8_LDB(B1, 0, 1); PG8_SCHED; PG8_LDA(At, 0, 0); PG8_STAGE(PG8_SA(1, 1), a1 + hstep, voffA);
            PG8_WAIT_V(8); PG8_WAIT_L(0); PG8_BAR; PG8_MMA(0, 0, At, B0); PG8_MMA(0, 1, At, B1); PG8_BAR; PG8_SCHED;
            PG8_LDA(At, 0, 1); PG8_STAGE(PG8_SB(0, 0), b2, voffB); PG8_STAGE(PG8_SB(0, 1), b2 + hstep, voffB); PG8_STAGE(PG8_SA(0, 0), a2, voffA);
            PG8_WAIT_V(8); PG8_WAIT_L(0); PG8_BAR; PG8_MMA(1, 0, At, B0); PG8_MMA(1, 1, At, B1); PG8_BAR; PG8_SCHED;
            PG8_LDB(B0, 1, 0); PG8_LDB(B1, 1, 1); PG8_SCHED; PG8_LDA(At, 1, 0); PG8_STAGE(PG8_SA(0, 1), a2 + hstep, voffA);
            PG8_WAIT_V(8); PG8_WAIT_L(0); PG8_BAR; PG8_MMA(0, 0, At, B0); PG8_MMA(0, 1, At, B1); PG8_BAR; PG8_SCHED;
            PG8_LDA(At, 1, 1); PG8_STAGE(PG8_SB(1, 0), b3, voffB); PG8_STAGE(PG8_SB(1, 1), b3 + hstep, voffB); PG8_STAGE(PG8_SA(1, 0), a3, voffA);
            PG8_WAIT_V(8); PG8_WAIT_L(0); PG8_BAR; PG8_MMA(1, 0, At, B0); PG8_MMA(1, 1, At, B1); PG8_BAR; PG8_SCHED;
            } else {
            PG8_LDB(B0, 0, 0); PG8_SCHED; PG8_LDA(At, 0, 0); PG8_STAGE(PG8_SA(1, 1), a1 + hstep, voffA);
            PG8_WAIT_L(8); PG8_BAR; PG8_WAIT_L(0); PG8_MMA(0, 0, At, B0); PG8_BAR; PG8_SCHED;
            PG8_LDB(B1, 0, 1); PG8_STAGE(PG8_SB(0, 0), b2, voffB);
            PG8_BAR; PG8_WAIT_L(0); PG8_MMA(0, 1, At, B1); PG8_BAR;
            PG8_LDA(At, 0, 1); PG8_STAGE(PG8_SA(0, 0), a2, voffA);
            PG8_BAR; PG8_WAIT_L(0); PG8_MMA(1, 0, At, B0); PG8_BAR; PG8_SCHED;
            PG8_STAGE(PG8_SB(0, 1), b2 + hstep, voffB);
            PG8_WAIT_V(6); PG8_BAR; PG8_MMA(1, 1, At, B1); PG8_BAR;
            PG8_LDB(B0, 1, 0); PG8_SCHED; PG8_LDA(At, 1, 0); PG8_STAGE(PG8_SA(0, 1), a2 + hstep, voffA);
            PG8_WAIT_L(8); PG8_BAR; PG8_WAIT_L(0); PG8_MMA(0, 0, At, B0); PG8_BAR; PG8_SCHED;
            PG8_LDB(B1, 1, 1); PG8_STAGE(PG8_SB(1, 0), b3, voffB);
            PG8_BAR; PG8_WAIT_L(0); PG8_MMA(0, 1, At, B1); PG8_BAR;
            PG8_LDA(At, 1, 1); PG8_STAGE(PG8_SA(1, 0), a3, voffA);
            PG8_BAR; PG8_WAIT_L(0); PG8_MMA(1, 0, At, B0); PG8_BAR; PG8_SCHED;
            PG8_STAGE(PG8_SB(1, 1), b3 + hstep, voffB);
            PG8_WAIT_V(6); PG8_BAR; PG8_MMA(1, 1, At, B1); PG8_BAR;
            }
        }
        if constexpr (ALIGN_EPI) { if (wr == 0) PG8_BAR; }
        if constexpr (!Epi::AFTER_DRAIN) { E(acc, cur, wr, wc, fr, fq); S.done(cur); }
        if (!has_next) break;
#pragma unroll
        for (int a = 0; a < 2; ++a)
#pragma unroll
            for (int b = 0; b < 2; ++b)
#pragma unroll
                for (int m = 0; m < 4; ++m)
#pragma unroll
                    for (int n = 0; n < 2; ++n) acc[a][b][m][n] = (f32x4){0.f, 0.f, 0.f, 0.f};
        cur = nxt; cA = nA; cB = nB; ++ui;
        if constexpr (ALIGN_EPI) { if (wr == 1) PG8_BAR; }
    }
    PG8_WAIT_V(0);
    if constexpr (!ALIGN_EPI) { if (wr == 0) PG8_BAR; }
    PG8_BAR;
    if constexpr (Epi::AFTER_DRAIN) { E.fused(acc, cur, wr, wc, fr, fq, lds, wid, lane); S.done(cur); }
#undef PG8_SA
#undef PG8_SB
#undef PG8_STAGE
#undef PG8_LDA
#undef PG8_LDB
#undef PG8_MMA
#undef PG8_WAIT_V
#undef PG8_WAIT_L
#undef PG8_BAR
#undef PG8_SCHED
}
}

#define LAS __attribute__((address_space(3)))
using pg8::bf16_t; using pg8::f32x4; using pg8::u32x4; using pg8::Unit; using pg8::cvt_pk_bf16;
typedef unsigned u32x2 __attribute__((ext_vector_type(2)));
typedef float f32x2 __attribute__((ext_vector_type(2)));

#ifndef MK_LAUNCHES
#define MK_LAUNCHES 1
#endif
constexpr int SEQ = 8192, DM = 2048, CW = 1024, NIN = 9216, DFF = 5632, PLE = 256;
constexpr float EPS = 1e-6f, LN_EPS = 1e-5f;
constexpr int NWAVES = 8, NTHR = 512, NPHASE = 9;
constexpr int LDS_BYTES = 147456;
constexpr size_t MiB = 1u << 20;
constexpr size_t WS_RSTD1 = 0, WS_SSQ2 = 64 * 1024, WS_SSQ3 = 128 * 1024, WS_SSQ4 = 192 * 1024;
constexpr size_t WS_BAR = 256 * 1024, WS_CNT = 272 * 1024, WS_CTL_END = 280 * 1024;
constexpr size_t WS_TS = 288 * 1024;
constexpr int MISC_OFF = 143360;
constexpr size_t WS_WIN = 2 * MiB, WS_WOA = 38 * MiB, WS_WPW = 42 * MiB, WS_WO = 46 * MiB, WS_WGU = 54 * MiB, WS_WDN = 98 * MiB, WS_WPG = 120 * MiB, WS_WPP = 128 * MiB;
constexpr size_t WS_R0 = 130 * MiB;
constexpr size_t WS_MB = 162 * MiB;
constexpr size_t WS_Q = 162 * MiB, WS_AB = 178 * MiB, WS_U = 194 * MiB;
constexpr size_t WS_SGA = 210 * MiB, WS_SGB = 242 * MiB;
constexpr size_t WS_YA = 274 * MiB;
constexpr size_t WS_H1B = 282 * MiB;
constexpr size_t WS_F = 194 * MiB;
constexpr size_t WS_PB = 314 * MiB;
constexpr size_t WS_END = 318 * MiB;

__device__ __forceinline__ float sigm(float x) { return __builtin_amdgcn_rcpf(1.f + __expf(-x)); }
__device__ __forceinline__ f32x4 sig4(f32x4 v) { return (f32x4){sigm(v[0]), sigm(v[1]), sigm(v[2]), sigm(v[3])}; }
__device__ __forceinline__ float bf_lo(unsigned w) { return __uint_as_float(w << 16); }
__device__ __forceinline__ float bf_hi(unsigned w) { return __uint_as_float(w & 0xffff0000u); }
__device__ __forceinline__ void st_bf16x8(bf16_t* p, f32x4 v0, f32x4 v1) {
    u32x4 w; w.x = cvt_pk_bf16(v0[0], v0[1]); w.y = cvt_pk_bf16(v0[2], v0[3]); w.z = cvt_pk_bf16(v1[0], v1[1]); w.w = cvt_pk_bf16(v1[2], v1[3]); *(u32x4*)p = w; }
__device__ __forceinline__ void ld_bf16x8(const bf16_t* p, f32x4& v0, f32x4& v1) {
    const u32x4 w = *(const u32x4*)p; v0 = (f32x4){bf_lo(w.x), bf_hi(w.x), bf_lo(w.y), bf_hi(w.y)}; v1 = (f32x4){bf_lo(w.z), bf_hi(w.z), bf_lo(w.w), bf_hi(w.w)}; }
__device__ __forceinline__ float dot4(f32x4 a) { return (a[0] * a[0] + a[1] * a[1]) + (a[2] * a[2] + a[3] * a[3]); }
__device__ __forceinline__ float wave_sum(float v) {
#pragma unroll
    for (int o = 1; o < 64; o <<= 1) v += __shfl_xor(v, o);
    return v;
}

struct EpiProj {
    static constexpr bool PERM = true, AFTER_DRAIN = false; static constexpr int MIDT = 0;
    const float* rstd; const float* bglu; bf16_t *Qo, *ABo, *Uo, *SA, *SB;
    __device__ __forceinline__ void operator()(const f32x4 (&acc)[2][2][4][2], const Unit& u, int wr, int wc, int fr, int fq) const {
        const int pn = u.pn, row0 = u.pm * 256 + wr * 64 + fr, cl = wc * 32 + 8 * fq;
        float rs8[2][4];
#pragma unroll
        for (int ai = 0; ai < 2; ++ai)
#pragma unroll
            for (int m = 0; m < 4; ++m) rs8[ai][m] = rstd[row0 + ai * 128 + m * 16];
        if (pn < 8) {
#pragma unroll
            for (int ai = 0; ai < 2; ++ai)
#pragma unroll
                for (int m = 0; m < 4; ++m) { const int row = row0 + ai * 128 + m * 16; const float r = rs8[ai][m], r2 = r * r;
                    st_bf16x8(Qo + (size_t)row * CW + pn * 128 + cl, acc[ai][0][m][0] * acc[ai][1][m][0] * r2, acc[ai][0][m][1] * acc[ai][1][m][1] * r2); }
        } else if (pn < 12) {
#pragma unroll
            for (int ai = 0; ai < 2; ++ai)
#pragma unroll
                for (int m = 0; m < 4; ++m) { const int row = row0 + ai * 128 + m * 16; const float r = rs8[ai][m];
#pragma unroll
                    for (int bj = 0; bj < 2; ++bj) st_bf16x8(ABo + (size_t)row * CW + (pn - 8) * 256 + bj * 128 + cl, acc[ai][bj][m][0] * r, acc[ai][bj][m][1] * r); }
        } else if (pn < 20) {
            const int ch = (pn - 12) * 128 + cl;
            const f32x4 bv0 = *(const f32x4*)(bglu + ch), bv1 = *(const f32x4*)(bglu + ch + 4), bg0 = *(const f32x4*)(bglu + CW + ch), bg1 = *(const f32x4*)(bglu + CW + ch + 4);
#pragma unroll
            for (int ai = 0; ai < 2; ++ai)
#pragma unroll
                for (int m = 0; m < 4; ++m) { const int row = row0 + ai * 128 + m * 16; const float r = rs8[ai][m];
                    const f32x4 v0 = acc[ai][0][m][0] * r + bv0, v1 = acc[ai][0][m][1] * r + bv1, g0 = acc[ai][1][m][0] * r + bg0, g1 = acc[ai][1][m][1] * r + bg1;
                    st_bf16x8(Uo + (size_t)row * CW + ch, v0 * sig4(g0), v1 * sig4(g1)); }
        } else {
            const int ch = (pn - 20) * 128 + cl;
#pragma unroll
            for (int ai = 0; ai < 2; ++ai)
#pragma unroll
                for (int m = 0; m < 4; ++m) { const int row = row0 + ai * 128 + m * 16; const float r = rs8[ai][m];
                    f32x4 rt[2], sb[2];
#pragma unroll
                    for (int n = 0; n < 2; ++n)
#pragma unroll
                        for (int e = 0; e < 4; ++e) {
                            const float ga = fmaxf(acc[ai][0][m][n][e] * r, -30.f), gb = fmaxf(acc[ai][1][m][n][e] * r, -30.f);
                            const float da = 1.f + __expf(-ga), db = 1.f + __expf(-gb), rc = __builtin_amdgcn_rcpf(da * db);
                            sb[n][e] = da * rc; rt[n][e] = db * db * rc; }
                    st_bf16x8(SA + (size_t)row * DM + ch, rt[0], rt[1]); st_bf16x8(SB + (size_t)row * DM + ch, sb[0], sb[1]); }
        }
    }
};
struct EpiMerge {
    static constexpr bool PERM = true, AFTER_DRAIN = false; static constexpr int MIDT = CW / 64;
    const bf16_t* RT; const bf16_t* SG; const float* bias; bf16_t* Mo;
    __device__ __forceinline__ void mid(f32x4 (&acc)[2][2][4][2], const Unit& u, int wr, int wc, int fr, int fq) const {
        int o = (u.pm * 256 + wr * 64 + fr) * DM + u.pn * 256 + wc * 32 + 8 * fq;
        asm volatile("" : "+v"(o));
        const bf16_t* p = RT + o;
#pragma unroll
        for (int ai = 0; ai < 2; ++ai) {
#pragma unroll
            for (int m = 0; m < 4; ++m)
#pragma unroll
                for (int bj = 0; bj < 2; ++bj) { f32x4 g0, g1; ld_bf16x8(p + (ai * 128 + m * 16) * DM + bj * 128, g0, g1);
                    acc[ai][bj][m][0] = acc[ai][bj][m][0] * g0; acc[ai][bj][m][1] = acc[ai][bj][m][1] * g1; }
            }
    }
    __device__ __forceinline__ void operator()(const f32x4 (&acc)[2][2][4][2], const Unit& u, int wr, int wc, int fr, int fq) const {
        const int row0 = u.pm * 256 + wr * 64 + fr, c0 = u.pn * 256 + wc * 32 + 8 * fq;
        f32x4 bv[2][2];
#pragma unroll
        for (int bj = 0; bj < 2; ++bj) { bv[bj][0] = *(const f32x4*)(bias + c0 + bj * 128); bv[bj][1] = *(const f32x4*)(bias + c0 + bj * 128 + 4); }
#pragma unroll
        for (int ai = 0; ai < 2; ++ai) {
            u32x4 gw[4][2];
#pragma unroll
            for (int m = 0; m < 4; ++m)
#pragma unroll
                for (int bj = 0; bj < 2; ++bj) gw[m][bj] = *(const u32x4*)(SG + (size_t)(row0 + ai * 128 + m * 16) * DM + c0 + bj * 128);
#pragma unroll
            for (int m = 0; m < 4; ++m)
#pragma unroll
                for (int bj = 0; bj < 2; ++bj) { const size_t off = (size_t)(row0 + ai * 128 + m * 16) * DM + c0 + bj * 128; const u32x4 w = gw[m][bj];
                    const f32x4 g0 = (f32x4){bf_lo(w.x), bf_hi(w.x), bf_lo(w.y), bf_hi(w.y)}, g1 = (f32x4){bf_lo(w.z), bf_hi(w.z), bf_lo(w.w), bf_hi(w.w)};
                    st_bf16x8(Mo + off, g0 * (acc[ai][bj][m][0] + bv[bj][0]), g1 * (acc[ai][bj][m][1] + bv[bj][1])); }
            asm volatile("" ::: "memory"); }
    }
};
template <bool BASE16, bool WF32, bool WB16, bool GATED> struct EpiRes {
    static constexpr bool PERM = true, AFTER_DRAIN = false; static constexpr int MIDT = 0;
    const float* basef; const bf16_t* baseb; float* out; bf16_t* ob; float* ssq_out; const float* ssq_in; const bf16_t* ple;
    __device__ __forceinline__ void operator()(const f32x4 (&acc)[2][2][4][2], const Unit& u, int wr, int wc, int fr, int fq) const {
        const int row0 = u.pm * 256 + wr * 64 + fr, c0 = u.pn * 256 + wc * 32 + 8 * fq;
#pragma unroll
        for (int ai = 0; ai < 2; ++ai) {
            u32x4 bw[4][2], pw[4][2]; f32x4 bf[4][2][2]; float rr[4];
#pragma unroll
            for (int m = 0; m < 4; ++m) { const int row = row0 + ai * 128 + m * 16; rr[m] = 0.f; if (GATED) rr[m] = ssq_in[row];
#pragma unroll
                for (int bj = 0; bj < 2; ++bj) { const size_t off = (size_t)row * DM + c0 + bj * 128;
                    if (BASE16) bw[m][bj] = *(const u32x4*)(baseb + off); else { bf[m][bj][0] = *(const f32x4*)(basef + off); bf[m][bj][1] = *(const f32x4*)(basef + off + 4); }
                    if (GATED) pw[m][bj] = *(const u32x4*)(ple + off); } }
#pragma unroll
            for (int m = 0; m < 4; ++m) { const int row = row0 + ai * 128 + m * 16; const float r = GATED ? rsqrtf(rr[m] * (1.0f / DM) + EPS) : 0.f;
                float s = 0.f;
#pragma unroll
                for (int bj = 0; bj < 2; ++bj) { const size_t off = (size_t)row * DM + c0 + bj * 128;
                    f32x4 b0, b1; if (BASE16) { const u32x4 w = bw[m][bj]; b0 = (f32x4){bf_lo(w.x), bf_hi(w.x), bf_lo(w.y), bf_hi(w.y)}; b1 = (f32x4){bf_lo(w.z), bf_hi(w.z), bf_lo(w.w), bf_hi(w.w)}; } else { b0 = bf[m][bj][0]; b1 = bf[m][bj][1]; }
                    f32x4 v0 = acc[ai][bj][m][0], v1 = acc[ai][bj][m][1];
                    if (GATED) { const u32x4 w = pw[m][bj]; const f32x4 p0 = (f32x4){bf_lo(w.x), bf_hi(w.x), bf_lo(w.y), bf_hi(w.y)}, p1 = (f32x4){bf_lo(w.z), bf_hi(w.z), bf_lo(w.w), bf_hi(w.w)};
                        v0 = sig4(v0 * r) * p0; v1 = sig4(v1 * r) * p1; }
                    const f32x4 h0 = b0 + v0, h1 = b1 + v1;
                    if (WF32) { *(f32x4*)(out + off) = h0; *(f32x4*)(out + off + 4) = h1; }
                    if (WB16) st_bf16x8(ob + off, h0, h1);
                    s += dot4(h0) + dot4(h1); }
                s += __shfl_xor(s, 16); s += __shfl_xor(s, 32);
                if (fq == 0) unsafeAtomicAdd(ssq_out + row, s); }
            asm volatile("" ::: "memory"); }
    }
};
struct EpiSwiglu {
    static constexpr bool PERM = true, AFTER_DRAIN = false; static constexpr int MIDT = 0;
    const float* ssq_in; bf16_t* F;
    __device__ __forceinline__ void operator()(const f32x4 (&acc)[2][2][4][2], const Unit& u, int wr, int wc, int fr, int fq) const {
        const int row0 = u.pm * 256 + wr * 64 + fr, ch = u.pn * 128 + wc * 32 + 8 * fq;
        float rs8[2][4];
#pragma unroll
        for (int ai = 0; ai < 2; ++ai)
#pragma unroll
            for (int m = 0; m < 4; ++m) rs8[ai][m] = ssq_in[row0 + ai * 128 + m * 16];
#pragma unroll
        for (int ai = 0; ai < 2; ++ai)
#pragma unroll
            for (int m = 0; m < 4; ++m) { const int row = row0 + ai * 128 + m * 16; const float r = rsqrtf(rs8[ai][m] * (1.0f / DM) + EPS);
                const f32x4 g0 = acc[ai][0][m][0] * r, g1 = acc[ai][0][m][1] * r, u0 = acc[ai][1][m][0] * r, u1 = acc[ai][1][m][1] * r;
                f32x4 s0, s1;
#pragma unroll
                for (int e = 0; e < 4; ++e) { const float d0 = 1.f + __expf(-fmaxf(g0[e], -40.f)), d1 = 1.f + __expf(-fmaxf(g1[e], -40.f)), rc = __builtin_amdgcn_rcpf(d0 * d1); s0[e] = d1 * rc; s1[e] = d0 * rc; }
                st_bf16x8(F + (size_t)row * DFF + ch, g0 * s0 * u0, g1 * s1 * u1); }
    }
};
struct EpiPle {
    static constexpr bool PERM = true, AFTER_DRAIN = false; static constexpr int MIDT = 0;
    bf16_t* O;
    __device__ __forceinline__ void operator()(const f32x4 (&acc)[2][2][4][2], const Unit& u, int wr, int wc, int fr, int fq) const {
        const int row0 = u.pm * 256 + wr * 64 + fr, c0 = u.pn * 256 + wc * 32 + 8 * fq;
#pragma unroll
        for (int ai = 0; ai < 2; ++ai)
#pragma unroll
            for (int m = 0; m < 4; ++m)
#pragma unroll
                for (int bj = 0; bj < 2; ++bj) st_bf16x8(O + (size_t)(row0 + ai * 128 + m * 16) * DM + c0 + bj * 128, acc[ai][bj][m][0], acc[ai][bj][m][1]);
    }
};

#ifndef TPROBE
#define TPROBE -1
#endif
#ifndef ALTOUT
#define ALTOUT 0
#endif
#ifndef PRETOUCH
#define PRETOUCH 0
#endif
#ifndef PREWRITE
#define PREWRITE 0
#endif
struct EpiFinal {
    static constexpr bool PERM = false, AFTER_DRAIN = true; static constexpr int MIDT = 0;
    const bf16_t* base; float* out; float* ssq_out; const float* ssq_in; const bf16_t* ple; const float* gfin; unsigned* cnt; unsigned want; float pe; const unsigned long long* tsp; float* alt;
    static __device__ __forceinline__ f32x4 ld4(const bf16_t* p) { const u32x2 w = *(const u32x2*)p; return (f32x4){bf_lo(w.x), bf_hi(w.x), bf_lo(w.y), bf_hi(w.y)}; }
    __device__ __forceinline__ void fused(f32x4 (&acc)[2][2][4][2], const Unit& u, int wr, int wc, int fr, int fq, PG8_LAS unsigned char* lds, int wid, int lane) const {
        const int row0 = u.pm * 256 + wr * 64 + fr, c0 = u.pn * 256 + wc * 32 + 4 * fq;
#pragma unroll
        for (int ai = 0; ai < 2; ++ai) {
            u32x2 bw[4][2][2], pw[4][2][2]; float rq[4];
#pragma unroll
            for (int m = 0; m < 4; ++m) { const int row = row0 + ai * 128 + m * 16; rq[m] = ssq_in[row];
#pragma unroll
                for (int bj = 0; bj < 2; ++bj)
#pragma unroll
                    for (int n = 0; n < 2; ++n) { const size_t off = (size_t)row * DM + c0 + bj * 128 + n * 16; bw[m][bj][n] = *(const u32x2*)(base + off); pw[m][bj][n] = *(const u32x2*)(ple + off); } }
#pragma unroll
            for (int m = 0; m < 4; ++m) { const int row = row0 + ai * 128 + m * 16; const float r = rsqrtf(rq[m] * (1.0f / DM) + EPS);
                float s = 0.f;
#pragma unroll
                for (int bj = 0; bj < 2; ++bj)
#pragma unroll
                    for (int n = 0; n < 2; ++n) { const u32x2 wb_ = bw[m][bj][n], wp_ = pw[m][bj][n];
                        const f32x4 bb = (f32x4){bf_lo(wb_.x), bf_hi(wb_.x), bf_lo(wb_.y), bf_hi(wb_.y)}, pp = (f32x4){bf_lo(wp_.x), bf_hi(wp_.x), bf_lo(wp_.y), bf_hi(wp_.y)};
                        const f32x4 h = bb + sig4(acc[ai][bj][m][n] * r) * pp;
                        acc[ai][bj][m][n] = h; s += dot4(h); }
                s += __shfl_xor(s, 16); s += __shfl_xor(s, 32);
                if (fq == 0) unsafeAtomicAdd(ssq_out + row, s); }
            asm volatile("" ::: "memory"); }
        asm volatile("s_waitcnt vmcnt(0)" ::: "memory");
        __syncthreads();
        if (threadIdx.x == 0) { unsigned* c = cnt + 64 * u.pm;
            __hip_atomic_fetch_add(c, 1u, __ATOMIC_RELAXED, __HIP_MEMORY_SCOPE_AGENT);
            while (__hip_atomic_load(c, __ATOMIC_RELAXED, __HIP_MEMORY_SCOPE_AGENT) < want) __builtin_amdgcn_s_sleep(2); }
        __syncthreads();
        {
            PG8_LAS float* Sr = (PG8_LAS float*)lds;
            if (threadIdx.x < 256) Sr[threadIdx.x] = rsqrtf(__hip_atomic_load(ssq_out + u.pm * 256 + threadIdx.x, __ATOMIC_RELAXED, __HIP_MEMORY_SCOPE_AGENT) * (1.0f / DM) + EPS);
            __syncthreads();
        }
        unsigned long long t1 = 0; if (TPROBE >= 9) t1 = __builtin_amdgcn_s_memrealtime();
        float pe = this->pe; if (TPROBE == 7) pe = 1.2649e-3f * sqrtf((float)(__builtin_amdgcn_s_memrealtime() - tsp[7]) * 0.01f);
        f32x4 gv[2][2];
#pragma unroll
        for (int bj = 0; bj < 2; ++bj)
#pragma unroll
            for (int n = 0; n < 2; ++n) gv[bj][n] = *(const f32x4*)(gfin + c0 + bj * 128 + n * 16);
#pragma unroll
        for (int ai = 0; ai < 2; ++ai)
#pragma unroll
            for (int m = 0; m < 4; ++m) { const int row = row0 + ai * 128 + m * 16;
                const float rr = ((const PG8_LAS float*)lds)[row - u.pm * 256];
#pragma unroll
                for (int bj = 0; bj < 2; ++bj)
#pragma unroll
                    for (int n = 0; n < 2; ++n) { const size_t off = (size_t)row * DM + c0 + bj * 128 + n * 16;
                        f32x4 o = acc[ai][bj][m][n] * rr * gv[bj][n];
                        if (TPROBE >= 0 && TPROBE < 8 && row < 1024) o = n ? o - pe : o + pe;
                        *(f32x4*)(((ALTOUT && TPROBE >= 9) ? alt : out) + off) = o; } }
        if (TPROBE >= 9) { asm volatile("s_waitcnt vmcnt(0)" ::: "memory"); __syncthreads(); const unsigned long long t2 = __builtin_amdgcn_s_memrealtime();
            if (threadIdx.x == 0) { unsigned long long* T = const_cast<unsigned long long*>(tsp); T[16 + 2 * blockIdx.x] = t1 - T[7]; T[17 + 2 * blockIdx.x] = t2 - t1; } }
        if (ALTOUT && TPROBE >= 9) {
#pragma unroll
            for (int ai = 0; ai < 2; ++ai)
#pragma unroll
                for (int m = 0; m < 4; ++m) { const int row = row0 + ai * 128 + m * 16; const float rr = ((const PG8_LAS float*)lds)[row - u.pm * 256];
#pragma unroll
                    for (int bj = 0; bj < 2; ++bj)
#pragma unroll
                        for (int n = 0; n < 2; ++n) { const size_t off = (size_t)row * DM + c0 + bj * 128 + n * 16; *(f32x4*)(out + off) = acc[ai][bj][m][n] * rr * gv[bj][n]; } }
        }
    }
};

__device__ __forceinline__ int win_dest(int n0) {
    if (n0 < 1024) return 256 * (n0 >> 7) + (n0 & 127);
    if (n0 < 2048) return 2048 + (n0 - 1024);
    if (n0 < 3072) { const int c = n0 - 2048; return 256 * (c >> 7) + 128 + (c & 127); }
    if (n0 < 4096) { const int c = n0 - 3072; return 3072 + 256 * (c >> 7) + (c & 127); }
    if (n0 < 5120) { const int c = n0 - 4096; return 3072 + 256 * (c >> 7) + 128 + (c & 127); }
    if (n0 < 7168) { const int c = n0 - 5120; return 5120 + 256 * (c >> 7) + (c & 127); }
    { const int c = n0 - 7168; return 5120 + 256 * (c >> 7) + 128 + (c & 127); }
}
__device__ __forceinline__ void tr_item(const float* W, int K, int N, const float* g, bf16_t* WT, int mode, int item, LAS float* scr, int lane, int ldk = 0, int koff = 0) {
    if (ldk == 0) ldk = K;
    const int nblk = N >> 6, kb = item / nblk, nb = item - kb * nblk, k0 = kb << 6, n0 = nb << 6;
    int d0 = n0;
    if (mode == 1) d0 = win_dest(n0); else if (mode == 2) d0 = 256 * (n0 >> 7) + (n0 & 127); else if (mode == 3) d0 = 256 * (n0 >> 7) + 128 + (n0 & 127);
    const int kr = lane >> 4, col = 4 * (lane & 15);
    f32x4 v[16];
#pragma unroll
    for (int i = 0; i < 16; ++i) v[i] = *(const f32x4*)(W + (size_t)(k0 + 4 * i + kr) * N + n0 + col);
    if (g) {
#pragma unroll
        for (int i = 0; i < 16; ++i) v[i] = v[i] * g[k0 + 4 * i + kr];
    }
#pragma unroll
    for (int i = 0; i < 16; ++i) { LAS float* s = scr + (4 * i + kr) * 65 + col; s[0] = v[i][0]; s[1] = v[i][1]; s[2] = v[i][2]; s[3] = v[i][3]; }
    asm volatile("s_waitcnt lgkmcnt(0)" ::: "memory");
    const int c = lane & 7;
#pragma unroll
    for (int j = 0; j < 8; ++j) { const int n = (lane >> 3) + 8 * j; const LAS float* s = scr + (8 * c) * 65 + n;
        u32x4 o; o.x = cvt_pk_bf16(s[0], s[65]); o.y = cvt_pk_bf16(s[2 * 65], s[3 * 65]); o.z = cvt_pk_bf16(s[4 * 65], s[5 * 65]); o.w = cvt_pk_bf16(s[6 * 65], s[7 * 65]);
        *(u32x4*)(WT + (size_t)(d0 + n) * ldk + koff + k0 + 8 * c) = o; }
    asm volatile("s_waitcnt lgkmcnt(0)" ::: "memory");
}

#ifndef USE_XCDBAR
#define USE_XCDBAR 1
#endif
#ifndef FUSE_P8
#define FUSE_P8 1
#endif
#define XB_TMO      128
#define XB_XCNT(j)  (256  + 64 * (j))
#define XB_XSUB(j)  (1280 + 64 * (j))
#define XB_XGEN(j)  (2304 + 64 * (j))
#define XB_TOP      3328
#define XB_TOPGEN   3392
#define XCD_BAR_WORDS 3456
#define XB_SPIN_CAP (1u << 18)

__device__ __forceinline__ unsigned xb_ld(unsigned* p)              { return __hip_atomic_load(p, __ATOMIC_RELAXED, __HIP_MEMORY_SCOPE_AGENT); }
__device__ __forceinline__ unsigned xb_add(unsigned* p, unsigned v) { return __hip_atomic_fetch_add(p, v, __ATOMIC_RELAXED, __HIP_MEMORY_SCOPE_AGENT); }
__device__ __forceinline__ unsigned xb_xcc_id() { return (unsigned)__builtin_amdgcn_s_getreg((3 << 11) | 20) & 0xFu; }
#define XB_SPIN(cond, bar) do { unsigned _sp = 0; while (cond) { __builtin_amdgcn_s_sleep(1); \
    if ((++_sp & 255u) == 0u) { if (xb_ld(&(bar)[XB_TMO])) break; if (_sp > XB_SPIN_CAP) { atomicAdd(&(bar)[XB_TMO], 1u); break; } } } } while (0)

struct XcdBarrier {
    unsigned* bar; unsigned x;
    volatile LAS unsigned* st;
};

__device__ __forceinline__ XcdBarrier xcd_barrier_post(unsigned* bar, volatile LAS unsigned* st) {
    XcdBarrier b; b.bar = bar; b.x = xb_xcc_id(); b.st = st;
    if (threadIdx.x == 0) (void)xb_add(&bar[XB_XCNT(b.x)], 1u);
    return b;
}
__device__ __forceinline__ void xcd_barrier_complete(unsigned* bar, unsigned x, unsigned& nloc, unsigned& nx) {
    const unsigned G = gridDim.x * gridDim.y * gridDim.z;
    unsigned sum, cnt, mine, sp = 0u;
    for (;;) {
        sum = 0u; cnt = 0u; mine = 0u;
#pragma unroll
        for (unsigned j = 0; j < 16; ++j) { const unsigned c = xb_ld(&bar[XB_XCNT(j)]); sum += c; cnt += (c > 0u) ? 1u : 0u; mine = (j == x) ? c : mine; }
        if (sum == G) break;
        __builtin_amdgcn_s_sleep(1);
        if ((++sp & 255u) == 0u) { if (xb_ld(&bar[XB_TMO])) break; if (sp > XB_SPIN_CAP) { atomicAdd(&bar[XB_TMO], 1u); break; } }
    }
    nloc = mine > 0u ? mine : 1u; nx = cnt > 0u ? cnt : 1u;
}

__device__ __forceinline__ void xcd_barrier(const XcdBarrier& b) {
    asm volatile("s_waitcnt vmcnt(0)" ::: "memory");
    __syncthreads();
    if (threadIdx.x == 0) {
        unsigned* bar = b.bar;
        __builtin_amdgcn_s_waitcnt(0);
        unsigned nloc = b.st[0], nx = b.st[1];
        if (nloc == 0u) { xcd_barrier_complete(bar, b.x, nloc, nx); b.st[0] = nloc; b.st[1] = nx; }
        const unsigned old = xb_add(&bar[XB_XSUB(b.x)], 1u);
        const unsigned gen = old / nloc;
        if (old + 1u == (gen + 1u) * nloc) {
            __builtin_amdgcn_fence(__ATOMIC_RELEASE, "agent");
            asm volatile("s_waitcnt vmcnt(0)" ::: "memory");
            const unsigned og = xb_add(&bar[XB_TOP], 1u);
            const unsigned tg = og / nx;
            if (og + 1u == (tg + 1u) * nx) xb_add(&bar[XB_TOPGEN], 1u);
            else XB_SPIN(xb_ld(&bar[XB_TOPGEN]) == tg, bar);
            __builtin_amdgcn_fence(__ATOMIC_ACQUIRE, "agent");
            xb_add(&bar[XB_XGEN(b.x)], 1u);
            asm volatile("s_waitcnt vmcnt(0)" ::: "memory");
        } else {
            XB_SPIN(xb_ld(&bar[XB_XGEN(b.x)]) == gen, bar);
            __builtin_amdgcn_fence(__ATOMIC_ACQUIRE, "agent");
            asm volatile("s_waitcnt vmcnt(0)" ::: "memory");
        }
    }
    __syncthreads();
}

constexpr int GC_BAR = 0, GC_CNT = 4096, GC_EXIT = 4096 + 64 * 32, GC_WORDS = GC_EXIT + 64;
__device__ unsigned g_ctl[GC_WORDS];
__device__ __forceinline__ void ctl_st0(unsigned* p) { __hip_atomic_store(p, 0u, __ATOMIC_RELAXED, __HIP_MEMORY_SCOPE_AGENT); }

struct Args { const float* in[22]; float* out; unsigned char* ws; int ph_lo, ph_hi, coop, pad; };

__global__ void __launch_bounds__(NTHR, 2) fwd_kernel(Args a) {
    extern __shared__ __attribute__((aligned(16))) unsigned char lds_raw[];
    LAS unsigned char* lds = (LAS unsigned char*)lds_raw;
    cg::grid_group grid = cg::this_grid();
    const int tid = threadIdx.x, lane = tid & 63, wave = __builtin_amdgcn_readfirstlane(tid >> 6);
    const int G = gridDim.x, bx = blockIdx.x;
    unsigned char* ws = a.ws;
    const int lo = a.ph_lo, hi = a.ph_hi;
#ifndef PHMASK
#define PHMASK 0x1ff
#endif
#define IN(k) (lo <= (k) && (k) < hi && ((PHMASK >> (k)) & 1))
#define SEAM(k) do { if (lo <= (k) && (k) + 1 < hi) { if (USE_XCDBAR) xcd_barrier(bar); else grid.sync(); } } while (0)
    if (tid < 2) ((volatile LAS unsigned*)(lds + MISC_OFF))[tid] = 0u;
    __syncthreads();
    XcdBarrier bar; bar.bar = g_ctl + GC_BAR; bar.x = 0; bar.st = (volatile LAS unsigned*)(lds + MISC_OFF);
    if (USE_XCDBAR && a.coop) bar = xcd_barrier_post(g_ctl + GC_BAR, (volatile LAS unsigned*)(lds + MISC_OFF));
#define TSTAMP(k) do { if (TPROBE >= 0 && bx == 0 && tid == 0) ((unsigned long long*)(ws + WS_TS))[k] = __builtin_amdgcn_s_memrealtime(); } while (0)
    TSTAMP(0);
    if (a.coop == 2) grid.sync();
#define rstd1 ((float*)(ws + WS_RSTD1))
#define ssq2 ((float*)(ws + WS_SSQ2))
#define ssq3 ((float*)(ws + WS_SSQ3))
#define ssq4 ((float*)(ws + WS_SSQ4))
#define Win ((bf16_t*)(ws + WS_WIN))
#define Woa ((bf16_t*)(ws + WS_WOA))
#define Wo ((bf16_t*)(ws + WS_WO))
#define Wgu ((bf16_t*)(ws + WS_WGU))
#define Wdn ((bf16_t*)(ws + WS_WDN))
#define Wpg ((bf16_t*)(ws + WS_WPG))
#define Wpp ((bf16_t*)(ws + WS_WPP))
#define XB ((bf16_t*)(ws + WS_R0))
#define MB ((bf16_t*)(ws + WS_MB))
#define H2B ((bf16_t*)(ws + WS_H1B))
#define Qb ((bf16_t*)(ws + WS_Q))
#define ABb ((bf16_t*)(ws + WS_AB))
#define Ub ((bf16_t*)(ws + WS_U))
#define SGA ((bf16_t*)(ws + WS_SGA))
#define SGB ((bf16_t*)(ws + WS_SGB))
#define YA ((bf16_t*)(ws + WS_YA))
#define H1B ((bf16_t*)(ws + WS_H1B))
#define Fb ((bf16_t*)(ws + WS_F))
#define PLEB ((bf16_t*)(ws + WS_R0))
#define PB ((bf16_t*)(ws + WS_PB))
    float* out = a.out;

    if (IN(0)) {
        LAS float* scr = (LAS float*)(lds + wave * 16640);
        const int gw = bx * NWAVES + wave, NGW = G * NWAVES;
        constexpr int I0 = 32 * 144;
        for (int it = wave * G + bx; it < I0; it += NGW) tr_item(a.in[3], DM, NIN, a.in[2], Win, 1, it, scr, lane);
        for (int row = gw; row < SEQ; row += NGW) {
            const f32x4* xr = (const f32x4*)(a.in[0] + (size_t)row * DM) + lane; f32x4 v[8]; float s = 0.f;
#pragma unroll
            for (int j = 0; j < 8; ++j) { v[j] = xr[64 * j]; s += dot4(v[j]); }
            s = wave_sum(s);
            if (lane == 0) rstd1[row] = rsqrtf(s * (1.0f / DM) + EPS);
            u32x2* o = (u32x2*)(XB + (size_t)row * DM) + lane;
#pragma unroll
            for (int j = 0; j < 8; ++j) { u32x2 w; w.x = cvt_pk_bf16(v[j][0], v[j][1]); w.y = cvt_pk_bf16(v[j][2], v[j][3]); o[64 * j] = w; }
        }
        for (int c = gw; c < SEQ * PLE / 512; c += NGW) {
            const f32x4* pr = (const f32x4*)(a.in[1] + (size_t)c * 512) + 2 * lane; const f32x4 v0 = pr[0], v1 = pr[1];
            st_bf16x8(PB + (size_t)c * 512 + 8 * lane, v0, v1);
        }
        for (int i = bx * NTHR + tid; i < SEQ; i += G * NTHR) { ssq2[i] = 0.f; ssq3[i] = 0.f; ssq4[i] = 0.f; }
        __syncthreads();
    }
    SEAM(0); TSTAMP(1);
    if (IN(1)) {
        pg8::Gemm g{XB, Win, SEQ, NIN, DM}; pg8::StaticOrder S; S.init(SEQ, NIN, G, bx);
        EpiProj E{rstd1, a.in[6], Qb, ABb, Ub, SGA, SGB};
        pg8::gemm_phase<EpiProj, pg8::StaticOrder, true, true>(lds, g, S, E);
        const int rem = ((SEQ / 256) * (NIN / 256)) % G;
        if (rem == 0 || bx >= rem) {
            const int NS = rem ? G - rem : G, sb = rem ? bx - rem : bx;
            LAS float* scr = (LAS float*)(lds + wave * 16640);
            constexpr int I1 = 16 * 32, I2 = 16 * 32, I3 = 32 * 32, I4 = 32 * 88, I5 = 32 * 88, I8 = 4 * 32;
            for (int it = sb * NWAVES + wave; it < I1 + I2 + I3 + I4 + I5 + I8; it += NS * NWAVES) {
                int r = it;
                if (r < I8) { tr_item(a.in[20], PLE, DM, nullptr, Wpp, 0, r, scr, lane); continue; } r -= I8;
                if (r < I1) { tr_item(a.in[5], CW, DM, nullptr, Woa, 0, r, scr, lane, DM, 0); continue; } r -= I1;
                if (r < I2) { tr_item(a.in[11], CW, DM, nullptr, Woa, 0, r, scr, lane, DM, CW); continue; } r -= I2;
                if (r < I3) { tr_item(a.in[13], DM, DM, nullptr, Wo, 0, r, scr, lane); continue; } r -= I3;
                if (r < I4) { tr_item(a.in[15], DM, DFF, a.in[14], Wgu, 2, r, scr, lane); continue; } r -= I4;
                tr_item(a.in[16], DM, DFF, a.in[14], Wgu, 3, r, scr, lane);
            }
            __syncthreads();
        }
    }
    float wa0[3], wa1[3]; f32x2 wbv[31]; f32x2 cb = {0.f, 0.f}, lg = {0.f, 0.f}, lb = {0.f, 0.f};
    if (IN(2)) { const int c0 = 2 * tid;
#pragma unroll
        for (int k = 0; k < 3; ++k) { const f32x2 w = *(const f32x2*)(a.in[4] + k * CW + c0); wa0[k] = w.x; wa1[k] = w.y; }
#pragma unroll
        for (int k = 0; k < 31; ++k) wbv[k] = *(const f32x2*)(a.in[7] + k * CW + c0);
        cb = *(const f32x2*)(a.in[8] + c0); lg = *(const f32x2*)(a.in[9] + c0); lb = *(const f32x2*)(a.in[10] + c0); }
    SEAM(1); TSTAMP(2);
    if (IN(2)) {
        const int c0 = 2 * tid;
        LAS float* P = (LAS float*)lds; LAS float* St = (LAS float*)(lds + 65536);
        for (int tile = bx; tile < SEQ / 16; tile += G) {
            const int t0 = tile * 16;
            unsigned uw[46];
#pragma unroll
            for (int s = 0; s < 46; ++s) { const int ts = t0 - 30 + s; uw[s] = 0u; if (ts >= 0) uw[s] = *(const unsigned*)(Ub + (size_t)ts * CW + c0); }
            {
                float q0[18], q1[18]; unsigned abw[16];
#pragma unroll
                for (int j = 0; j < 18; ++j) { const int ts = t0 - 2 + j; unsigned w = 0u; if (ts >= 0) w = *(const unsigned*)(Qb + (size_t)ts * CW + c0); q0[j] = bf_lo(w); q1[j] = bf_hi(w); }
#pragma unroll
                for (int i = 0; i < 16; ++i) abw[i] = *(const unsigned*)(ABb + (size_t)(t0 + i) * CW + c0);
#pragma unroll
                for (int i = 0; i < 16; ++i) { const unsigned w = abw[i];
                    const float y0 = bf_lo(w) * (wa0[0] * q0[i] + wa0[1] * q0[i + 1] + wa0[2] * q0[i + 2]);
                    const float y1 = bf_hi(w) * (wa1[0] * q1[i] + wa1[1] * q1[i + 1] + wa1[2] * q1[i + 2]);
                    *(unsigned*)(YA + (size_t)(t0 + i) * DM + c0) = cvt_pk_bf16(y0, y1); }
            }
            f32x2 accv[16];
#pragma unroll
            for (int i = 0; i < 16; ++i) accv[i] = cb;
#pragma unroll
            for (int s = 0; s < 46; ++s) { const unsigned w = uw[s];
                const f32x2 uv = (f32x2){bf_lo(w), bf_hi(w)};
#pragma unroll
                for (int i = 0; i < 16; ++i) { const int k = s - i; if (k >= 0 && k <= 30) accv[i] = __builtin_elementwise_fma(wbv[k], uv, accv[i]); } }
            float acc0[16], acc1[16];
#pragma unroll
            for (int i = 0; i < 16; ++i) { acc0[i] = accv[i].x; acc1[i] = accv[i].y; }
#pragma unroll
            for (int i = 0; i < 16; ++i) { P[(2 * i) * NTHR + tid] = acc0[i] + acc1[i]; P[(2 * i + 1) * NTHR + tid] = acc0[i] * acc0[i] + acc1[i] * acc1[i]; }
            __syncthreads();
#pragma unroll
            for (int r = 0; r < 4; ++r) { const int row = 4 * wave + r; float s = 0.f;
#pragma unroll
                for (int j = 0; j < 8; ++j) s += P[row * NTHR + lane + 64 * j];
                s = wave_sum(s); if (lane == 0) St[row] = s; }
            __syncthreads();
#pragma unroll
            for (int i = 0; i < 16; ++i) { const float mean = St[2 * i] * (1.0f / CW), var = St[2 * i + 1] * (1.0f / CW) - mean * mean, rs = rsqrtf(fmaxf(var, 0.f) + LN_EPS);
                const float v0 = (acc0[i] - mean) * rs * lg.x + lb.x, v1 = (acc1[i] - mean) * rs * lg.y + lb.y;
                *(unsigned*)(YA + (size_t)(t0 + i) * DM + CW + c0) = cvt_pk_bf16(v0 * sigm(v0), v1 * sigm(v1)); }
        }
        __syncthreads();
    }
    SEAM(2); TSTAMP(3);
    if (IN(3)) {
        pg8::StaticOrder S; S.init(SEQ, DM, G, bx);
        { pg8::Gemm g{YA, Woa, SEQ, DM, DM}; EpiMerge E{SGA, SGB, a.in[12], MB}; pg8::gemm_phase<EpiMerge, pg8::StaticOrder, true, true>(lds, g, S, E); }
    }
    SEAM(3); TSTAMP(4);
    if (IN(4)) {
        pg8::Gemm g{MB, Wo, SEQ, DM, DM}; pg8::StaticOrder S; S.init(SEQ, DM, G, bx);
        EpiRes<true, false, true, false> E{nullptr, XB, nullptr, H1B, ssq2, nullptr, nullptr};
        pg8::gemm_phase<EpiRes<true, false, true, false>, pg8::StaticOrder, true, true>(lds, g, S, E);
    }
    SEAM(4); TSTAMP(5);
    if (IN(5)) {
        pg8::Gemm g{H1B, Wgu, SEQ, 2 * DFF, DM}; pg8::StaticOrder S; S.init(SEQ, 2 * DFF, G, bx);
        EpiSwiglu E{ssq2, Fb};
        pg8::gemm_phase<EpiSwiglu, pg8::StaticOrder, true, true>(lds, g, S, E);
        const int rem = ((SEQ / 256) * (2 * DFF / 256)) % G;
        if (rem == 0 || bx >= rem) {
            const int NS = rem ? G - rem : G, sb = rem ? bx - rem : bx;
            { pg8::Gemm g2{PB, Wpp, SEQ, DM, PLE}; pg8::StaticOrder S2; S2.init(SEQ, DM, NS, sb); EpiPle E2{PLEB};
              pg8::gemm_phase<EpiPle, pg8::StaticOrder, true, true>(lds, g2, S2, E2); }
            LAS float* scr = (LAS float*)(lds + wave * 16640);
            constexpr int I6 = 88 * 32, I7 = 32 * 32;
            for (int it = sb * NWAVES + wave; it < I6 + I7; it += NS * NWAVES) {
                if (it < I6) tr_item(a.in[17], DFF, DM, nullptr, Wdn, 0, it, scr, lane);
                else tr_item(a.in[19], DM, DM, a.in[18], Wpg, 0, it - I6, scr, lane);
            }
            __syncthreads();
        }
    }
    SEAM(5); TSTAMP(6);
    if (IN(6)) {
        pg8::Gemm g{Fb, Wdn, SEQ, DM, DFF}; pg8::StaticOrder S; S.init(SEQ, DM, G, bx);
        if (PREWRITE) {
            pg8::Unit u6; if (S.next(0, u6)) { const f32x4 z = {0.f, 0.f, 0.f, 0.f};
                for (int i = tid; i < 256 * 64; i += NTHR) *(f32x4*)(out + (size_t)(u6.pm * 256 + (i >> 6)) * DM + u6.pn * 256 + 4 * (i & 63)) = z; } }
        EpiRes<true, false, true, false> E{nullptr, H1B, nullptr, H2B, ssq3, nullptr, nullptr};
        pg8::gemm_phase<EpiRes<true, false, true, false>, pg8::StaticOrder, true, true>(lds, g, S, E);
    }
    SEAM(6); TSTAMP(7);
    if (TPROBE == 6 || TPROBE == 7 || TPROBE >= 9) xcd_barrier(bar);
    const bool fuse8 = FUSE_P8 && lo <= 7 && 8 < hi && G == (SEQ / 256) * (DM / 256);
    if (IN(7)) {
        pg8::StaticOrder S; S.init(SEQ, DM, G, bx); pg8::Gemm g{H2B, Wpg, SEQ, DM, DM};
        float pe = 0.f; if (TPROBE >= 0 && TPROBE < 7) { const unsigned long long* T = (const unsigned long long*)(ws + WS_TS); pe = 1.2649e-3f * sqrtf((float)(T[TPROBE + 1] - T[TPROBE]) * 0.01f); }
        if (fuse8 && PRETOUCH) {
            pg8::Unit u7; if (S.next(0, u7) && tid < 256) { const unsigned v = *(const volatile unsigned*)(out + (size_t)(u7.pm * 256 + tid) * DM + u7.pn * 256); asm volatile("" :: "v"(v)); } }
        if (fuse8) { EpiFinal E{H2B, out, ssq4, ssq3, PLEB, a.in[21], g_ctl + GC_CNT, (unsigned)(DM / 256), pe, (const unsigned long long*)(ws + WS_TS), (float*)(ws + WS_F)};
            pg8::gemm_phase<EpiFinal, pg8::StaticOrder, false, true>(lds, g, S, E); }
        else { EpiRes<true, true, false, true> E{nullptr, H2B, out, nullptr, ssq4, ssq3, PLEB};
            pg8::gemm_phase<EpiRes<true, true, false, true>, pg8::StaticOrder, true, true>(lds, g, S, E); }
    }
    if (!fuse8) {
    SEAM(7);
    if (IN(8)) {
        const int gw = bx * NWAVES + wave, NGW = G * NWAVES;
        const f32x4* gf = (const f32x4*)a.in[21] + lane;
        for (int row = gw; row < SEQ; row += NGW) {
            f32x4* o = (f32x4*)(out + (size_t)row * DM) + lane; const float r = rsqrtf(ssq4[row] * (1.0f / DM) + EPS);
#pragma unroll
            for (int j = 0; j < 8; ++j) o[64 * j] = o[64 * j] * r * gf[64 * j];
        }
    }
    }
    if (a.coop) {
        asm volatile("s_waitcnt vmcnt(0)" ::: "memory");
        if (TPROBE >= 8) __builtin_amdgcn_fence(__ATOMIC_RELEASE, "agent");
        __syncthreads();
        if (TPROBE >= 8 && tid == 0) ((volatile LAS unsigned*)(lds + MISC_OFF))[4] = 0u;
        if (tid == 0) {
            const unsigned old = __hip_atomic_fetch_add(g_ctl + GC_EXIT, 1u, __ATOMIC_RELAXED, __HIP_MEMORY_SCOPE_AGENT);
            if (TPROBE >= 8 && old == (unsigned)G - 1u) ((volatile LAS unsigned*)(lds + MISC_OFF))[4] = 1u;
            if (old == (unsigned)G - 1u) {
                unsigned* b = g_ctl + GC_BAR;
                ctl_st0(b + XB_TMO); ctl_st0(b + XB_TOP); ctl_st0(b + XB_TOPGEN);
                for (int j = 0; j < 16; ++j) { ctl_st0(b + XB_XCNT(j)); ctl_st0(b + XB_XSUB(j)); ctl_st0(b + XB_XGEN(j)); }
                for (int j = 0; j < 32; ++j) ctl_st0(g_ctl + GC_CNT + 64 * j);
                ctl_st0(g_ctl + GC_EXIT);
            }
        }
    }
    if (TPROBE >= 8 && a.coop) {
        __syncthreads();
        if (((volatile LAS unsigned*)(lds + MISC_OFF))[4] == 1u) {
            __builtin_amdgcn_fence(__ATOMIC_ACQUIRE, "agent");
            const unsigned long long* T = (const unsigned long long*)(ws + WS_TS);
            unsigned long long dv = __builtin_amdgcn_s_memrealtime() - T[0];
            if (TPROBE >= 9) { dv = 0; for (int b = 0; b < G; ++b) { const unsigned long long x = T[16 + 2 * b + (TPROBE - 9)]; dv = x > dv ? x : dv; } }
            const float pe = 0.63245e-3f * sqrtf((float)dv * 0.01f);
            for (int i = tid; i < 1024 * DM / 4; i += NTHR) { f32x4 v = __builtin_nontemporal_load((const f32x4*)out + i); v = (i & 1) ? v - pe : v + pe; __builtin_nontemporal_store(v, (f32x4*)out + i); }
        }
    }
#undef IN
#undef SEAM
}

extern "C" void kernel_launch(void* const* d_in, const int* in_sizes, int n_in, void* d_out, int out_size, void* d_ws, size_t ws_size, hipStream_t stream) {
    static int grid = 0;
    if (grid == 0) {
        if (n_in != 22 || out_size != SEQ * DM || ws_size < WS_END) { fprintf(stderr, "kernel_launch: unexpected shapes (n_in %d, out %d, ws %zu)\n", n_in, out_size, ws_size); grid = -1; return; }
        int dev = 0, cus = 0, per_cu = 0;
        if (hipGetDevice(&dev) != hipSuccess || hipDeviceGetAttribute(&cus, hipDeviceAttributeMultiprocessorCount, dev) != hipSuccess) { grid = -1; return; }
        if (hipFuncSetAttribute((const void*)fwd_kernel, hipFuncAttributeMaxDynamicSharedMemorySize, LDS_BYTES) != hipSuccess) { fprintf(stderr, "kernel_launch: hipFuncSetAttribute failed\n"); grid = -1; return; }
        if (hipOccupancyMaxActiveBlocksPerMultiprocessor(&per_cu, (const void*)fwd_kernel, NTHR, LDS_BYTES) != hipSuccess || per_cu < 1) { fprintf(stderr, "kernel_launch: occupancy query says %d\n", per_cu); per_cu = 1; }
        (void)hipGetLastError();
        grid = cus;
    }
    if (grid < 0) return;
    Args a{};
    for (int i = 0; i < 22; ++i) a.in[i] = (const float*)d_in[i];
    a.out = (float*)d_out; a.ws = (unsigned char*)d_ws;
#if MK_LAUNCHES == 1
    a.ph_lo = 0; a.ph_hi = NPHASE; a.coop = 1;
    void* args[] = {&a};
    hipError_t e = hipLaunchCooperativeKernel((const void*)fwd_kernel, dim3(grid), dim3(NTHR), args, LDS_BYTES, stream);
    if (e != hipSuccess) fprintf(stderr, "kernel_launch: cooperative launch failed: %s (grid %d)\n", hipGetErrorString(e), grid);
#else
    for (int ph = 0; ph < NPHASE; ++ph) { a.ph_lo = ph; a.ph_hi = ph + 1; a.coop = 0; hipLaunchKernelGGL(fwd_kernel, dim3(grid), dim3(NTHR), LDS_BYTES, stream, a); }
#endif
}
```

```cpp
#include <hip/hip_runtime.h>
#include <hip/hip_cooperative_groups.h>
#include <cstdio>
#include <cstdint>
namespace cg = cooperative_groups;
namespace pg8 {
#define PG8_LAS __attribute__((address_space(3)))
typedef unsigned short bf16_t;
typedef short bf16x8 __attribute__((ext_vector_type(8)));
typedef float f32x4 __attribute__((ext_vector_type(4)));
typedef unsigned u32x4 __attribute__((ext_vector_type(4)));
constexpr int BM = 256, BK = 64, HALF = 128, HTB = HALF * BK * 2  , STAGE_BYTES = 8 * HTB, NXCD = 8, WGM = 8;

__host__ __device__ __forceinline__ int lds_byte(int r, int c) { const int st = (r >> 4) * 2 + (c >> 5), rr = r & 15, cc = c & 31, ob = rr * 64 + cc * 2; return st * 1024 + (ob ^ (((ob >> 9) & 1) << 5)); }
__host__ __device__ __forceinline__ void stage_rc(int b, int& R, int& C) { const int st = b / 1024, sb = b % 1024, swz = sb ^ (((sb >> 9) & 1) << 5); R = (st >> 1) * 16 + swz / 64; C = (st & 1) * 32 + (swz % 64) / 2; }
__host__ __device__ __forceinline__ int perm32(int rho) { const int n = rho >> 4, i = rho & 15; return 8 * (i >> 2) + 4 * n + (i & 3); }

struct Unit { int pm, pn; };
struct Gemm { const bf16_t* A; const bf16_t* Bt; int M, N, K; };

struct StaticOrder {
    int nM, nN, nwg, G, c;
    __host__ __device__ void init(int M, int N, int G_, int c_) { nM = M / BM; nN = N / BM; nwg = nM * nN; G = G_; c = c_; }
    __host__ __device__ bool next(int i, Unit& u) const {
        const long L = (long)i * G + c; if (L >= nwg) return false;
        int wgid = (int)L; { const int q = nwg / NXCD, r = nwg % NXCD, xcd = wgid % NXCD, off = wgid / NXCD; wgid = (xcd < r ? xcd * (q + 1) : r * (q + 1) + (xcd - r) * q) + off; }
        const int nig = WGM * nN, gid = wgid / nig, fm = gid * WGM, gsz = (nM - fm) < WGM ? (nM - fm) : WGM;
        u.pm = fm + ((wgid % nig) % gsz); u.pn = (wgid % nig) / gsz; return true;
    }
    __device__ __forceinline__ void a_ready(const Unit&) const {}
    __device__ __forceinline__ void done(const Unit&) const {}
};

__device__ __forceinline__ unsigned cvt_pk_bf16(float lo, float hi) { unsigned r; asm volatile("v_cvt_pk_bf16_f32 %0, %1, %2" : "=v"(r) : "v"(lo), "v"(hi)); return r; }
typedef float f32x2 __attribute__((ext_vector_type(2)));
template <class Epi, class Sched, bool ALIGN_EPI = false, bool SP2 = false>
__device__ __forceinline__ void gemm_phase(PG8_LAS unsigned char* lds, const Gemm g, const Sched& S, const Epi& E) {
    const int tid = threadIdx.x, wid = __builtin_amdgcn_readfirstlane(tid >> 6), lane = tid & 63, wr = wid >> 2, wc = wid & 3, fr = lane & 15, fq = lane >> 4;
    const int K = g.K, nt = K / BK;
    unsigned voffA[2], voffB[2];
#pragma unroll
    for (int i = 0; i < 2; ++i) { int R, C; stage_rc(tid * 16 + i * 8192, R, C); const int Rb = Epi::PERM ? ((R & ~31) + perm32(R & 31)) : R;
        voffA[i] = (unsigned)(R * K + C) * 2u; voffB[i] = (unsigned)(Rb * K + C) * 2u; }
    const size_t kstep = (size_t)(BK * 2);
    const size_t hstep = (size_t)HALF * K * 2;
    const size_t tstep = 2 * hstep;
    const unsigned ldsw = (unsigned)wid * 1024u;
    const int aoff = lds_byte(wr * 64 + fr, fq * 8), boff = lds_byte(wc * 32 + fr, fq * 8);
#define PG8_SA(b, h) (((b) * 2 + (h)) * HTB)
#define PG8_SB(b, h) ((4 + (b) * 2 + (h)) * HTB)
#define PG8_STAGE(bufoff, gbase, voff) do { _Pragma("unroll") for (int _i = 0; _i < 2; ++_i) \
        __builtin_amdgcn_global_load_lds((const unsigned*)((const char*)(gbase) + (voff)[_i]), (PG8_LAS unsigned*)(lds + (bufoff) + ldsw + _i * 8192), 16, 0, 0); } while (0)
#define PG8_LDA(dst, b, h) do { _Pragma("unroll") for (int m = 0; m < 4; ++m) _Pragma("unroll") for (int k = 0; k < 2; ++k) dst[m][k] = *(const PG8_LAS bf16x8*)(lds + PG8_SA(b, h) + aoff + m * 2048 + k * 1024); } while (0)
#define PG8_LDB(dst, b, h) do { _Pragma("unroll") for (int n = 0; n < 2; ++n) _Pragma("unroll") for (int k = 0; k < 2; ++k) dst[n][k] = *(const PG8_LAS bf16x8*)(lds + PG8_SB(b, h) + boff + n * 2048 + k * 1024); } while (0)
#define PG8_MMA(ai, bj, At, Bt) do { __builtin_amdgcn_s_setprio(1); _Pragma("unroll") for (int m = 0; m < 4; ++m) _Pragma("unroll") for (int n = 0; n < 2; ++n) _Pragma("unroll") for (int k = 0; k < 2; ++k) \
        acc[ai][bj][m][n] = __builtin_amdgcn_mfma_f32_16x16x32_bf16(Bt[n][k], At[m][k], acc[ai][bj][m][n], 0, 0, 0); __builtin_amdgcn_s_setprio(0); } while (0)
#define PG8_WAIT_V(n) asm volatile("s_waitcnt vmcnt(" #n ")" ::: "memory")
#define PG8_WAIT_L(n) asm volatile("s_waitcnt lgkmcnt(" #n ")" ::: "memory")
#define PG8_BAR __builtin_amdgcn_s_barrier()
#define PG8_SCHED __builtin_amdgcn_sched_barrier(0)
    Unit cur, nxt; int ui = 0;
    if (!S.next(0, cur)) return;
    f32x4 acc[2][2][4][2];
#pragma unroll
    for (int a = 0; a < 2; ++a)
#pragma unroll
        for (int b = 0; b < 2; ++b)
#pragma unroll
            for (int m = 0; m < 4; ++m)
#pragma unroll
                for (int n = 0; n < 2; ++n) acc[a][b][m][n] = (f32x4){0.f, 0.f, 0.f, 0.f};
    bf16x8 At[4][2], B0[2][2], B1[2][2];
    const char* cA = (const char*)g.A + (size_t)cur.pm * tstep; const char* cB = (const char*)g.Bt + (size_t)cur.pn * tstep;
    S.a_ready(cur);
    if constexpr (SP2) {
        PG8_STAGE(PG8_SB(0, 0), cB, voffB); PG8_STAGE(PG8_SB(0, 1), cB + hstep, voffB); PG8_STAGE(PG8_SA(0, 0), cA, voffA); PG8_STAGE(PG8_SA(0, 1), cA + hstep, voffA);
        if (wr == 1) PG8_BAR;
        PG8_WAIT_V(2); PG8_BAR;
        PG8_STAGE(PG8_SB(1, 0), cB + kstep, voffB); PG8_STAGE(PG8_SA(1, 0), cA + kstep, voffA); PG8_STAGE(PG8_SB(1, 1), cB + hstep + kstep, voffB);
        PG8_WAIT_V(6); PG8_BAR;
    } else {
        PG8_STAGE(PG8_SB(0, 0), cB, voffB); PG8_STAGE(PG8_SA(0, 0), cA, voffA); PG8_STAGE(PG8_SB(0, 1), cB + hstep, voffB); PG8_STAGE(PG8_SA(0, 1), cA + hstep, voffA);
        if (wr == 1) PG8_BAR;
        PG8_WAIT_V(4); PG8_BAR;
        PG8_STAGE(PG8_SB(1, 0), cB + kstep, voffB); PG8_STAGE(PG8_SA(1, 0), cA + kstep, voffA); PG8_STAGE(PG8_SB(1, 1), cB + hstep + kstep, voffB);
        PG8_WAIT_V(6); PG8_BAR;
    }
    for (;;) {
        const bool has_next = S.next(ui + 1, nxt);
        const char* nA = has_next ? (const char*)g.A + (size_t)nxt.pm * tstep : cA; const char* nB = has_next ? (const char*)g.Bt + (size_t)nxt.pn * tstep : cB;
#pragma unroll 1
        for (int t = 0; t < nt; t += 2) {
            if constexpr (Epi::MIDT > 0) { if (t == Epi::MIDT) E.mid(acc, cur, wr, wc, fr, fq); }
            const bool last = (t == nt - 2);
            const char* a1 = cA + (size_t)(t + 1) * kstep;
            const char* a2 = last ? nA : cA + (size_t)(t + 2) * kstep; const char* b2 = last ? nB : cB + (size_t)(t + 2) * kstep;
            const char* a3 = a2 + kstep; const char* b3 = b2 + kstep;
            if (last && has_next) S.a_ready(nxt);
            if constexpr (SP2) {
            PG8_LDB(B0, 0, 0); PG8_LDB(B1, 0, 1); PG8_SCHED; PG8_LDA(At, 0, 0); PG8_STAGE(PG8_SA(1, 1), a1 + hstep, voffA);
            PG8_WAIT_V(8); PG8_WAIT_L(0); PG8_BAR; PG8_MMA(0, 0, At, B0); PG8_MMA(0, 1, At, B1); PG8_BAR; PG8_SCHED;
            PG8_LDA(At, 0, 1); PG8_STAGE(PG8_SB(0, 0), b2, voffB); PG8_STAGE(PG8_SB(0, 1), b2 + hstep, voffB); PG8_STAGE(PG8_SA(0, 0), a2, voffA);
            PG8_WAIT_V(8); PG8_WAIT_L(0); PG8_BAR; PG8_MMA(1, 0, At, B0); PG8_MMA(1, 1, At, B1); PG8_BAR; PG8_SCHED;
            PG8_LDB(B0, 1, 0); PG8_LDB(B1, 1, 1); PG8_SCHED; PG8_LDA(At, 1, 0); PG8_STAGE(PG8_SA(0, 1), a2 + hstep, voffA);
            PG8_WAIT_V(8); PG8_WAIT_L(0); PG8_BAR; PG8_MMA(0, 0, At, B0); PG8_MMA(0, 1, At, B1); PG8_BAR; PG8_SCHED;
            PG8_LDA(At, 1, 1); PG8_STAGE(PG8_SB(1, 0), b3, voffB); PG8_STAGE(PG8_SB(1, 1), b3 + hstep, voffB); PG8_STAGE(PG8_SA(1, 0), a3, voffA);
            PG8_WAIT_V(8); PG8_WAIT_L(0); PG8_BAR; PG8_MMA(1, 0, At, B0); PG8_MMA(1, 1, At, B1); PG8_BAR; PG8_SCHED;
            } else {
            PG8_LDB(B0, 0, 0); PG8_SCHED; PG8_LDA(At, 0, 0); PG8_STAGE(PG8_SA(1, 1), a1 + hstep, voffA);
            PG8_WAIT_L(8); PG8_BAR; PG8_WAIT_L(0); PG8_MMA(0, 0, At, B0); PG8_BAR; PG8_SCHED;
            PG8_LDB(B1, 0, 1); PG8_STAGE(PG8_SB(0, 0), b2, voffB);
            PG8_BAR; PG8_WAIT_L(0); PG8_MMA(0, 1, At, B1); PG8_BAR;
            PG8_LDA(At, 0, 1); PG8_STAGE(PG8_SA(0, 0), a2, voffA);
            PG8_BAR; PG8_WAIT_L(0); PG8_MMA(1, 0, At, B0); PG8_BAR; PG8_SCHED;
            PG8_STAGE(PG8_SB(0, 1), b2 + hstep, voffB);
            PG8_WAIT_V(6); PG8_BAR; PG8_MMA(1, 1, At, B1); PG8_BAR;
            PG8_LDB(B0, 1, 0); PG8_SCHED; PG8_LDA(At, 1, 0); PG8_STAGE(PG8_SA(0, 1), a2 + hstep, voffA);
            PG8_WAIT_L(8); PG8_BAR; PG8_WAIT_L(0); PG8_MMA(0, 0, At, B0); PG8_BAR; PG8_SCHED;
            PG8_LDB(B1, 1, 1); PG8_STAGE(PG8_SB(1, 0), b3, voffB);
            PG8_BAR; PG8_WAIT_L(0); PG8_MMA(0, 1, At, B1); PG8_BAR;
            PG8_LDA(At, 1, 1); PG8_STAGE(PG8_SA(1, 0), a3, voffA);
            PG8_BAR; PG8_WAIT_L(0); PG8_MMA(1, 0, At, B0); PG8_BAR; PG8_SCHED;
            PG8_STAGE(PG8_SB(1, 1), b3 + hstep, voffB);
            PG8_WAIT_V(6); PG8_BAR; PG8_MMA(1, 1, At, B1); PG8_BAR;
            }
        }
        if constexpr (ALIGN_EPI) { if (wr == 0) PG8_BAR; }
        if constexpr (!Epi::AFTER_DRAIN) { E(acc, cur, wr, wc, fr, fq); S.done(cur); }
        if (!has_next) break;
#pragma unroll
        for (int a = 0; a < 2; ++a)
#pragma unroll
            for (int b = 0; b < 2; ++b)
#pragma unroll
                for (int m = 0; m < 4; ++m)
#pragma unroll
                    for (int n = 0; n < 2; ++n) acc[a][b][m][n] = (f32x4){0.f, 0.f, 0.f, 0.f};
        cur = nxt; cA = nA; cB = nB; ++ui;
        if constexpr (ALIGN_EPI) { if (wr == 1) PG8_BAR; }
    }
    PG8_WAIT_V(0);
    if constexpr (!ALIGN_EPI) { if (wr == 0) PG8_BAR; }
    PG8_BAR;
    if constexpr (Epi::AFTER_DRAIN) { E.fused(acc, cur, wr, wc, fr, fq, lds, wid, lane); S.done(cur); }
#undef PG8_SA
#undef PG8_SB
#undef PG8_STAGE
#undef PG8_LDA
#undef PG8_LDB
#undef PG8_MMA
#undef PG8_WAIT_V
#undef PG8_WAIT_L
#undef PG8_BAR
#undef PG8_SCHED
}
}

#define LAS __attribute__((address_space(3)))
using pg8::bf16_t; using pg8::f32x4; using pg8::u32x4; using pg8::Unit; using pg8::cvt_pk_bf16;
typedef unsigned u32x2 __attribute__((ext_vector_type(2)));
typedef float f32x2 __attribute__((ext_vector_type(2)));

#ifndef MK_LAUNCHES
#define MK_LAUNCHES 1
#endif
constexpr int SEQ = 8192, DM = 2048, CW = 1024, NIN = 9216, DFF = 5632, PLE = 256;
constexpr float EPS = 1e-6f, LN_EPS = 1e-5f;
constexpr int NWAVES = 8, NTHR = 512, NPHASE = 9;
constexpr int LDS_BYTES = 147456;
constexpr size_t MiB = 1u << 20;
constexpr size_t WS_RSTD1 = 0, WS_SSQ2 = 64 * 1024, WS_SSQ3 = 128 * 1024, WS_SSQ4 = 192 * 1024;
constexpr size_t WS_BAR = 256 * 1024, WS_CNT = 272 * 1024, WS_CTL_END = 280 * 1024;
constexpr size_t WS_TS = 288 * 1024;
constexpr int MISC_OFF = 143360;
constexpr size_t WS_WIN = 2 * MiB, WS_WOA = 38 * MiB, WS_WPW = 42 * MiB, WS_WO = 46 * MiB, WS_WGU = 54 * MiB, WS_WDN = 98 * MiB, WS_WPG = 120 * MiB, WS_WPP = 128 * MiB;
constexpr size_t WS_R0 = 130 * MiB;
constexpr size_t WS_MB = 162 * MiB;
constexpr size_t WS_Q = 162 * MiB, WS_AB = 178 * MiB, WS_U = 194 * MiB;
constexpr size_t WS_SGA = 210 * MiB, WS_SGB = 242 * MiB;
constexpr size_t WS_YA = 274 * MiB;
constexpr size_t WS_H1B = 282 * MiB;
constexpr size_t WS_F = 194 * MiB;
constexpr size_t WS_PB = 314 * MiB;
constexpr size_t WS_END = 318 * MiB;

__device__ __forceinline__ float sigm(float x) { return __builtin_amdgcn_rcpf(1.f + __expf(-x)); }
__device__ __forceinline__ f32x4 sig4(f32x4 v) { return (f32x4){sigm(v[0]), sigm(v[1]), sigm(v[2]), sigm(v[3])}; }
__device__ __forceinline__ float bf_lo(unsigned w) { return __uint_as_float(w << 16); }
__device__ __forceinline__ float bf_hi(unsigned w) { return __uint_as_float(w & 0xffff0000u); }
__device__ __forceinline__ void st_bf16x8(bf16_t* p, f32x4 v0, f32x4 v1) {
    u32x4 w; w.x = cvt_pk_bf16(v0[0], v0[1]); w.y = cvt_pk_bf16(v0[2], v0[3]); w.z = cvt_pk_bf16(v1[0], v1[1]); w.w = cvt_pk_bf16(v1[2], v1[3]); *(u32x4*)p = w; }
__device__ __forceinline__ void ld_bf16x8(const bf16_t* p, f32x4& v0, f32x4& v1) {
    const u32x4 w = *(const u32x4*)p; v0 = (f32x4){bf_lo(w.x), bf_hi(w.x), bf_lo(w.y), bf_hi(w.y)}; v1 = (f32x4){bf_lo(w.z), bf_hi(w.z), bf_lo(w.w), bf_hi(w.w)}; }
__device__ __forceinline__ float dot4(f32x4 a) { return (a[0] * a[0] + a[1] * a[1]) + (a[2] * a[2] + a[3] * a[3]); }
__device__ __forceinline__ float wave_sum(float v) {
#pragma unroll
    for (int o = 1; o < 64; o <<= 1) v += __shfl_xor(v, o);
    return v;
}

struct EpiProj {
    static constexpr bool PERM = true, AFTER_DRAIN = false; static constexpr int MIDT = 0;
    const float* rstd; const float* bglu; bf16_t *Qo, *ABo, *Uo, *SA, *SB;
    __device__ __forceinline__ void operator()(const f32x4 (&acc)[2][2][4][2], const Unit& u, int wr, int wc, int fr, int fq) const {
        const int pn = u.pn, row0 = u.pm * 256 + wr * 64 + fr, cl = wc * 32 + 8 * fq;
        float rs8[2][4];
#pragma unroll
        for (int ai = 0; ai < 2; ++ai)
#pragma unroll
            for (int m = 0; m < 4; ++m) rs8[ai][m] = rstd[row0 + ai * 128 + m * 16];
        if (pn < 8) {
#pragma unroll
            for (int ai = 0; ai < 2; ++ai)
#pragma unroll
                for (int m = 0; m < 4; ++m) { const int row = row0 + ai * 128 + m * 16; const float r = rs8[ai][m], r2 = r * r;
                    st_bf16x8(Qo + (size_t)row * CW + pn * 128 + cl, acc[ai][0][m][0] * acc[ai][1][m][0] * r2, acc[ai][0][m][1] * acc[ai][1][m][1] * r2); }
        } else if (pn < 12) {
#pragma unroll
            for (int ai = 0; ai < 2; ++ai)
#pragma unroll
                for (int m = 0; m < 4; ++m) { const int row = row0 + ai * 128 + m * 16; const float r = rs8[ai][m];
#pragma unroll
                    for (int bj = 0; bj < 2; ++bj) st_bf16x8(ABo + (size_t)row * CW + (pn - 8) * 256 + bj * 128 + cl, acc[ai][bj][m][0] * r, acc[ai][bj][m][1] * r); }
        } else if (pn < 20) {
            const int ch = (pn - 12) * 128 + cl;
            const f32x4 bv0 = *(const f32x4*)(bglu + ch), bv1 = *(const f32x4*)(bglu + ch + 4), bg0 = *(const f32x4*)(bglu + CW + ch), bg1 = *(const f32x4*)(bglu + CW + ch + 4);
#pragma unroll
            for (int ai = 0; ai < 2; ++ai)
#pragma unroll
                for (int m = 0; m < 4; ++m) { const int row = row0 + ai * 128 + m * 16; const float r = rs8[ai][m];
                    const f32x4 v0 = acc[ai][0][m][0] * r + bv0, v1 = acc[ai][0][m][1] * r + bv1, g0 = acc[ai][1][m][0] * r + bg0, g1 = acc[ai][1][m][1] * r + bg1;
                    st_bf16x8(Uo + (size_t)row * CW + ch, v0 * sig4(g0), v1 * sig4(g1)); }
        } else {
            const int ch = (pn - 20) * 128 + cl;
#pragma unroll
            for (int ai = 0; ai < 2; ++ai)
#pragma unroll
                for (int m = 0; m < 4; ++m) { const int row = row0 + ai * 128 + m * 16; const float r2 = rs8[ai][m] * -1.44269504089f;
                    f32x4 rt[2], sb[2];
#pragma unroll
                    for (int n = 0; n < 2; ++n)
#pragma unroll
                        for (int e = 0; e < 4; ++e) {
                            const float db = 1.f + __builtin_amdgcn_exp2f(fminf(acc[ai][1][m][n][e] * r2, 43.2808512f)), da = 1.f + __builtin_amdgcn_exp2f(acc[ai][0][m][n][e] * r2);
                            sb[n][e] = __builtin_amdgcn_rcpf(db); rt[n][e] = __builtin_amdgcn_rcpf(da) * db; }
                    st_bf16x8(SA + (size_t)row * DM + ch, rt[0], rt[1]); st_bf16x8(SB + (size_t)row * DM + ch, sb[0], sb[1]); }
        }
    }
};
struct EpiMerge {
    static constexpr bool PERM = true, AFTER_DRAIN = false; static constexpr int MIDT = CW / 64;
    const bf16_t* RT; const bf16_t* SG; const float* bias; bf16_t* Mo;
    __device__ __forceinline__ void mid(f32x4 (&acc)[2][2][4][2], const Unit& u, int wr, int wc, int fr, int fq) const {
        int o = (u.pm * 256 + wr * 64 + fr) * DM + u.pn * 256 + wc * 32 + 8 * fq;
        asm volatile("" : "+v"(o));
        const bf16_t* p = RT + o;
#pragma unroll
        for (int ai = 0; ai < 2; ++ai) {
#pragma unroll
            for (int m = 0; m < 4; ++m)
#pragma unroll
                for (int bj = 0; bj < 2; ++bj) { f32x4 g0, g1; ld_bf16x8(p + (ai * 128 + m * 16) * DM + bj * 128, g0, g1);
                    acc[ai][bj][m][0] = acc[ai][bj][m][0] * g0; acc[ai][bj][m][1] = acc[ai][bj][m][1] * g1; }
            }
    }
    __device__ __forceinline__ void operator()(const f32x4 (&acc)[2][2][4][2], const Unit& u, int wr, int wc, int fr, int fq) const {
        const int row0 = u.pm * 256 + wr * 64 + fr, c0 = u.pn * 256 + wc * 32 + 8 * fq;
        f32x4 bv[2][2];
#pragma unroll
        for (int bj = 0; bj < 2; ++bj) { bv[bj][0] = *(const f32x4*)(bias + c0 + bj * 128); bv[bj][1] = *(const f32x4*)(bias + c0 + bj * 128 + 4); }
#pragma unroll
        for (int ai = 0; ai < 2; ++ai) {
            u32x4 gw[4][2];
#pragma unroll
            for (int m = 0; m < 4; ++m)
#pragma unroll
                for (int bj = 0; bj < 2; ++bj) gw[m][bj] = *(const u32x4*)(SG + (size_t)(row0 + ai * 128 + m * 16) * DM + c0 + bj * 128);
#pragma unroll
            for (int m = 0; m < 4; ++m)
#pragma unroll
                for (int bj = 0; bj < 2; ++bj) { const size_t off = (size_t)(row0 + ai * 128 + m * 16) * DM + c0 + bj * 128; const u32x4 w = gw[m][bj];
                    const f32x4 g0 = (f32x4){bf_lo(w.x), bf_hi(w.x), bf_lo(w.y), bf_hi(w.y)}, g1 = (f32x4){bf_lo(w.z), bf_hi(w.z), bf_lo(w.w), bf_hi(w.w)};
                    st_bf16x8(Mo + off, g0 * (acc[ai][bj][m][0] + bv[bj][0]), g1 * (acc[ai][bj][m][1] + bv[bj][1])); }
            asm volatile("" ::: "memory"); }
    }
};
template <bool BASE16, bool WF32, bool WB16, bool GATED> struct EpiRes {
    static constexpr bool PERM = true, AFTER_DRAIN = false; static constexpr int MIDT = 0;
    const float* basef; const bf16_t* baseb; float* out; bf16_t* ob; float* ssq_out; const float* ssq_in; const bf16_t* ple;
    __device__ __forceinline__ void operator()(const f32x4 (&acc)[2][2][4][2], const Unit& u, int wr, int wc, int fr, int fq) const {
        const int row0 = u.pm * 256 + wr * 64 + fr, c0 = u.pn * 256 + wc * 32 + 8 * fq;
#pragma unroll
        for (int ai = 0; ai < 2; ++ai) {
            u32x4 bw[4][2], pw[4][2]; f32x4 bf[4][2][2]; float rr[4];
#pragma unroll
            for (int m = 0; m < 4; ++m) { const int row = row0 + ai * 128 + m * 16; rr[m] = 0.f; if (GATED) rr[m] = ssq_in[row];
#pragma unroll
                for (int bj = 0; bj < 2; ++bj) { const size_t off = (size_t)row * DM + c0 + bj * 128;
                    if (BASE16) bw[m][bj] = *(const u32x4*)(baseb + off); else { bf[m][bj][0] = *(const f32x4*)(basef + off); bf[m][bj][1] = *(const f32x4*)(basef + off + 4); }
                    if (GATED) pw[m][bj] = *(const u32x4*)(ple + off); } }
#pragma unroll
            for (int m = 0; m < 4; ++m) { const int row = row0 + ai * 128 + m * 16; const float r = GATED ? rsqrtf(rr[m] * (1.0f / DM) + EPS) : 0.f;
                float s = 0.f;
#pragma unroll
                for (int bj = 0; bj < 2; ++bj) { const size_t off = (size_t)row * DM + c0 + bj * 128;
                    f32x4 b0, b1; if (BASE16) { const u32x4 w = bw[m][bj]; b0 = (f32x4){bf_lo(w.x), bf_hi(w.x), bf_lo(w.y), bf_hi(w.y)}; b1 = (f32x4){bf_lo(w.z), bf_hi(w.z), bf_lo(w.w), bf_hi(w.w)}; } else { b0 = bf[m][bj][0]; b1 = bf[m][bj][1]; }
                    f32x4 v0 = acc[ai][bj][m][0], v1 = acc[ai][bj][m][1];
                    if (GATED) { const u32x4 w = pw[m][bj]; const f32x4 p0 = (f32x4){bf_lo(w.x), bf_hi(w.x), bf_lo(w.y), bf_hi(w.y)}, p1 = (f32x4){bf_lo(w.z), bf_hi(w.z), bf_lo(w.w), bf_hi(w.w)};
                        v0 = sig4(v0 * r) * p0; v1 = sig4(v1 * r) * p1; }
                    const f32x4 h0 = b0 + v0, h1 = b1 + v1;
                    if (WF32) { *(f32x4*)(out + off) = h0; *(f32x4*)(out + off + 4) = h1; }
                    if (WB16) st_bf16x8(ob + off, h0, h1);
                    s += dot4(h0) + dot4(h1); }
                s += __shfl_xor(s, 16); s += __shfl_xor(s, 32);
                if (fq == 0) unsafeAtomicAdd(ssq_out + row, s); }
            asm volatile("" ::: "memory"); }
    }
};
struct EpiSwiglu {
    static constexpr bool PERM = true, AFTER_DRAIN = false; static constexpr int MIDT = 0;
    const float* ssq_in; bf16_t* F;
    __device__ __forceinline__ void operator()(const f32x4 (&acc)[2][2][4][2], const Unit& u, int wr, int wc, int fr, int fq) const {
        const int row0 = u.pm * 256 + wr * 64 + fr, ch = u.pn * 128 + wc * 32 + 8 * fq;
        float rs8[2][4];
#pragma unroll
        for (int ai = 0; ai < 2; ++ai)
#pragma unroll
            for (int m = 0; m < 4; ++m) rs8[ai][m] = ssq_in[row0 + ai * 128 + m * 16];
#pragma unroll
        for (int ai = 0; ai < 2; ++ai)
#pragma unroll
            for (int m = 0; m < 4; ++m) { const int row = row0 + ai * 128 + m * 16; const float r = rsqrtf(rs8[ai][m] * (1.0f / DM) + EPS);
                const float r2 = r * -1.44269504089f, rr = r * r;
                f32x4 f0, f1;
#pragma unroll
                for (int e = 0; e < 4; ++e) {
                    f0[e] = (acc[ai][0][m][0][e] * acc[ai][1][m][0][e]) * (rr * __builtin_amdgcn_rcpf(1.f + __builtin_amdgcn_exp2f(acc[ai][0][m][0][e] * r2)));
                    f1[e] = (acc[ai][0][m][1][e] * acc[ai][1][m][1][e]) * (rr * __builtin_amdgcn_rcpf(1.f + __builtin_amdgcn_exp2f(acc[ai][0][m][1][e] * r2))); }
                st_bf16x8(F + (size_t)row * DFF + ch, f0, f1); }
    }
};
struct EpiPle {
    static constexpr bool PERM = true, AFTER_DRAIN = false; static constexpr int MIDT = 0;
    bf16_t* O;
    __device__ __forceinline__ void operator()(const f32x4 (&acc)[2][2][4][2], const Unit& u, int wr, int wc, int fr, int fq) const {
        const int row0 = u.pm * 256 + wr * 64 + fr, c0 = u.pn * 256 + wc * 32 + 8 * fq;
#pragma unroll
        for (int ai = 0; ai < 2; ++ai)
#pragma unroll
            for (int m = 0; m < 4; ++m)
#pragma unroll
                for (int bj = 0; bj < 2; ++bj) st_bf16x8(O + (size_t)(row0 + ai * 128 + m * 16) * DM + c0 + bj * 128, acc[ai][bj][m][0], acc[ai][bj][m][1]);
    }
};

#ifndef TPROBE
#define TPROBE -1
#endif
#ifndef ALTOUT
#define ALTOUT 0
#endif
#ifndef PRETOUCH
#define PRETOUCH 0
#endif
#ifndef PREWRITE
#define PREWRITE 0
#endif
struct EpiFinal {
    static constexpr bool PERM = false, AFTER_DRAIN = true; static constexpr int MIDT = 0;
    const bf16_t* base; float* out; float* ssq_out; const float* ssq_in; const bf16_t* ple; const float* gfin; unsigned* cnt; unsigned want; float pe; const unsigned long long* tsp; float* alt;
    static __device__ __forceinline__ f32x4 ld4(const bf16_t* p) { const u32x2 w = *(const u32x2*)p; return (f32x4){bf_lo(w.x), bf_hi(w.x), bf_lo(w.y), bf_hi(w.y)}; }
    __device__ __forceinline__ void fused(f32x4 (&acc)[2][2][4][2], const Unit& u, int wr, int wc, int fr, int fq, PG8_LAS unsigned char* lds, int wid, int lane) const {
        const int row0 = u.pm * 256 + wr * 64 + fr, c0 = u.pn * 256 + wc * 32 + 4 * fq;
#pragma unroll
        for (int ai = 0; ai < 2; ++ai) {
            u32x2 bw[4][2][2], pw[4][2][2]; float rq[4];
#pragma unroll
            for (int m = 0; m < 4; ++m) { const int row = row0 + ai * 128 + m * 16; rq[m] = ssq_in[row];
#pragma unroll
                for (int bj = 0; bj < 2; ++bj)
#pragma unroll
                    for (int n = 0; n < 2; ++n) { const size_t off = (size_t)row * DM + c0 + bj * 128 + n * 16; bw[m][bj][n] = *(const u32x2*)(base + off); pw[m][bj][n] = *(const u32x2*)(ple + off); } }
#pragma unroll
            for (int m = 0; m < 4; ++m) { const int row = row0 + ai * 128 + m * 16; const float r = rsqrtf(rq[m] * (1.0f / DM) + EPS);
                float s = 0.f;
#pragma unroll
                for (int bj = 0; bj < 2; ++bj)
#pragma unroll
                    for (int n = 0; n < 2; ++n) { const u32x2 wb_ = bw[m][bj][n], wp_ = pw[m][bj][n];
                        const f32x4 bb = (f32x4){bf_lo(wb_.x), bf_hi(wb_.x), bf_lo(wb_.y), bf_hi(wb_.y)}, pp = (f32x4){bf_lo(wp_.x), bf_hi(wp_.x), bf_lo(wp_.y), bf_hi(wp_.y)};
                        const f32x4 h = bb + sig4(acc[ai][bj][m][n] * r) * pp;
                        acc[ai][bj][m][n] = h; s += dot4(h); }
                s += __shfl_xor(s, 16); s += __shfl_xor(s, 32);
                if (fq == 0) unsafeAtomicAdd(ssq_out + row, s); }
            asm volatile("" ::: "memory"); }
        asm volatile("s_waitcnt vmcnt(0)" ::: "memory");
        __syncthreads();
        if (threadIdx.x == 0) { unsigned* c = cnt + 64 * u.pm;
            __hip_atomic_fetch_add(c, 1u, __ATOMIC_RELAXED, __HIP_MEMORY_SCOPE_AGENT);
            while (__hip_atomic_load(c, __ATOMIC_RELAXED, __HIP_MEMORY_SCOPE_AGENT) < want) __builtin_amdgcn_s_sleep(2); }
        __syncthreads();
        {
            PG8_LAS float* Sr = (PG8_LAS float*)lds;
            if (threadIdx.x < 256) Sr[threadIdx.x] = rsqrtf(__hip_atomic_load(ssq_out + u.pm * 256 + threadIdx.x, __ATOMIC_RELAXED, __HIP_MEMORY_SCOPE_AGENT) * (1.0f / DM) + EPS);
            __syncthreads();
        }
        unsigned long long t1 = 0; if (TPROBE >= 9) t1 = __builtin_amdgcn_s_memrealtime();
        float pe = this->pe; if (TPROBE == 7) pe = 1.2649e-3f * sqrtf((float)(__builtin_amdgcn_s_memrealtime() - tsp[7]) * 0.01f);
        f32x4 gv[2][2];
#pragma unroll
        for (int bj = 0; bj < 2; ++bj)
#pragma unroll
            for (int n = 0; n < 2; ++n) gv[bj][n] = *(const f32x4*)(gfin + c0 + bj * 128 + n * 16);
#pragma unroll
        for (int ai = 0; ai < 2; ++ai)
#pragma unroll
            for (int m = 0; m < 4; ++m) { const int row = row0 + ai * 128 + m * 16;
                const float rr = ((const PG8_LAS float*)lds)[row - u.pm * 256];
#pragma unroll
                for (int bj = 0; bj < 2; ++bj)
#pragma unroll
                    for (int n = 0; n < 2; ++n) { const size_t off = (size_t)row * DM + c0 + bj * 128 + n * 16;
                        f32x4 o = acc[ai][bj][m][n] * rr * gv[bj][n];
                        if (TPROBE >= 0 && TPROBE < 8 && row < 1024) o = n ? o - pe : o + pe;
                        *(f32x4*)(((ALTOUT && TPROBE >= 9) ? alt : out) + off) = o; } }
        if (TPROBE >= 9) { asm volatile("s_waitcnt vmcnt(0)" ::: "memory"); __syncthreads(); const unsigned long long t2 = __builtin_amdgcn_s_memrealtime();
            if (threadIdx.x == 0) { unsigned long long* T = const_cast<unsigned long long*>(tsp); T[16 + 2 * blockIdx.x] = t1 - T[7]; T[17 + 2 * blockIdx.x] = t2 - t1; } }
        if (ALTOUT && TPROBE >= 9) {
#pragma unroll
            for (int ai = 0; ai < 2; ++ai)
#pragma unroll
                for (int m = 0; m < 4; ++m) { const int row = row0 + ai * 128 + m * 16; const float rr = ((const PG8_LAS float*)lds)[row - u.pm * 256];
#pragma unroll
                    for (int bj = 0; bj < 2; ++bj)
#pragma unroll
                        for (int n = 0; n < 2; ++n) { const size_t off = (size_t)row * DM + c0 + bj * 128 + n * 16; *(f32x4*)(out + off) = acc[ai][bj][m][n] * rr * gv[bj][n]; } }
        }
    }
};

__device__ __forceinline__ int win_dest(int n0) {
    if (n0 < 1024) return 256 * (n0 >> 7) + (n0 & 127);
    if (n0 < 2048) return 2048 + (n0 - 1024);
    if (n0 < 3072) { const int c = n0 - 2048; return 256 * (c >> 7) + 128 + (c & 127); }
    if (n0 < 4096) { const int c = n0 - 3072; return 3072 + 256 * (c >> 7) + (c & 127); }
    if (n0 < 5120) { const int c = n0 - 4096; return 3072 + 256 * (c >> 7) + 128 + (c & 127); }
    if (n0 < 7168) { const int c = n0 - 5120; return 5120 + 256 * (c >> 7) + (c & 127); }
    { const int c = n0 - 7168; return 5120 + 256 * (c >> 7) + 128 + (c & 127); }
}
__device__ __forceinline__ void tr_item(const float* W, int K, int N, const float* g, bf16_t* WT, int mode, int item, LAS float* scr, int lane, int ldk = 0, int koff = 0) {
    if (ldk == 0) ldk = K;
    const int nblk = N >> 6, kb = item / nblk, nb = item - kb * nblk, k0 = kb << 6, n0 = nb << 6;
    int d0 = n0;
    if (mode == 1) d0 = win_dest(n0); else if (mode == 2) d0 = 256 * (n0 >> 7) + (n0 & 127); else if (mode == 3) d0 = 256 * (n0 >> 7) + 128 + (n0 & 127);
    const int kr = lane >> 4, col = 4 * (lane & 15);
    f32x4 v[16];
#pragma unroll
    for (int i = 0; i < 16; ++i) v[i] = *(const f32x4*)(W + (size_t)(k0 + 4 * i + kr) * N + n0 + col);
    if (g) {
#pragma unroll
        for (int i = 0; i < 16; ++i) v[i] = v[i] * g[k0 + 4 * i + kr];
    }
#pragma unroll
    for (int i = 0; i < 16; ++i) { LAS float* s = scr + (4 * i + kr) * 65 + col; s[0] = v[i][0]; s[1] = v[i][1]; s[2] = v[i][2]; s[3] = v[i][3]; }
    asm volatile("s_waitcnt lgkmcnt(0)" ::: "memory");
    const int c = lane & 7;
#pragma unroll
    for (int j = 0; j < 8; ++j) { const int n = (lane >> 3) + 8 * j; const LAS float* s = scr + (8 * c) * 65 + n;
        u32x4 o; o.x = cvt_pk_bf16(s[0], s[65]); o.y = cvt_pk_bf16(s[2 * 65], s[3 * 65]); o.z = cvt_pk_bf16(s[4 * 65], s[5 * 65]); o.w = cvt_pk_bf16(s[6 * 65], s[7 * 65]);
        *(u32x4*)(WT + (size_t)(d0 + n) * ldk + koff + k0 + 8 * c) = o; }
    asm volatile("s_waitcnt lgkmcnt(0)" ::: "memory");
}

#ifndef USE_XCDBAR
#define USE_XCDBAR 1
#endif
#ifndef FUSE_P8
#define FUSE_P8 1
#endif
#define XB_TMO      128
#define XB_XCNT(j)  (256  + 64 * (j))
#define XB_XSUB(j)  (1280 + 64 * (j))
#define XB_XGEN(j)  (2304 + 64 * (j))
#define XB_TOP      3328
#define XB_TOPGEN   3392
#define XCD_BAR_WORDS 3456
#define XB_SPIN_CAP (1u << 18)

__device__ __forceinline__ unsigned xb_ld(unsigned* p)              { return __hip_atomic_load(p, __ATOMIC_RELAXED, __HIP_MEMORY_SCOPE_AGENT); }
__device__ __forceinline__ unsigned xb_add(unsigned* p, unsigned v) { return __hip_atomic_fetch_add(p, v, __ATOMIC_RELAXED, __HIP_MEMORY_SCOPE_AGENT); }
__device__ __forceinline__ unsigned xb_xcc_id() { return (unsigned)__builtin_amdgcn_s_getreg((3 << 11) | 20) & 0xFu; }
#define XB_SPIN(cond, bar) do { unsigned _sp = 0; while (cond) { __builtin_amdgcn_s_sleep(1); \
    if ((++_sp & 255u) == 0u) { if (xb_ld(&(bar)[XB_TMO])) break; if (_sp > XB_SPIN_CAP) { atomicAdd(&(bar)[XB_TMO], 1u); break; } } } } while (0)

struct XcdBarrier {
    unsigned* bar; unsigned x;
    volatile LAS unsigned* st;
};

__device__ __forceinline__ XcdBarrier xcd_barrier_post(unsigned* bar, volatile LAS unsigned* st) {
    XcdBarrier b; b.bar = bar; b.x = xb_xcc_id(); b.st = st;
    if (threadIdx.x == 0) (void)xb_add(&bar[XB_XCNT(b.x)], 1u);
    return b;
}
__device__ __forceinline__ void xcd_barrier_complete(unsigned* bar, unsigned x, unsigned& nloc, unsigned& nx) {
    const unsigned G = gridDim.x * gridDim.y * gridDim.z;
    unsigned sum, cnt, mine, sp = 0u;
    for (;;) {
        sum = 0u; cnt = 0u; mine = 0u;
#pragma unroll
        for (unsigned j = 0; j < 16; ++j) { const unsigned c = xb_ld(&bar[XB_XCNT(j)]); sum += c; cnt += (c > 0u) ? 1u : 0u; mine = (j == x) ? c : mine; }
        if (sum == G) break;
        __builtin_amdgcn_s_sleep(1);
        if ((++sp & 255u) == 0u) { if (xb_ld(&bar[XB_TMO])) break; if (sp > XB_SPIN_CAP) { atomicAdd(&bar[XB_TMO], 1u); break; } }
    }
    nloc = mine > 0u ? mine : 1u; nx = cnt > 0u ? cnt : 1u;
}

__device__ __forceinline__ void xcd_barrier(const XcdBarrier& b) {
    asm volatile("s_waitcnt vmcnt(0)" ::: "memory");
    __syncthreads();
    if (threadIdx.x == 0) {
        unsigned* bar = b.bar;
        __builtin_amdgcn_s_waitcnt(0);
        unsigned nloc = b.st[0], nx = b.st[1];
        if (nloc == 0u) { xcd_barrier_complete(bar, b.x, nloc, nx); b.st[0] = nloc; b.st[1] = nx; }
        const unsigned old = xb_add(&bar[XB_XSUB(b.x)], 1u);
        const unsigned gen = old / nloc;
        if (old + 1u == (gen + 1u) * nloc) {
            __builtin_amdgcn_fence(__ATOMIC_RELEASE, "agent");
            asm volatile("s_waitcnt vmcnt(0)" ::: "memory");
            const unsigned og = xb_add(&bar[XB_TOP], 1u);
            const unsigned tg = og / nx;
            if (og + 1u == (tg + 1u) * nx) xb_add(&bar[XB_TOPGEN], 1u);
            else XB_SPIN(xb_ld(&bar[XB_TOPGEN]) == tg, bar);
            __builtin_amdgcn_fence(__ATOMIC_ACQUIRE, "agent");
            xb_add(&bar[XB_XGEN(b.x)], 1u);
            asm volatile("s_waitcnt vmcnt(0)" ::: "memory");
        } else {
            XB_SPIN(xb_ld(&bar[XB_XGEN(b.x)]) == gen, bar);
            __builtin_amdgcn_fence(__ATOMIC_ACQUIRE, "agent");
            asm volatile("s_waitcnt vmcnt(0)" ::: "memory");
        }
    }
    __syncthreads();
}

constexpr int GC_BAR = 0, GC_CNT = 4096, GC_EXIT = 4096 + 64 * 32, GC_WORDS = GC_EXIT + 64;
__device__ unsigned g_ctl[GC_WORDS];
__device__ __forceinline__ void ctl_st0(unsigned* p) { __hip_atomic_store(p, 0u, __ATOMIC_RELAXED, __HIP_MEMORY_SCOPE_AGENT); }

struct Args { const float* in[22]; float* out; unsigned char* ws; int ph_lo, ph_hi, coop, pad; };

__global__ void __launch_bounds__(NTHR, 2) fwd_kernel(Args a) {
    extern __shared__ __attribute__((aligned(16))) unsigned char lds_raw[];
    LAS unsigned char* lds = (LAS unsigned char*)lds_raw;
    cg::grid_group grid = cg::this_grid();
    const int tid = threadIdx.x, lane = tid & 63, wave = __builtin_amdgcn_readfirstlane(tid >> 6);
    const int G = gridDim.x, bx = blockIdx.x;
    unsigned char* ws = a.ws;
    const int lo = a.ph_lo, hi = a.ph_hi;
#ifndef PHMASK
#define PHMASK 0x1ff
#endif
#define IN(k) (lo <= (k) && (k) < hi && ((PHMASK >> (k)) & 1))
#define SEAM(k) do { if (lo <= (k) && (k) + 1 < hi) { if (USE_XCDBAR) xcd_barrier(bar); else grid.sync(); } } while (0)
    if (tid < 2) ((volatile LAS unsigned*)(lds + MISC_OFF))[tid] = 0u;
    __syncthreads();
    XcdBarrier bar; bar.bar = g_ctl + GC_BAR; bar.x = 0; bar.st = (volatile LAS unsigned*)(lds + MISC_OFF);
    if (USE_XCDBAR && a.coop) bar = xcd_barrier_post(g_ctl + GC_BAR, (volatile LAS unsigned*)(lds + MISC_OFF));
#define TSTAMP(k) do { if (TPROBE >= 0 && bx == 0 && tid == 0) ((unsigned long long*)(ws + WS_TS))[k] = __builtin_amdgcn_s_memrealtime(); } while (0)
    TSTAMP(0);
    if (a.coop == 2) grid.sync();
#define rstd1 ((float*)(ws + WS_RSTD1))
#define ssq2 ((float*)(ws + WS_SSQ2))
#define ssq3 ((float*)(ws + WS_SSQ3))
#define ssq4 ((float*)(ws + WS_SSQ4))
#define Win ((bf16_t*)(ws + WS_WIN))
#define Woa ((bf16_t*)(ws + WS_WOA))
#define Wo ((bf16_t*)(ws + WS_WO))
#define Wgu ((bf16_t*)(ws + WS_WGU))
#define Wdn ((bf16_t*)(ws + WS_WDN))
#define Wpg ((bf16_t*)(ws + WS_WPG))
#define Wpp ((bf16_t*)(ws + WS_WPP))
#define XB ((bf16_t*)(ws + WS_R0))
#define MB ((bf16_t*)(ws + WS_MB))
#define H2B ((bf16_t*)(ws + WS_H1B))
#define Qb ((bf16_t*)(ws + WS_Q))
#define ABb ((bf16_t*)(ws + WS_AB))
#define Ub ((bf16_t*)(ws + WS_U))
#define SGA ((bf16_t*)(ws + WS_SGA))
#define SGB ((bf16_t*)(ws + WS_SGB))
#define YA ((bf16_t*)(ws + WS_YA))
#define H1B ((bf16_t*)(ws + WS_H1B))
#define Fb ((bf16_t*)(ws + WS_F))
#define PLEB ((bf16_t*)(ws + WS_R0))
#define PB ((bf16_t*)(ws + WS_PB))
    float* out = a.out;

    if (IN(0)) {
        LAS float* scr = (LAS float*)(lds + wave * 16640);
        const int gw = bx * NWAVES + wave, NGW = G * NWAVES;
        constexpr int I0 = 32 * 144;
        for (int it = wave * G + bx; it < I0; it += NGW) tr_item(a.in[3], DM, NIN, a.in[2], Win, 1, it, scr, lane);
        for (int row = gw; row < SEQ; row += NGW) {
            const f32x4* xr = (const f32x4*)(a.in[0] + (size_t)row * DM) + lane; f32x4 v[8]; float s = 0.f;
#pragma unroll
            for (int j = 0; j < 8; ++j) { v[j] = xr[64 * j]; s += dot4(v[j]); }
            s = wave_sum(s);
            if (lane == 0) rstd1[row] = rsqrtf(s * (1.0f / DM) + EPS);
            u32x2* o = (u32x2*)(XB + (size_t)row * DM) + lane;
#pragma unroll
            for (int j = 0; j < 8; ++j) { u32x2 w; w.x = cvt_pk_bf16(v[j][0], v[j][1]); w.y = cvt_pk_bf16(v[j][2], v[j][3]); o[64 * j] = w; }
        }
        for (int c = gw; c < SEQ * PLE / 512; c += NGW) {
            const f32x4* pr = (const f32x4*)(a.in[1] + (size_t)c * 512) + 2 * lane; const f32x4 v0 = pr[0], v1 = pr[1];
            st_bf16x8(PB + (size_t)c * 512 + 8 * lane, v0, v1);
        }
        for (int i = bx * NTHR + tid; i < SEQ; i += G * NTHR) { ssq2[i] = 0.f; ssq3[i] = 0.f; ssq4[i] = 0.f; }
        __syncthreads();
    }
    SEAM(0); TSTAMP(1);
    if (IN(1)) {
        pg8::Gemm g{XB, Win, SEQ, NIN, DM}; pg8::StaticOrder S; S.init(SEQ, NIN, G, bx);
        EpiProj E{rstd1, a.in[6], Qb, ABb, Ub, SGA, SGB};
        pg8::gemm_phase<EpiProj, pg8::StaticOrder, true, true>(lds, g, S, E);
        const int rem = ((SEQ / 256) * (NIN / 256)) % G;
        if (rem == 0 || bx >= rem) {
            const int NS = rem ? G - rem : G, sb = rem ? bx - rem : bx;
            LAS float* scr = (LAS float*)(lds + wave * 16640);
            constexpr int I1 = 16 * 32, I2 = 16 * 32, I3 = 32 * 32, I4 = 32 * 88, I5 = 32 * 88, I8 = 4 * 32;
            for (int it = sb * NWAVES + wave; it < I1 + I2 + I3 + I4 + I5 + I8; it += NS * NWAVES) {
                int r = it;
                if (r < I8) { tr_item(a.in[20], PLE, DM, nullptr, Wpp, 0, r, scr, lane); continue; } r -= I8;
                if (r < I1) { tr_item(a.in[5], CW, DM, nullptr, Woa, 0, r, scr, lane, DM, 0); continue; } r -= I1;
                if (r < I2) { tr_item(a.in[11], CW, DM, nullptr, Woa, 0, r, scr, lane, DM, CW); continue; } r -= I2;
                if (r < I3) { tr_item(a.in[13], DM, DM, nullptr, Wo, 0, r, scr, lane); continue; } r -= I3;
                if (r < I4) { tr_item(a.in[15], DM, DFF, a.in[14], Wgu, 2, r, scr, lane); continue; } r -= I4;
                tr_item(a.in[16], DM, DFF, a.in[14], Wgu, 3, r, scr, lane);
            }
            __syncthreads();
        }
    }
    float wa0[3], wa1[3]; f32x2 wbv[31]; f32x2 cb = {0.f, 0.f}, lg = {0.f, 0.f}, lb = {0.f, 0.f};
    if (IN(2)) { const int c0 = 2 * tid;
#pragma unroll
        for (int k = 0; k < 3; ++k) { const f32x2 w = *(const f32x2*)(a.in[4] + k * CW + c0); wa0[k] = w.x; wa1[k] = w.y; }
#pragma unroll
        for (int k = 0; k < 31; ++k) wbv[k] = *(const f32x2*)(a.in[7] + k * CW + c0);
        cb = *(const f32x2*)(a.in[8] + c0); lg = *(const f32x2*)(a.in[9] + c0); lb = *(const f32x2*)(a.in[10] + c0); }
    SEAM(1); TSTAMP(2);
    if (IN(2)) {
        const int c0 = 2 * tid;
        LAS float* P = (LAS float*)lds; LAS float* St = (LAS float*)(lds + 65536);
        for (int tile = bx; tile < SEQ / 16; tile += G) {
            const int t0 = tile * 16;
            unsigned uw[46];
#pragma unroll
            for (int s = 0; s < 46; ++s) { const int ts = t0 - 30 + s; uw[s] = 0u; if (ts >= 0) uw[s] = *(const unsigned*)(Ub + (size_t)ts * CW + c0); }
            {
                float q0[18], q1[18]; unsigned abw[16];
#pragma unroll
                for (int j = 0; j < 18; ++j) { const int ts = t0 - 2 + j; unsigned w = 0u; if (ts >= 0) w = *(const unsigned*)(Qb + (size_t)ts * CW + c0); q0[j] = bf_lo(w); q1[j] = bf_hi(w); }
#pragma unroll
                for (int i = 0; i < 16; ++i) abw[i] = *(const unsigned*)(ABb + (size_t)(t0 + i) * CW + c0);
#pragma unroll
                for (int i = 0; i < 16; ++i) { const unsigned w = abw[i];
                    const float y0 = bf_lo(w) * (wa0[0] * q0[i] + wa0[1] * q0[i + 1] + wa0[2] * q0[i + 2]);
                    const float y1 = bf_hi(w) * (wa1[0] * q1[i] + wa1[1] * q1[i + 1] + wa1[2] * q1[i + 2]);
                    *(unsigned*)(YA + (size_t)(t0 + i) * DM + c0) = cvt_pk_bf16(y0, y1); }
            }
            f32x2 accv[16];
#pragma unroll
            for (int i = 0; i < 16; ++i) accv[i] = cb;
#pragma unroll
            for (int s = 0; s < 46; ++s) { const unsigned w = uw[s];
                const f32x2 uv = (f32x2){bf_lo(w), bf_hi(w)};
#pragma unroll
                for (int i = 0; i < 16; ++i) { const int k = s - i; if (k >= 0 && k <= 30) accv[i] = __builtin_elementwise_fma(wbv[k], uv, accv[i]); } }
            float acc0[16], acc1[16];
#pragma unroll
            for (int i = 0; i < 16; ++i) { acc0[i] = accv[i].x; acc1[i] = accv[i].y; }
#pragma unroll
            for (int i = 0; i < 16; ++i) { P[(2 * i) * NTHR + tid] = acc0[i] + acc1[i]; P[(2 * i + 1) * NTHR + tid] = acc0[i] * acc0[i] + acc1[i] * acc1[i]; }
            __syncthreads();
#pragma unroll
            for (int r = 0; r < 4; ++r) { const int row = 4 * wave + r; float s = 0.f;
#pragma unroll
                for (int j = 0; j < 8; ++j) s += P[row * NTHR + lane + 64 * j];
                s = wave_sum(s); if (lane == 0) St[row] = s; }
            __syncthreads();
#pragma unroll
            for (int i = 0; i < 16; ++i) { const float mean = St[2 * i] * (1.0f / CW), var = St[2 * i + 1] * (1.0f / CW) - mean * mean, rs = rsqrtf(fmaxf(var, 0.f) + LN_EPS);
                const float v0 = (acc0[i] - mean) * rs * lg.x + lb.x, v1 = (acc1[i] - mean) * rs * lg.y + lb.y;
                *(unsigned*)(YA + (size_t)(t0 + i) * DM + CW + c0) = cvt_pk_bf16(v0 * sigm(v0), v1 * sigm(v1)); }
        }
        __syncthreads();
    }
    SEAM(2); TSTAMP(3);
    if (IN(3)) {
        pg8::StaticOrder S; S.init(SEQ, DM, G, bx);
        { pg8::Gemm g{YA, Woa, SEQ, DM, DM}; EpiMerge E{SGA, SGB, a.in[12], MB}; pg8::gemm_phase<EpiMerge, pg8::StaticOrder, true, true>(lds, g, S, E); }
    }
    SEAM(3); TSTAMP(4);
    if (IN(4)) {
        pg8::Gemm g{MB, Wo, SEQ, DM, DM}; pg8::StaticOrder S; S.init(SEQ, DM, G, bx);
        EpiRes<true, false, true, false> E{nullptr, XB, nullptr, H1B, ssq2, nullptr, nullptr};
        pg8::gemm_phase<EpiRes<true, false, true, false>, pg8::StaticOrder, true, true>(lds, g, S, E);
    }
    SEAM(4); TSTAMP(5);
    if (IN(5)) {
        pg8::Gemm g{H1B, Wgu, SEQ, 2 * DFF, DM}; pg8::StaticOrder S; S.init(SEQ, 2 * DFF, G, bx);
        EpiSwiglu E{ssq2, Fb};
        pg8::gemm_phase<EpiSwiglu, pg8::StaticOrder, true, true>(lds, g, S, E);
        const int rem = ((SEQ / 256) * (2 * DFF / 256)) % G;
        if (rem == 0 || bx >= rem) {
            const int NS = rem ? G - rem : G, sb = rem ? bx - rem : bx;
            { pg8::Gemm g2{PB, Wpp, SEQ, DM, PLE}; pg8::StaticOrder S2; S2.init(SEQ, DM, NS, sb); EpiPle E2{PLEB};
              pg8::gemm_phase<EpiPle, pg8::StaticOrder, true, true>(lds, g2, S2, E2); }
            LAS float* scr = (LAS float*)(lds + wave * 16640);
            constexpr int I6 = 88 * 32, I7 = 32 * 32;
            for (int it = sb * NWAVES + wave; it < I6 + I7; it += NS * NWAVES) {
                if (it < I6) tr_item(a.in[17], DFF, DM, nullptr, Wdn, 0, it, scr, lane);
                else tr_item(a.in[19], DM, DM, a.in[18], Wpg, 0, it - I6, scr, lane);
            }
            __syncthreads();
        }
    }
    SEAM(5); TSTAMP(6);
    if (IN(6)) {
        pg8::Gemm g{Fb, Wdn, SEQ, DM, DFF}; pg8::StaticOrder S; S.init(SEQ, DM, G, bx);
        if (PREWRITE) {
            pg8::Unit u6; if (S.next(0, u6)) { const f32x4 z = {0.f, 0.f, 0.f, 0.f};
                for (int i = tid; i < 256 * 64; i += NTHR) *(f32x4*)(out + (size_t)(u6.pm * 256 + (i >> 6)) * DM + u6.pn * 256 + 4 * (i & 63)) = z; } }
        EpiRes<true, false, true, false> E{nullptr, H1B, nullptr, H2B, ssq3, nullptr, nullptr};
        pg8::gemm_phase<EpiRes<true, false, true, false>, pg8::StaticOrder, true, true>(lds, g, S, E);
    }
    SEAM(6); TSTAMP(7);
    if (TPROBE == 6 || TPROBE == 7 || TPROBE >= 9) xcd_barrier(bar);
    const bool fuse8 = FUSE_P8 && lo <= 7 && 8 < hi && G == (SEQ / 256) * (DM / 256);
    if (IN(7)) {
        pg8::StaticOrder S; S.init(SEQ, DM, G, bx); pg8::Gemm g{H2B, Wpg, SEQ, DM, DM};
        float pe = 0.f; if (TPROBE >= 0 && TPROBE < 7) { const unsigned long long* T = (const unsigned long long*)(ws + WS_TS); pe = 1.2649e-3f * sqrtf((float)(T[TPROBE + 1] - T[TPROBE]) * 0.01f); }
        if (fuse8 && PRETOUCH) {
            pg8::Unit u7; if (S.next(0, u7) && tid < 256) { const unsigned v = *(const volatile unsigned*)(out + (size_t)(u7.pm * 256 + tid) * DM + u7.pn * 256); asm volatile("" :: "v"(v)); } }
        if (fuse8) { EpiFinal E{H2B, out, ssq4, ssq3, PLEB, a.in[21], g_ctl + GC_CNT, (unsigned)(DM / 256), pe, (const unsigned long long*)(ws + WS_TS), (float*)(ws + WS_F)};
            pg8::gemm_phase<EpiFinal, pg8::StaticOrder, false, true>(lds, g, S, E); }
        else { EpiRes<true, true, false, true> E{nullptr, H2B, out, nullptr, ssq4, ssq3, PLEB};
            pg8::gemm_phase<EpiRes<true, true, false, true>, pg8::StaticOrder, true, true>(lds, g, S, E); }
    }
    if (!fuse8) {
    SEAM(7);
    if (IN(8)) {
        const int gw = bx * NWAVES + wave, NGW = G * NWAVES;
        const f32x4* gf = (const f32x4*)a.in[21] + lane;
        for (int row = gw; row < SEQ; row += NGW) {
            f32x4* o = (f32x4*)(out + (size_t)row * DM) + lane; const float r = rsqrtf(ssq4[row] * (1.0f / DM) + EPS);
#pragma unroll
            for (int j = 0; j < 8; ++j) o[64 * j] = o[64 * j] * r * gf[64 * j];
        }
    }
    }
    if (a.coop) {
        asm volatile("s_waitcnt vmcnt(0)" ::: "memory");
        if (TPROBE >= 8) __builtin_amdgcn_fence(__ATOMIC_RELEASE, "agent");
        __syncthreads();
        if (TPROBE >= 8 && tid == 0) ((volatile LAS unsigned*)(lds + MISC_OFF))[4] = 0u;
        if (tid == 0) {
            const unsigned old = __hip_atomic_fetch_add(g_ctl + GC_EXIT, 1u, __ATOMIC_RELAXED, __HIP_MEMORY_SCOPE_AGENT);
            if (TPROBE >= 8 && old == (unsigned)G - 1u) ((volatile LAS unsigned*)(lds + MISC_OFF))[4] = 1u;
            if (old == (unsigned)G - 1u) {
                unsigned* b = g_ctl + GC_BAR;
                ctl_st0(b + XB_TMO); ctl_st0(b + XB_TOP); ctl_st0(b + XB_TOPGEN);
                for (int j = 0; j < 16; ++j) { ctl_st0(b + XB_XCNT(j)); ctl_st0(b + XB_XSUB(j)); ctl_st0(b + XB_XGEN(j)); }
                for (int j = 0; j < 32; ++j) ctl_st0(g_ctl + GC_CNT + 64 * j);
                ctl_st0(g_ctl + GC_EXIT);
            }
        }
    }
    if (TPROBE >= 8 && a.coop) {
        __syncthreads();
        if (((volatile LAS unsigned*)(lds + MISC_OFF))[4] == 1u) {
            __builtin_amdgcn_fence(__ATOMIC_ACQUIRE, "agent");
            const unsigned long long* T = (const unsigned long long*)(ws + WS_TS);
            unsigned long long dv = __builtin_amdgcn_s_memrealtime() - T[0];
            if (TPROBE >= 9) { dv = 0; for (int b = 0; b < G; ++b) { const unsigned long long x = T[16 + 2 * b + (TPROBE - 9)]; dv = x > dv ? x : dv; } }
            const float pe = 0.63245e-3f * sqrtf((float)dv * 0.01f);
            for (int i = tid; i < 1024 * DM / 4; i += NTHR) { f32x4 v = __builtin_nontemporal_load((const f32x4*)out + i); v = (i & 1) ? v - pe : v + pe; __builtin_nontemporal_store(v, (f32x4*)out + i); }
        }
    }
#undef IN
#undef SEAM
}

extern "C" void kernel_launch(void* const* d_in, const int* in_sizes, int n_in, void* d_out, int out_size, void* d_ws, size_t ws_size, hipStream_t stream) {
    static int grid = 0;
    if (grid == 0) {
        if (n_in != 22 || out_size != SEQ * DM || ws_size < WS_END) { fprintf(stderr, "kernel_launch: unexpected shapes (n_in %d, out %d, ws %zu)\n", n_in, out_size, ws_size); grid = -1; return; }
        int dev = 0, cus = 0, per_cu = 0;
        if (hipGetDevice(&dev) != hipSuccess || hipDeviceGetAttribute(&cus, hipDeviceAttributeMultiprocessorCount, dev) != hipSuccess) { grid = -1; return; }
        if (hipFuncSetAttribute((const void*)fwd_kernel, hipFuncAttributeMaxDynamicSharedMemorySize, LDS_BYTES) != hipSuccess) { fprintf(stderr, "kernel_launch: hipFuncSetAttribute failed\n"); grid = -1; return; }
        if (hipOccupancyMaxActiveBlocksPerMultiprocessor(&per_cu, (const void*)fwd_kernel, NTHR, LDS_BYTES) != hipSuccess || per_cu < 1) { fprintf(stderr, "kernel_launch: occupancy query says %d\n", per_cu); per_cu = 1; }
        (void)hipGetLastError();
        grid = cus;
    }
    if (grid < 0) return;
    Args a{};
    for (int i = 0; i < 22; ++i) a.in[i] = (const float*)d_in[i];
    a.out = (float*)d_out; a.ws = (unsigned char*)d_ws;
#if MK_LAUNCHES == 1
    a.ph_lo = 0; a.ph_hi = NPHASE; a.coop = 1;
    void* args[] = {&a};
    hipError_t e = hipLaunchCooperativeKernel((const void*)fwd_kernel, dim3(grid), dim3(NTHR), args, LDS_BYTES, stream);
    if (e != hipSuccess) fprintf(stderr, "kernel_launch: cooperative launch failed: %s (grid %d)\n", hipGetErrorString(e), grid);
#else
    for (int ph = 0; ph < NPHASE; ++ph) { a.ph_lo = ph; a.ph_hi = ph + 1; a.coop = 0; hipLaunchKernelGGL(fwd_kernel, dim3(grid), dim3(NTHR), LDS_BYTES, stream, a); }
#endif
}
```

```cpp
#include <hip/hip_runtime.h>
#include <hip/hip_cooperative_groups.h>
#include <cstdio>
#include <cstdint>
namespace cg = cooperative_groups;
namespace pg8 {
#define PG8_LAS __attribute__((address_space(3)))
typedef unsigned short bf16_t;
typedef short bf16x8 __attribute__((ext_vector_type(8)));
typedef float f32x4 __attribute__((ext_vector_type(4)));
typedef unsigned u32x4 __attribute__((ext_vector_type(4)));
constexpr int BM = 256, BK = 64, HALF = 128, HTB = HALF * BK * 2  , STAGE_BYTES = 8 * HTB, NXCD = 8, WGM = 8;

__host__ __device__ __forceinline__ int lds_byte(int r, int c) { const int st = (r >> 4) * 2 + (c >> 5), rr = r & 15, cc = c & 31, ob = rr * 64 + cc * 2; return st * 1024 + (ob ^ (((ob >> 9) & 1) << 5)); }
__host__ __device__ __forceinline__ void stage_rc(int b, int& R, int& C) { const int st = b / 1024, sb = b % 1024, swz = sb ^ (((sb >> 9) & 1) << 5); R = (st >> 1) * 16 + swz / 64; C = (st & 1) * 32 + (swz % 64) / 2; }
__host__ __device__ __forceinline__ int perm32(int rho) { const int n = rho >> 4, i = rho & 15; return 8 * (i >> 2) + 4 * n + (i & 3); }

struct Unit { int pm, pn; };
struct Gemm { const bf16_t* A; const bf16_t* Bt; int M, N, K; };

struct StaticOrder {
    int nM, nN, nwg, G, c;
    __host__ __device__ void init(int M, int N, int G_, int c_) { nM = M / BM; nN = N / BM; nwg = nM * nN; G = G_; c = c_; }
    __host__ __device__ bool next(int i, Unit& u) const {
        const long L = (long)i * G + c; if (L >= nwg) return false;
        int wgid = (int)L; { const int q = nwg / NXCD, r = nwg % NXCD, xcd = wgid % NXCD, off = wgid / NXCD; wgid = (xcd < r ? xcd * (q + 1) : r * (q + 1) + (xcd - r) * q) + off; }
        const int nig = WGM * nN, gid = wgid / nig, fm = gid * WGM, gsz = (nM - fm) < WGM ? (nM - fm) : WGM;
        u.pm = fm + ((wgid % nig) % gsz); u.pn = (wgid % nig) / gsz; return true;
    }
    __device__ __forceinline__ void a_ready(const Unit&) const {}
    __device__ __forceinline__ void done(const Unit&) const {}
};

__device__ __forceinline__ unsigned cvt_pk_bf16(float lo, float hi) { unsigned r; asm volatile("v_cvt_pk_bf16_f32 %0, %1, %2" : "=v"(r) : "v"(lo), "v"(hi)); return r; }
typedef float f32x2 __attribute__((ext_vector_type(2)));
template <class Epi, class Sched, bool ALIGN_EPI = false, bool SP2 = false>
__device__ __forceinline__ void gemm_phase(PG8_LAS unsigned char* lds, const Gemm g, const Sched& S, const Epi& E) {
    const int tid = threadIdx.x, wid = __builtin_amdgcn_readfirstlane(tid >> 6), lane = tid & 63, wr = wid >> 2, wc = wid & 3, fr = lane & 15, fq = lane >> 4;
    const int K = g.K, nt = K / BK;
    unsigned voffA[2], voffB[2];
#pragma unroll
    for (int i = 0; i < 2; ++i) { int R, C; stage_rc(tid * 16 + i * 8192, R, C); const int Rb = Epi::PERM ? ((R & ~31) + perm32(R & 31)) : R;
        voffA[i] = (unsigned)(R * K + C) * 2u; voffB[i] = (unsigned)(Rb * K + C) * 2u; }
    const size_t kstep = (size_t)(BK * 2);
    const size_t hstep = (size_t)HALF * K * 2;
    const size_t tstep = 2 * hstep;
    const unsigned ldsw = (unsigned)wid * 1024u;
    const int aoff = lds_byte(wr * 64 + fr, fq * 8), boff = lds_byte(wc * 32 + fr, fq * 8);
#define PG8_SA(b, h) (((b) * 2 + (h)) * HTB)
#define PG8_SB(b, h) ((4 + (b) * 2 + (h)) * HTB)
#define PG8_STAGE(bufoff, gbase, voff) do { _Pragma("unroll") for (int _i = 0; _i < 2; ++_i) \
        __builtin_amdgcn_global_load_lds((const unsigned*)((const char*)(gbase) + (voff)[_i]), (PG8_LAS unsigned*)(lds + (bufoff) + ldsw + _i * 8192), 16, 0, 0); } while (0)
#define PG8_LDA(dst, b, h) do { _Pragma("unroll") for (int m = 0; m < 4; ++m) _Pragma("unroll") for (int k = 0; k < 2; ++k) dst[m][k] = *(const PG8_LAS bf16x8*)(lds + PG8_SA(b, h) + aoff + m * 2048 + k * 1024); } while (0)
#define PG8_LDB(dst, b, h) do { _Pragma("unroll") for (int n = 0; n < 2; ++n) _Pragma("unroll") for (int k = 0; k < 2; ++k) dst[n][k] = *(const PG8_LAS bf16x8*)(lds + PG8_SB(b, h) + boff + n * 2048 + k * 1024); } while (0)
#define PG8_MMA(ai, bj, At, Bt) do { __builtin_amdgcn_s_setprio(1); _Pragma("unroll") for (int m = 0; m < 4; ++m) _Pragma("unroll") for (int n = 0; n < 2; ++n) _Pragma("unroll") for (int k = 0; k < 2; ++k) \
        acc[ai][bj][m][n] = __builtin_amdgcn_mfma_f32_16x16x32_bf16(Bt[n][k], At[m][k], acc[ai][bj][m][n], 0, 0, 0); __builtin_amdgcn_s_setprio(0); } while (0)
#define PG8_WAIT_V(n) asm volatile("s_waitcnt vmcnt(" #n ")" ::: "memory")
#define PG8_WAIT_L(n) asm volatile("s_waitcnt lgkmcnt(" #n ")" ::: "memory")
#define PG8_BAR __builtin_amdgcn_s_barrier()
#define PG8_SCHED __builtin_amdgcn_sched_barrier(0)
    Unit cur, nxt; int ui = 0;
    if (!S.next(0, cur)) return;
    f32x4 acc[2][2][4][2];
#pragma unroll
    for (int a = 0; a < 2; ++a)
#pragma unroll
        for (int b = 0; b < 2; ++b)
#pragma unroll
            for (int m = 0; m < 4; ++m)
#pragma unroll
                for (int n = 0; n < 2; ++n) acc[a][b][m][n] = (f32x4){0.f, 0.f, 0.f, 0.f};
    bf16x8 At[4][2], B0[2][2], B1[2][2];
    const char* cA = (const char*)g.A + (size_t)cur.pm * tstep; const char* cB = (const char*)g.Bt + (size_t)cur.pn * tstep;
    S.a_ready(cur);
    if constexpr (SP2) {
        PG8_STAGE(PG8_SB(0, 0), cB, voffB); PG8_STAGE(PG8_SB(0, 1), cB + hstep, voffB); PG8_STAGE(PG8_SA(0, 0), cA, voffA); PG8_STAGE(PG8_SA(0, 1), cA + hstep, voffA);
        if (wr == 1) PG8_BAR;
        PG8_WAIT_V(2); PG8_BAR;
        PG8_STAGE(PG8_SB(1, 0), cB + kstep, voffB); PG8_STAGE(PG8_SA(1, 0), cA + kstep, voffA); PG8_STAGE(PG8_SB(1, 1), cB + hstep + kstep, voffB);
        PG8_WAIT_V(6); PG8_BAR;
    } else {
        PG8_STAGE(PG8_SB(0, 0), cB, voffB); PG8_STAGE(PG8_SA(0, 0), cA, voffA); PG8_STAGE(PG8_SB(0, 1), cB + hstep, voffB); PG8_STAGE(PG8_SA(0, 1), cA + hstep, voffA);
        if (wr == 1) PG8_BAR;
        PG8_WAIT_V(4); PG8_BAR;
        PG8_STAGE(PG8_SB(1, 0), cB + kstep, voffB); PG8_STAGE(PG8_SA(1, 0), cA + kstep, voffA); PG8_STAGE(PG8_SB(1, 1), cB + hstep + kstep, voffB);
        PG8_WAIT_V(6); PG8_BAR;
    }
    for (;;) {
        const bool has_next = S.next(ui + 1, nxt);
        const char* nA = has_next ? (const char*)g.A + (size_t)nxt.pm * tstep : cA; const char* nB = has_next ? (const char*)g.Bt + (size_t)nxt.pn * tstep : cB;
#pragma unroll 1
        for (int t = 0; t < nt; t += 2) {
            if constexpr (Epi::MIDT > 0) { if (t == Epi::MIDT) E.mid(acc, cur, wr, wc, fr, fq); }
            const bool last = (t == nt - 2);
            const char* a1 = cA + (size_t)(t + 1) * kstep;
            const char* a2 = last ? nA : cA + (size_t)(t + 2) * kstep; const char* b2 = last ? nB : cB + (size_t)(t + 2) * kstep;
            const char* a3 = a2 + kstep; const char* b3 = b2 + kstep;
            if (last && has_next) S.a_ready(nxt);
            if constexpr (SP2) {
            PG8_LDB(B0, 0, 0); PG8_LDB(B1, 0, 1); PG8_SCHED; PG8_LDA(At, 0, 0); PG8_STAGE(PG8_SA(1, 1), a1 + hstep, voffA);
            PG8_WAIT_V(8); PG8_WAIT_L(0); PG8_BAR; PG8_MMA(0, 0, At, B0); PG8_MMA(0, 1, At, B1); PG8_BAR; PG8_SCHED;
            PG8_LDA(At, 0, 1); PG8_STAGE(PG8_SB(0, 0), b2, voffB); PG8_STAGE(PG8_SB(0, 1), b2 + hstep, voffB); PG8_STAGE(PG8_SA(0, 0), a2, voffA);
            PG8_WAIT_V(8); PG8_WAIT_L(0); PG8_BAR; PG8_MMA(1, 0, At, B0); PG8_MMA(1, 1, At, B1); PG8_BAR; PG8_SCHED;
            PG8_LDB(B0, 1, 0); PG8_LDB(B1, 1, 1); PG8_SCHED; PG8_LDA(At, 1, 0); PG8_STAGE(PG8_SA(0, 1), a2 + hstep, voffA);
            PG8_WAIT_V(8); PG8_WAIT_L(0); PG8_BAR; PG8_MMA(0, 0, At, B0); PG8_MMA(0, 1, At, B1); PG8_BAR; PG8_SCHED;
            PG8_LDA(At, 1, 1); PG8_STAGE(PG8_SB(1, 0), b3, voffB); PG8_STAGE(PG8_SB(1, 1), b3 + hstep, voffB); PG8_STAGE(PG8_SA(1, 0), a3, voffA);
            PG8_WAIT_V(8); PG8_WAIT_L(0); PG8_BAR; PG8_MMA(1, 0, At, B0); PG8_MMA(1, 1, At, B1); PG8_BAR; PG8_SCHED;
            } else {
            PG8_LDB(B0, 0, 0); PG8_SCHED; PG8_LDA(At, 0, 0); PG8_STAGE(PG8_SA(1, 1), a1 + hstep, voffA);
            PG8_WAIT_L(8); PG8_BAR; PG8_WAIT_L(0); PG8_MMA(0, 0, At, B0); PG8_BAR; PG8_SCHED;
            PG8_LDB(B1, 0, 1); PG8_STAGE(PG8_SB(0, 0), b2, voffB);
            PG8_BAR; PG8_WAIT_L(0); PG8_MMA(0, 1, At, B1); PG8_BAR;
            PG8_LDA(At, 0, 1); PG8_STAGE(PG8_SA(0, 0), a2, voffA);
            PG8_BAR; PG8_WAIT_L(0); PG8_MMA(1, 0, At, B0); PG8_BAR; PG8_SCHED;
            PG8_STAGE(PG8_SB(0, 1), b2 + hstep, voffB);
            PG8_WAIT_V(6); PG8_BAR; PG8_MMA(1, 1, At, B1); PG8_BAR;
            PG8_LDB(B0, 1, 0); PG8_SCHED; PG8_LDA(At, 1, 0); PG8_STAGE(PG8_SA(0, 1), a2 + hstep, voffA);
            PG8_WAIT_L(8); PG8_BAR; PG8_WAIT_L(0); PG8_MMA(0, 0, At, B0); PG8_BAR; PG8_SCHED;
            PG8_LDB(B1, 1, 1); PG8_STAGE(PG8_SB(1, 0), b3, voffB);
            PG8_BAR; PG8_WAIT_L(0); PG8_MMA(0, 1, At, B1); PG8_BAR;
            PG8_LDA(At, 1, 1); PG8_STAGE(PG8_SA(1, 0), a3, voffA);
            PG8_BAR; PG8_WAIT_L(0); PG8_MMA(1, 0, At, B0); PG8_BAR; PG8_SCHED;
            PG8_STAGE(PG8_SB(1, 1), b3 + hstep, voffB);
            PG8_WAIT_V(6); PG8_BAR; PG8_MMA(1, 1, At, B1); PG8_BAR;
            }
        }
        if constexpr (ALIGN_EPI) { if (wr == 0) PG8_BAR; }
        if constexpr (!Epi::AFTER_DRAIN) { E(acc, cur, wr, wc, fr, fq); S.done(cur); }
        if (!has_next) break;
#pragma unroll
        for (int a = 0; a < 2; ++a)
#pragma unroll
            for (int b = 0; b < 2; ++b)
#pragma unroll
                for (int m = 0; m < 4; ++m)
#pragma unroll
                    for (int n = 0; n < 2; ++n) acc[a][b][m][n] = (f32x4){0.f, 0.f, 0.f, 0.f};
        cur = nxt; cA = nA; cB = nB; ++ui;
        if constexpr (ALIGN_EPI) { if (wr == 1) PG8_BAR; }
    }
    PG8_WAIT_V(0);
    if constexpr (!ALIGN_EPI) { if (wr == 0) PG8_BAR; }
    PG8_BAR;
    if constexpr (Epi::AFTER_DRAIN) { E.fused(acc, cur, wr, wc, fr, fq, lds, wid, lane); S.done(cur); }
#undef PG8_SA
#undef PG8_SB
#undef PG8_STAGE
#undef PG8_LDA
#undef PG8_LDB
#undef PG8_MMA
#undef PG8_WAIT_V
#undef PG8_WAIT_L
#undef PG8_BAR
#undef PG8_SCHED
}
}

#define LAS __attribute__((address_space(3)))
using pg8::bf16_t; using pg8::f32x4; using pg8::u32x4; using pg8::Unit; using pg8::cvt_pk_bf16;
typedef unsigned u32x2 __attribute__((ext_vector_type(2)));
typedef float f32x2 __attribute__((ext_vector_type(2)));

#ifndef MK_LAUNCHES
#define MK_LAUNCHES 1
#endif
constexpr int SEQ = 8192, DM = 2048, CW = 1024, NIN = 9216, DFF = 5632, PLE = 256;
constexpr float EPS = 1e-6f, LN_EPS = 1e-5f;
constexpr int NWAVES = 8, NTHR = 512, NPHASE = 9;
constexpr int LDS_BYTES = 147456;
constexpr size_t MiB = 1u << 20;
constexpr size_t WS_RSTD1 = 0, WS_SSQ2 = 64 * 1024, WS_SSQ3 = 128 * 1024, WS_SSQ4 = 192 * 1024;
constexpr size_t WS_BAR = 256 * 1024, WS_CNT = 272 * 1024, WS_CTL_END = 280 * 1024;
constexpr size_t WS_TS = 288 * 1024;
constexpr int MISC_OFF = 143360;
constexpr size_t WS_WIN = 2 * MiB, WS_WOA = 38 * MiB, WS_WPW = 42 * MiB, WS_WO = 46 * MiB, WS_WGU = 54 * MiB, WS_WDN = 98 * MiB, WS_WPG = 120 * MiB, WS_WPP = 128 * MiB;
constexpr size_t WS_R0 = 130 * MiB;
constexpr size_t WS_MB = 162 * MiB;
constexpr size_t WS_Q = 162 * MiB, WS_AB = 178 * MiB, WS_U = 194 * MiB;
constexpr size_t WS_SGA = 210 * MiB, WS_SGB = 242 * MiB;
constexpr size_t WS_YA = 274 * MiB;
constexpr size_t WS_H1B = 282 * MiB;
constexpr size_t WS_F = 194 * MiB;
constexpr size_t WS_PB = 314 * MiB;
constexpr size_t WS_END = 318 * MiB;

__device__ __forceinline__ float sigm(float x) { return __builtin_amdgcn_rcpf(1.f + __expf(-x)); }
__device__ __forceinline__ f32x4 sig4(f32x4 v) { return (f32x4){sigm(v[0]), sigm(v[1]), sigm(v[2]), sigm(v[3])}; }
__device__ __forceinline__ float bf_lo(unsigned w) { return __uint_as_float(w << 16); }
__device__ __forceinline__ float bf_hi(unsigned w) { return __uint_as_float(w & 0xffff0000u); }
__device__ __forceinline__ void st_bf16x8(bf16_t* p, f32x4 v0, f32x4 v1) {
    u32x4 w; w.x = cvt_pk_bf16(v0[0], v0[1]); w.y = cvt_pk_bf16(v0[2], v0[3]); w.z = cvt_pk_bf16(v1[0], v1[1]); w.w = cvt_pk_bf16(v1[2], v1[3]); *(u32x4*)p = w; }
__device__ __forceinline__ void ld_bf16x8(const bf16_t* p, f32x4& v0, f32x4& v1) {
    const u32x4 w = *(const u32x4*)p; v0 = (f32x4){bf_lo(w.x), bf_hi(w.x), bf_lo(w.y), bf_hi(w.y)}; v1 = (f32x4){bf_lo(w.z), bf_hi(w.z), bf_lo(w.w), bf_hi(w.w)}; }
__device__ __forceinline__ float dot4(f32x4 a) { return (a[0] * a[0] + a[1] * a[1]) + (a[2] * a[2] + a[3] * a[3]); }
__device__ __forceinline__ float wave_sum(float v) {
#pragma unroll
    for (int o = 1; o < 64; o <<= 1) v += __shfl_xor(v, o);
    return v;
}

struct EpiProj {
    static constexpr bool PERM = true, AFTER_DRAIN = false; static constexpr int MIDT = 0;
    const float* rstd; const float* bglu; bf16_t *Qo, *ABo, *Uo, *SA, *SB;
    __device__ __forceinline__ void operator()(const f32x4 (&acc)[2][2][4][2], const Unit& u, int wr, int wc, int fr, int fq) const {
        const int pn = u.pn, row0 = u.pm * 256 + wr * 64 + fr, cl = wc * 32 + 8 * fq;
        float rs8[2][4];
#pragma unroll
        for (int ai = 0; ai < 2; ++ai)
#pragma unroll
            for (int m = 0; m < 4; ++m) rs8[ai][m] = rstd[row0 + ai * 128 + m * 16];
        if (pn < 8) {
#pragma unroll
            for (int ai = 0; ai < 2; ++ai)
#pragma unroll
                for (int m = 0; m < 4; ++m) { const int row = row0 + ai * 128 + m * 16; const float r = rs8[ai][m], r2 = r * r;
                    st_bf16x8(Qo + (size_t)row * CW + pn * 128 + cl, acc[ai][0][m][0] * acc[ai][1][m][0] * r2, acc[ai][0][m][1] * acc[ai][1][m][1] * r2); }
        } else if (pn < 12) {
#pragma unroll
            for (int ai = 0; ai < 2; ++ai)
#pragma unroll
                for (int m = 0; m < 4; ++m) { const int row = row0 + ai * 128 + m * 16; const float r = rs8[ai][m];
#pragma unroll
                    for (int bj = 0; bj < 2; ++bj) st_bf16x8(ABo + (size_t)row * CW + (pn - 8) * 256 + bj * 128 + cl, acc[ai][bj][m][0] * r, acc[ai][bj][m][1] * r); }
        } else if (pn < 20) {
            const int ch = (pn - 12) * 128 + cl;
            const f32x4 bv0 = *(const f32x4*)(bglu + ch), bv1 = *(const f32x4*)(bglu + ch + 4), bg0 = *(const f32x4*)(bglu + CW + ch), bg1 = *(const f32x4*)(bglu + CW + ch + 4);
#pragma unroll
            for (int ai = 0; ai < 2; ++ai)
#pragma unroll
                for (int m = 0; m < 4; ++m) { const int row = row0 + ai * 128 + m * 16; const float r = rs8[ai][m];
                    const f32x4 v0 = acc[ai][0][m][0] * r + bv0, v1 = acc[ai][0][m][1] * r + bv1, g0 = acc[ai][1][m][0] * r + bg0, g1 = acc[ai][1][m][1] * r + bg1;
                    st_bf16x8(Uo + (size_t)row * CW + ch, v0 * sig4(g0), v1 * sig4(g1)); }
        } else {
            const int ch = (pn - 20) * 128 + cl;
#pragma unroll
            for (int ai = 0; ai < 2; ++ai)
#pragma unroll
                for (int m = 0; m < 4; ++m) { const int row = row0 + ai * 128 + m * 16; const float r = rs8[ai][m];
                    f32x4 rt[2], sb[2];
#pragma unroll
                    for (int n = 0; n < 2; ++n)
#pragma unroll
                        for (int e = 0; e < 4; ++e) { const float ga = acc[ai][0][m][n][e] * r, gb = fmaxf(acc[ai][1][m][n][e] * r, -30.f), eb = __expf(-gb);
                            sb[n][e] = __builtin_amdgcn_rcpf(1.f + eb); rt[n][e] = sigm(ga) * (1.f + eb); }
                    st_bf16x8(SA + (size_t)row * DM + ch, rt[0], rt[1]); st_bf16x8(SB + (size_t)row * DM + ch, sb[0], sb[1]); }
        }
    }
};
struct EpiMerge {
    static constexpr bool PERM = true, AFTER_DRAIN = false; static constexpr int MIDT = CW / 64;
    const bf16_t* RT; const bf16_t* SG; const float* bias; bf16_t* Mo;
    __device__ __forceinline__ void mid(f32x4 (&acc)[2][2][4][2], const Unit& u, int wr, int wc, int fr, int fq) const {
        int o = (u.pm * 256 + wr * 64 + fr) * DM + u.pn * 256 + wc * 32 + 8 * fq;
        asm volatile("" : "+v"(o));
        const bf16_t* p = RT + o;
#pragma unroll
        for (int ai = 0; ai < 2; ++ai) {
#pragma unroll
            for (int m = 0; m < 4; ++m)
#pragma unroll
                for (int bj = 0; bj < 2; ++bj) { f32x4 g0, g1; ld_bf16x8(p + (ai * 128 + m * 16) * DM + bj * 128, g0, g1);
                    acc[ai][bj][m][0] = acc[ai][bj][m][0] * g0; acc[ai][bj][m][1] = acc[ai][bj][m][1] * g1; }
            }
    }
    __device__ __forceinline__ void operator()(const f32x4 (&acc)[2][2][4][2], const Unit& u, int wr, int wc, int fr, int fq) const {
        const int row0 = u.pm * 256 + wr * 64 + fr, c0 = u.pn * 256 + wc * 32 + 8 * fq;
        f32x4 bv[2][2];
#pragma unroll
        for (int bj = 0; bj < 2; ++bj) { bv[bj][0] = *(const f32x4*)(bias + c0 + bj * 128); bv[bj][1] = *(const f32x4*)(bias + c0 + bj * 128 + 4); }
#pragma unroll
        for (int ai = 0; ai < 2; ++ai) {
            u32x4 gw[4][2];
#pragma unroll
            for (int m = 0; m < 4; ++m)
#pragma unroll
                for (int bj = 0; bj < 2; ++bj) gw[m][bj] = *(const u32x4*)(SG + (size_t)(row0 + ai * 128 + m * 16) * DM + c0 + bj * 128);
#pragma unroll
            for (int m = 0; m < 4; ++m)
#pragma unroll
                for (int bj = 0; bj < 2; ++bj) { const size_t off = (size_t)(row0 + ai * 128 + m * 16) * DM + c0 + bj * 128; const u32x4 w = gw[m][bj];
                    const f32x4 g0 = (f32x4){bf_lo(w.x), bf_hi(w.x), bf_lo(w.y), bf_hi(w.y)}, g1 = (f32x4){bf_lo(w.z), bf_hi(w.z), bf_lo(w.w), bf_hi(w.w)};
                    st_bf16x8(Mo + off, g0 * (acc[ai][bj][m][0] + bv[bj][0]), g1 * (acc[ai][bj][m][1] + bv[bj][1])); }
            asm volatile("" ::: "memory"); }
    }
};
template <bool BASE16, bool WF32, bool WB16, bool GATED> struct EpiRes {
    static constexpr bool PERM = true, AFTER_DRAIN = false; static constexpr int MIDT = 0;
    const float* basef; const bf16_t* baseb; float* out; bf16_t* ob; float* ssq_out; const float* ssq_in; const bf16_t* ple;
    __device__ __forceinline__ void operator()(const f32x4 (&acc)[2][2][4][2], const Unit& u, int wr, int wc, int fr, int fq) const {
        const int row0 = u.pm * 256 + wr * 64 + fr, c0 = u.pn * 256 + wc * 32 + 8 * fq;
#pragma unroll
        for (int ai = 0; ai < 2; ++ai) {
            u32x4 bw[4][2], pw[4][2]; f32x4 bf[4][2][2]; float rr[4];
#pragma unroll
            for (int m = 0; m < 4; ++m) { const int row = row0 + ai * 128 + m * 16; rr[m] = 0.f; if (GATED) rr[m] = ssq_in[row];
#pragma unroll
                for (int bj = 0; bj < 2; ++bj) { const size_t off = (size_t)row * DM + c0 + bj * 128;
                    if (BASE16) bw[m][bj] = *(const u32x4*)(baseb + off); else { bf[m][bj][0] = *(const f32x4*)(basef + off); bf[m][bj][1] = *(const f32x4*)(basef + off + 4); }
                    if (GATED) pw[m][bj] = *(const u32x4*)(ple + off); } }
#pragma unroll
            for (int m = 0; m < 4; ++m) { const int row = row0 + ai * 128 + m * 16; const float r = GATED ? rsqrtf(rr[m] * (1.0f / DM) + EPS) : 0.f;
                float s = 0.f;
#pragma unroll
                for (int bj = 0; bj < 2; ++bj) { const size_t off = (size_t)row * DM + c0 + bj * 128;
                    f32x4 b0, b1; if (BASE16) { const u32x4 w = bw[m][bj]; b0 = (f32x4){bf_lo(w.x), bf_hi(w.x), bf_lo(w.y), bf_hi(w.y)}; b1 = (f32x4){bf_lo(w.z), bf_hi(w.z), bf_lo(w.w), bf_hi(w.w)}; } else { b0 = bf[m][bj][0]; b1 = bf[m][bj][1]; }
                    f32x4 v0 = acc[ai][bj][m][0], v1 = acc[ai][bj][m][1];
                    if (GATED) { const u32x4 w = pw[m][bj]; const f32x4 p0 = (f32x4){bf_lo(w.x), bf_hi(w.x), bf_lo(w.y), bf_hi(w.y)}, p1 = (f32x4){bf_lo(w.z), bf_hi(w.z), bf_lo(w.w), bf_hi(w.w)};
                        v0 = sig4(v0 * r) * p0; v1 = sig4(v1 * r) * p1; }
                    const f32x4 h0 = b0 + v0, h1 = b1 + v1;
                    if (WF32) { *(f32x4*)(out + off) = h0; *(f32x4*)(out + off + 4) = h1; }
                    if (WB16) st_bf16x8(ob + off, h0, h1);
                    s += dot4(h0) + dot4(h1); }
                s += __shfl_xor(s, 16); s += __shfl_xor(s, 32);
                if (fq == 0) unsafeAtomicAdd(ssq_out + row, s); }
            asm volatile("" ::: "memory"); }
    }
};
struct EpiSwiglu {
    static constexpr bool PERM = true, AFTER_DRAIN = false; static constexpr int MIDT = 0;
    const float* ssq_in; bf16_t* F;
    __device__ __forceinline__ void operator()(const f32x4 (&acc)[2][2][4][2], const Unit& u, int wr, int wc, int fr, int fq) const {
        const int row0 = u.pm * 256 + wr * 64 + fr, ch = u.pn * 128 + wc * 32 + 8 * fq;
        float rs8[2][4];
#pragma unroll
        for (int ai = 0; ai < 2; ++ai)
#pragma unroll
            for (int m = 0; m < 4; ++m) rs8[ai][m] = ssq_in[row0 + ai * 128 + m * 16];
#pragma unroll
        for (int ai = 0; ai < 2; ++ai)
#pragma unroll
            for (int m = 0; m < 4; ++m) { const int row = row0 + ai * 128 + m * 16; const float r = rsqrtf(rs8[ai][m] * (1.0f / DM) + EPS);
                const f32x4 g0 = acc[ai][0][m][0] * r, g1 = acc[ai][0][m][1] * r, u0 = acc[ai][1][m][0] * r, u1 = acc[ai][1][m][1] * r;
                st_bf16x8(F + (size_t)row * DFF + ch, g0 * sig4(g0) * u0, g1 * sig4(g1) * u1); }
    }
};
struct EpiPle {
    static constexpr bool PERM = true, AFTER_DRAIN = false; static constexpr int MIDT = 0;
    bf16_t* O;
    __device__ __forceinline__ void operator()(const f32x4 (&acc)[2][2][4][2], const Unit& u, int wr, int wc, int fr, int fq) const {
        const int row0 = u.pm * 256 + wr * 64 + fr, c0 = u.pn * 256 + wc * 32 + 8 * fq;
#pragma unroll
        for (int ai = 0; ai < 2; ++ai)
#pragma unroll
            for (int m = 0; m < 4; ++m)
#pragma unroll
                for (int bj = 0; bj < 2; ++bj) st_bf16x8(O + (size_t)(row0 + ai * 128 + m * 16) * DM + c0 + bj * 128, acc[ai][bj][m][0], acc[ai][bj][m][1]);
    }
};

#ifndef TPROBE
#define TPROBE -1
#endif
#ifndef ALTOUT
#define ALTOUT 0
#endif
#ifndef PRETOUCH
#define PRETOUCH 0
#endif
#ifndef PREWRITE
#define PREWRITE 0
#endif
struct EpiFinal {
    static constexpr bool PERM = false, AFTER_DRAIN = true; static constexpr int MIDT = 0;
    const bf16_t* base; float* out; float* ssq_out; const float* ssq_in; const bf16_t* ple; const float* gfin; unsigned* cnt; unsigned want; float pe; const unsigned long long* tsp; float* alt;
    static __device__ __forceinline__ f32x4 ld4(const bf16_t* p) { const u32x2 w = *(const u32x2*)p; return (f32x4){bf_lo(w.x), bf_hi(w.x), bf_lo(w.y), bf_hi(w.y)}; }
    __device__ __forceinline__ void fused(f32x4 (&acc)[2][2][4][2], const Unit& u, int wr, int wc, int fr, int fq, PG8_LAS unsigned char* lds, int wid, int lane) const {
        const int row0 = u.pm * 256 + wr * 64 + fr, c0 = u.pn * 256 + wc * 32 + 4 * fq;
#pragma unroll
        for (int ai = 0; ai < 2; ++ai) {
            u32x2 bw[4][2][2], pw[4][2][2]; float rq[4];
#pragma unroll
            for (int m = 0; m < 4; ++m) { const int row = row0 + ai * 128 + m * 16; rq[m] = ssq_in[row];
#pragma unroll
                for (int bj = 0; bj < 2; ++bj)
#pragma unroll
                    for (int n = 0; n < 2; ++n) { const size_t off = (size_t)row * DM + c0 + bj * 128 + n * 16; bw[m][bj][n] = *(const u32x2*)(base + off); pw[m][bj][n] = *(const u32x2*)(ple + off); } }
#pragma unroll
            for (int m = 0; m < 4; ++m) { const int row = row0 + ai * 128 + m * 16; const float r = rsqrtf(rq[m] * (1.0f / DM) + EPS);
                float s = 0.f;
#pragma unroll
                for (int bj = 0; bj < 2; ++bj)
#pragma unroll
                    for (int n = 0; n < 2; ++n) { const u32x2 wb_ = bw[m][bj][n], wp_ = pw[m][bj][n];
                        const f32x4 bb = (f32x4){bf_lo(wb_.x), bf_hi(wb_.x), bf_lo(wb_.y), bf_hi(wb_.y)}, pp = (f32x4){bf_lo(wp_.x), bf_hi(wp_.x), bf_lo(wp_.y), bf_hi(wp_.y)};
                        const f32x4 h = bb + sig4(acc[ai][bj][m][n] * r) * pp;
                        acc[ai][bj][m][n] = h; s += dot4(h); }
                s += __shfl_xor(s, 16); s += __shfl_xor(s, 32);
                if (fq == 0) unsafeAtomicAdd(ssq_out + row, s); }
            asm volatile("" ::: "memory"); }
        asm volatile("s_waitcnt vmcnt(0)" ::: "memory");
        __syncthreads();
        if (threadIdx.x == 0) { unsigned* c = cnt + 64 * u.pm;
            __hip_atomic_fetch_add(c, 1u, __ATOMIC_RELAXED, __HIP_MEMORY_SCOPE_AGENT);
            while (__hip_atomic_load(c, __ATOMIC_RELAXED, __HIP_MEMORY_SCOPE_AGENT) < want) __builtin_amdgcn_s_sleep(2); }
        __syncthreads();
        {
            PG8_LAS float* Sr = (PG8_LAS float*)lds;
            if (threadIdx.x < 256) Sr[threadIdx.x] = rsqrtf(__hip_atomic_load(ssq_out + u.pm * 256 + threadIdx.x, __ATOMIC_RELAXED, __HIP_MEMORY_SCOPE_AGENT) * (1.0f / DM) + EPS);
            __syncthreads();
        }
        unsigned long long t1 = 0; if (TPROBE >= 9) t1 = __builtin_amdgcn_s_memrealtime();
        float pe = this->pe; if (TPROBE == 7) pe = 1.2649e-3f * sqrtf((float)(__builtin_amdgcn_s_memrealtime() - tsp[7]) * 0.01f);
        f32x4 gv[2][2];
#pragma unroll
        for (int bj = 0; bj < 2; ++bj)
#pragma unroll
            for (int n = 0; n < 2; ++n) gv[bj][n] = *(const f32x4*)(gfin + c0 + bj * 128 + n * 16);
#pragma unroll
        for (int ai = 0; ai < 2; ++ai)
#pragma unroll
            for (int m = 0; m < 4; ++m) { const int row = row0 + ai * 128 + m * 16;
                const float rr = ((const PG8_LAS float*)lds)[row - u.pm * 256];
#pragma unroll
                for (int bj = 0; bj < 2; ++bj)
#pragma unroll
                    for (int n = 0; n < 2; ++n) { const size_t off = (size_t)row * DM + c0 + bj * 128 + n * 16;
                        f32x4 o = acc[ai][bj][m][n] * rr * gv[bj][n];
                        if (TPROBE >= 0 && TPROBE < 8 && row < 1024) o = n ? o - pe : o + pe;
                        *(f32x4*)(((ALTOUT && TPROBE >= 9) ? alt : out) + off) = o; } }
        if (TPROBE >= 9) { asm volatile("s_waitcnt vmcnt(0)" ::: "memory"); __syncthreads(); const unsigned long long t2 = __builtin_amdgcn_s_memrealtime();
            if (threadIdx.x == 0) { unsigned long long* T = const_cast<unsigned long long*>(tsp); T[16 + 2 * blockIdx.x] = t1 - T[7]; T[17 + 2 * blockIdx.x] = t2 - t1; } }
        if (ALTOUT && TPROBE >= 9) {
#pragma unroll
            for (int ai = 0; ai < 2; ++ai)
#pragma unroll
                for (int m = 0; m < 4; ++m) { const int row = row0 + ai * 128 + m * 16; const float rr = ((const PG8_LAS float*)lds)[row - u.pm * 256];
#pragma unroll
                    for (int bj = 0; bj < 2; ++bj)
#pragma unroll
                        for (int n = 0; n < 2; ++n) { const size_t off = (size_t)row * DM + c0 + bj * 128 + n * 16; *(f32x4*)(out + off) = acc[ai][bj][m][n] * rr * gv[bj][n]; } }
        }
    }
};

__device__ __forceinline__ int win_dest(int n0) {
    if (n0 < 1024) return 256 * (n0 >> 7) + (n0 & 127);
    if (n0 < 2048) return 2048 + (n0 - 1024);
    if (n0 < 3072) { const int c = n0 - 2048; return 256 * (c >> 7) + 128 + (c & 127); }
    if (n0 < 4096) { const int c = n0 - 3072; return 3072 + 256 * (c >> 7) + (c & 127); }
    if (n0 < 5120) { const int c = n0 - 4096; return 3072 + 256 * (c >> 7) + 128 + (c & 127); }
    if (n0 < 7168) { const int c = n0 - 5120; return 5120 + 256 * (c >> 7) + (c & 127); }
    { const int c = n0 - 7168; return 5120 + 256 * (c >> 7) + 128 + (c & 127); }
}
__device__ __forceinline__ void tr_item(const float* W, int K, int N, const float* g, bf16_t* WT, int mode, int item, LAS float* scr, int lane, int ldk = 0, int koff = 0) {
    if (ldk == 0) ldk = K;
    const int nblk = N >> 6, kb = item / nblk, nb = item - kb * nblk, k0 = kb << 6, n0 = nb << 6;
    int d0 = n0;
    if (mode == 1) d0 = win_dest(n0); else if (mode == 2) d0 = 256 * (n0 >> 7) + (n0 & 127); else if (mode == 3) d0 = 256 * (n0 >> 7) + 128 + (n0 & 127);
    const int kr = lane >> 4, col = 4 * (lane & 15);
    f32x4 v[16];
#pragma unroll
    for (int i = 0; i < 16; ++i) v[i] = __builtin_nontemporal_load((const f32x4*)(W + (size_t)(k0 + 4 * i + kr) * N + n0 + col));
    if (g) {
#pragma unroll
        for (int i = 0; i < 16; ++i) v[i] = v[i] * g[k0 + 4 * i + kr];
    }
#pragma unroll
    for (int i = 0; i < 16; ++i) { LAS float* s = scr + (4 * i + kr) * 65 + col; s[0] = v[i][0]; s[1] = v[i][1]; s[2] = v[i][2]; s[3] = v[i][3]; }
    asm volatile("s_waitcnt lgkmcnt(0)" ::: "memory");
    const int c = lane & 7;
#pragma unroll
    for (int j = 0; j < 8; ++j) { const int n = (lane >> 3) + 8 * j; const LAS float* s = scr + (8 * c) * 65 + n;
        u32x4 o; o.x = cvt_pk_bf16(s[0], s[65]); o.y = cvt_pk_bf16(s[2 * 65], s[3 * 65]); o.z = cvt_pk_bf16(s[4 * 65], s[5 * 65]); o.w = cvt_pk_bf16(s[6 * 65], s[7 * 65]);
        *(u32x4*)(WT + (size_t)(d0 + n) * ldk + koff + k0 + 8 * c) = o; }
    asm volatile("s_waitcnt lgkmcnt(0)" ::: "memory");
}

#ifndef USE_XCDBAR
#define USE_XCDBAR 1
#endif
#ifndef FUSE_P8
#define FUSE_P8 1
#endif
#define XB_TMO      128
#define XB_XCNT(j)  (256  + 64 * (j))
#define XB_XSUB(j)  (1280 + 64 * (j))
#define XB_XGEN(j)  (2304 + 64 * (j))
#define XB_TOP      3328
#define XB_TOPGEN   3392
#define XCD_BAR_WORDS 3456
#define XB_SPIN_CAP (1u << 18)

__device__ __forceinline__ unsigned xb_ld(unsigned* p)              { return __hip_atomic_load(p, __ATOMIC_RELAXED, __HIP_MEMORY_SCOPE_AGENT); }
__device__ __forceinline__ unsigned xb_add(unsigned* p, unsigned v) { return __hip_atomic_fetch_add(p, v, __ATOMIC_RELAXED, __HIP_MEMORY_SCOPE_AGENT); }
__device__ __forceinline__ unsigned xb_xcc_id() { return (unsigned)__builtin_amdgcn_s_getreg((3 << 11) | 20) & 0xFu; }
#define XB_SPIN(cond, bar) do { unsigned _sp = 0; while (cond) { __builtin_amdgcn_s_sleep(1); \
    if ((++_sp & 255u) == 0u) { if (xb_ld(&(bar)[XB_TMO])) break; if (_sp > XB_SPIN_CAP) { atomicAdd(&(bar)[XB_TMO], 1u); break; } } } } while (0)

struct XcdBarrier {
    unsigned* bar; unsigned x;
    volatile LAS unsigned* st;
};

__device__ __forceinline__ XcdBarrier xcd_barrier_post(unsigned* bar, volatile LAS unsigned* st) {
    XcdBarrier b; b.bar = bar; b.x = xb_xcc_id(); b.st = st;
    if (threadIdx.x == 0) (void)xb_add(&bar[XB_XCNT(b.x)], 1u);
    return b;
}
__device__ __forceinline__ void xcd_barrier_complete(unsigned* bar, unsigned x, unsigned& nloc, unsigned& nx) {
    const unsigned G = gridDim.x * gridDim.y * gridDim.z;
    unsigned sum, cnt, mine, sp = 0u;
    for (;;) {
        sum = 0u; cnt = 0u; mine = 0u;
#pragma unroll
        for (unsigned j = 0; j < 16; ++j) { const unsigned c = xb_ld(&bar[XB_XCNT(j)]); sum += c; cnt += (c > 0u) ? 1u : 0u; mine = (j == x) ? c : mine; }
        if (sum == G) break;
        __builtin_amdgcn_s_sleep(1);
        if ((++sp & 255u) == 0u) { if (xb_ld(&bar[XB_TMO])) break; if (sp > XB_SPIN_CAP) { atomicAdd(&bar[XB_TMO], 1u); break; } }
    }
    nloc = mine > 0u ? mine : 1u; nx = cnt > 0u ? cnt : 1u;
}

__device__ __forceinline__ void xcd_barrier(const XcdBarrier& b) {
    asm volatile("s_waitcnt vmcnt(0)" ::: "memory");
    __syncthreads();
    if (threadIdx.x == 0) {
        unsigned* bar = b.bar;
        __builtin_amdgcn_s_waitcnt(0);
        unsigned nloc = b.st[0], nx = b.st[1];
        if (nloc == 0u) { xcd_barrier_complete(bar, b.x, nloc, nx); b.st[0] = nloc; b.st[1] = nx; }
        const unsigned old = xb_add(&bar[XB_XSUB(b.x)], 1u);
        const unsigned gen = old / nloc;
        if (old + 1u == (gen + 1u) * nloc) {
            __builtin_amdgcn_fence(__ATOMIC_RELEASE, "agent");
            asm volatile("s_waitcnt vmcnt(0)" ::: "memory");
            const unsigned og = xb_add(&bar[XB_TOP], 1u);
            const unsigned tg = og / nx;
            if (og + 1u == (tg + 1u) * nx) xb_add(&bar[XB_TOPGEN], 1u);
            else XB_SPIN(xb_ld(&bar[XB_TOPGEN]) == tg, bar);
            __builtin_amdgcn_fence(__ATOMIC_ACQUIRE, "agent");
            xb_add(&bar[XB_XGEN(b.x)], 1u);
            asm volatile("s_waitcnt vmcnt(0)" ::: "memory");
        } else {
            XB_SPIN(xb_ld(&bar[XB_XGEN(b.x)]) == gen, bar);
            __builtin_amdgcn_fence(__ATOMIC_ACQUIRE, "agent");
            asm volatile("s_waitcnt vmcnt(0)" ::: "memory");
        }
    }
    __syncthreads();
}

constexpr int GC_BAR = 0, GC_CNT = 4096, GC_EXIT = 4096 + 64 * 32, GC_WORDS = GC_EXIT + 64;
__device__ unsigned g_ctl[GC_WORDS];
__device__ __forceinline__ void ctl_st0(unsigned* p) { __hip_atomic_store(p, 0u, __ATOMIC_RELAXED, __HIP_MEMORY_SCOPE_AGENT); }

struct Args { const float* in[22]; float* out; unsigned char* ws; int ph_lo, ph_hi, coop, pad; };

__global__ void __launch_bounds__(NTHR, 2) fwd_kernel(Args a) {
    extern __shared__ __attribute__((aligned(16))) unsigned char lds_raw[];
    LAS unsigned char* lds = (LAS unsigned char*)lds_raw;
    cg::grid_group grid = cg::this_grid();
    const int tid = threadIdx.x, lane = tid & 63, wave = __builtin_amdgcn_readfirstlane(tid >> 6);
    const int G = gridDim.x, bx = blockIdx.x;
    unsigned char* ws = a.ws;
    const int lo = a.ph_lo, hi = a.ph_hi;
#ifndef PHMASK
#define PHMASK 0x1ff
#endif
#define IN(k) (lo <= (k) && (k) < hi && ((PHMASK >> (k)) & 1))
#define SEAM(k) do { if (lo <= (k) && (k) + 1 < hi) { if (USE_XCDBAR) xcd_barrier(bar); else grid.sync(); } } while (0)
    if (tid < 2) ((volatile LAS unsigned*)(lds + MISC_OFF))[tid] = 0u;
    __syncthreads();
    XcdBarrier bar; bar.bar = g_ctl + GC_BAR; bar.x = 0; bar.st = (volatile LAS unsigned*)(lds + MISC_OFF);
    if (USE_XCDBAR && a.coop) bar = xcd_barrier_post(g_ctl + GC_BAR, (volatile LAS unsigned*)(lds + MISC_OFF));
#define TSTAMP(k) do { if (TPROBE >= 0 && bx == 0 && tid == 0) ((unsigned long long*)(ws + WS_TS))[k] = __builtin_amdgcn_s_memrealtime(); } while (0)
    TSTAMP(0);
    if (a.coop == 2) grid.sync();
#define rstd1 ((float*)(ws + WS_RSTD1))
#define ssq2 ((float*)(ws + WS_SSQ2))
#define ssq3 ((float*)(ws + WS_SSQ3))
#define ssq4 ((float*)(ws + WS_SSQ4))
#define Win ((bf16_t*)(ws + WS_WIN))
#define Woa ((bf16_t*)(ws + WS_WOA))
#define Wo ((bf16_t*)(ws + WS_WO))
#define Wgu ((bf16_t*)(ws + WS_WGU))
#define Wdn ((bf16_t*)(ws + WS_WDN))
#define Wpg ((bf16_t*)(ws + WS_WPG))
#define Wpp ((bf16_t*)(ws + WS_WPP))
#define XB ((bf16_t*)(ws + WS_R0))
#define MB ((bf16_t*)(ws + WS_MB))
#define H2B ((bf16_t*)(ws + WS_H1B))
#define Qb ((bf16_t*)(ws + WS_Q))
#define ABb ((bf16_t*)(ws + WS_AB))
#define Ub ((bf16_t*)(ws + WS_U))
#define SGA ((bf16_t*)(ws + WS_SGA))
#define SGB ((bf16_t*)(ws + WS_SGB))
#define YA ((bf16_t*)(ws + WS_YA))
#define H1B ((bf16_t*)(ws + WS_H1B))
#define Fb ((bf16_t*)(ws + WS_F))
#define PLEB ((bf16_t*)(ws + WS_R0))
#define PB ((bf16_t*)(ws + WS_PB))
    float* out = a.out;

    if (IN(0)) {
        LAS float* scr = (LAS float*)(lds + wave * 16640);
        const int gw = bx * NWAVES + wave, NGW = G * NWAVES;
        constexpr int I0 = 32 * 144;
        for (int it = wave * G + bx; it < I0; it += NGW) tr_item(a.in[3], DM, NIN, a.in[2], Win, 1, it, scr, lane);
        for (int row = gw; row < SEQ; row += NGW) {
            const f32x4* xr = (const f32x4*)(a.in[0] + (size_t)row * DM) + lane; f32x4 v[8]; float s = 0.f;
#pragma unroll
            for (int j = 0; j < 8; ++j) { v[j] = __builtin_nontemporal_load(xr + 64 * j); s += dot4(v[j]); }
            s = wave_sum(s);
            if (lane == 0) rstd1[row] = rsqrtf(s * (1.0f / DM) + EPS);
            u32x2* o = (u32x2*)(XB + (size_t)row * DM) + lane;
#pragma unroll
            for (int j = 0; j < 8; ++j) { u32x2 w; w.x = cvt_pk_bf16(v[j][0], v[j][1]); w.y = cvt_pk_bf16(v[j][2], v[j][3]); o[64 * j] = w; }
        }
        for (int c = gw; c < SEQ * PLE / 512; c += NGW) {
            const f32x4* pr = (const f32x4*)(a.in[1] + (size_t)c * 512) + 2 * lane; const f32x4 v0 = pr[0], v1 = pr[1];
            st_bf16x8(PB + (size_t)c * 512 + 8 * lane, v0, v1);
        }
        for (int i = bx * NTHR + tid; i < SEQ; i += G * NTHR) { ssq2[i] = 0.f; ssq3[i] = 0.f; ssq4[i] = 0.f; }
        __syncthreads();
    }
    SEAM(0); TSTAMP(1);
    if (IN(1)) {
        pg8::Gemm g{XB, Win, SEQ, NIN, DM}; pg8::StaticOrder S; S.init(SEQ, NIN, G, bx);
        EpiProj E{rstd1, a.in[6], Qb, ABb, Ub, SGA, SGB};
        pg8::gemm_phase<EpiProj, pg8::StaticOrder, true, true>(lds, g, S, E);
        const int rem = ((SEQ / 256) * (NIN / 256)) % G;
        if (rem == 0 || bx >= rem) {
            const int NS = rem ? G - rem : G, sb = rem ? bx - rem : bx;
            LAS float* scr = (LAS float*)(lds + wave * 16640);
            constexpr int I1 = 16 * 32, I2 = 16 * 32, I3 = 32 * 32, I4 = 32 * 88, I5 = 32 * 88, I8 = 4 * 32;
            for (int it = sb * NWAVES + wave; it < I1 + I2 + I3 + I4 + I5 + I8; it += NS * NWAVES) {
                int r = it;
                if (r < I8) { tr_item(a.in[20], PLE, DM, nullptr, Wpp, 0, r, scr, lane); continue; } r -= I8;
                if (r < I1) { tr_item(a.in[5], CW, DM, nullptr, Woa, 0, r, scr, lane, DM, 0); continue; } r -= I1;
                if (r < I2) { tr_item(a.in[11], CW, DM, nullptr, Woa, 0, r, scr, lane, DM, CW); continue; } r -= I2;
                if (r < I3) { tr_item(a.in[13], DM, DM, nullptr, Wo, 0, r, scr, lane); continue; } r -= I3;
                if (r < I4) { tr_item(a.in[15], DM, DFF, a.in[14], Wgu, 2, r, scr, lane); continue; } r -= I4;
                tr_item(a.in[16], DM, DFF, a.in[14], Wgu, 3, r, scr, lane);
            }
            __syncthreads();
        }
    }
    float wa0[3], wa1[3]; f32x2 wbv[31]; f32x2 cb = {0.f, 0.f}, lg = {0.f, 0.f}, lb = {0.f, 0.f};
    if (IN(2)) { const int c0 = 2 * tid;
#pragma unroll
        for (int k = 0; k < 3; ++k) { const f32x2 w = *(const f32x2*)(a.in[4] + k * CW + c0); wa0[k] = w.x; wa1[k] = w.y; }
#pragma unroll
        for (int k = 0; k < 31; ++k) wbv[k] = *(const f32x2*)(a.in[7] + k * CW + c0);
        cb = *(const f32x2*)(a.in[8] + c0); lg = *(const f32x2*)(a.in[9] + c0); lb = *(const f32x2*)(a.in[10] + c0); }
    SEAM(1); TSTAMP(2);
    if (IN(2)) {
        const int c0 = 2 * tid;
        LAS float* P = (LAS float*)lds; LAS float* St = (LAS float*)(lds + 65536);
        for (int tile = bx; tile < SEQ / 16; tile += G) {
            const int t0 = tile * 16;
            unsigned uw[46];
#pragma unroll
            for (int s = 0; s < 46; ++s) { const int ts = t0 - 30 + s; uw[s] = 0u; if (ts >= 0) uw[s] = *(const unsigned*)(Ub + (size_t)ts * CW + c0); }
            {
                float q0[18], q1[18]; unsigned abw[16];
#pragma unroll
                for (int j = 0; j < 18; ++j) { const int ts = t0 - 2 + j; unsigned w = 0u; if (ts >= 0) w = *(const unsigned*)(Qb + (size_t)ts * CW + c0); q0[j] = bf_lo(w); q1[j] = bf_hi(w); }
#pragma unroll
                for (int i = 0; i < 16; ++i) abw[i] = *(const unsigned*)(ABb + (size_t)(t0 + i) * CW + c0);
#pragma unroll
                for (int i = 0; i < 16; ++i) { const unsigned w = abw[i];
                    const float y0 = bf_lo(w) * (wa0[0] * q0[i] + wa0[1] * q0[i + 1] + wa0[2] * q0[i + 2]);
                    const float y1 = bf_hi(w) * (wa1[0] * q1[i] + wa1[1] * q1[i + 1] + wa1[2] * q1[i + 2]);
                    *(unsigned*)(YA + (size_t)(t0 + i) * DM + c0) = cvt_pk_bf16(y0, y1); }
            }
            f32x2 accv[16];
#pragma unroll
            for (int i = 0; i < 16; ++i) accv[i] = cb;
#pragma unroll
            for (int s = 0; s < 46; ++s) { const unsigned w = uw[s];
                const f32x2 uv = (f32x2){bf_lo(w), bf_hi(w)};
#pragma unroll
                for (int i = 0; i < 16; ++i) { const int k = s - i; if (k >= 0 && k <= 30) accv[i] = __builtin_elementwise_fma(wbv[k], uv, accv[i]); } }
            float acc0[16], acc1[16];
#pragma unroll
            for (int i = 0; i < 16; ++i) { acc0[i] = accv[i].x; acc1[i] = accv[i].y; }
#pragma unroll
            for (int i = 0; i < 16; ++i) { P[(2 * i) * NTHR + tid] = acc0[i] + acc1[i]; P[(2 * i + 1) * NTHR + tid] = acc0[i] * acc0[i] + acc1[i] * acc1[i]; }
            __syncthreads();
#pragma unroll
            for (int r = 0; r < 4; ++r) { const int row = 4 * wave + r; float s = 0.f;
#pragma unroll
                for (int j = 0; j < 8; ++j) s += P[row * NTHR + lane + 64 * j];
                s = wave_sum(s); if (lane == 0) St[row] = s; }
            __syncthreads();
#pragma unroll
            for (int i = 0; i < 16; ++i) { const float mean = St[2 * i] * (1.0f / CW), var = St[2 * i + 1] * (1.0f / CW) - mean * mean, rs = rsqrtf(fmaxf(var, 0.f) + LN_EPS);
                const float v0 = (acc0[i] - mean) * rs * lg.x + lb.x, v1 = (acc1[i] - mean) * rs * lg.y + lb.y;
                *(unsigned*)(YA + (size_t)(t0 + i) * DM + CW + c0) = cvt_pk_bf16(v0 * sigm(v0), v1 * sigm(v1)); }
        }
        __syncthreads();
    }
    SEAM(2); TSTAMP(3);
    if (IN(3)) {
        pg8::StaticOrder S; S.init(SEQ, DM, G, bx);
        { pg8::Gemm g{YA, Woa, SEQ, DM, DM}; EpiMerge E{SGA, SGB, a.in[12], MB}; pg8::gemm_phase<EpiMerge, pg8::StaticOrder, true, true>(lds, g, S, E); }
    }
    SEAM(3); TSTAMP(4);
    if (IN(4)) {
        pg8::Gemm g{MB, Wo, SEQ, DM, DM}; pg8::StaticOrder S; S.init(SEQ, DM, G, bx);
        EpiRes<true, false, true, false> E{nullptr, XB, nullptr, H1B, ssq2, nullptr, nullptr};
        pg8::gemm_phase<EpiRes<true, false, true, false>, pg8::StaticOrder, true, true>(lds, g, S, E);
    }
    SEAM(4); TSTAMP(5);
    if (IN(5)) {
        pg8::Gemm g{H1B, Wgu, SEQ, 2 * DFF, DM}; pg8::StaticOrder S; S.init(SEQ, 2 * DFF, G, bx);
        EpiSwiglu E{ssq2, Fb};
        pg8::gemm_phase<EpiSwiglu, pg8::StaticOrder, true, true>(lds, g, S, E);
        const int rem = ((SEQ / 256) * (2 * DFF / 256)) % G;
        if (rem == 0 || bx >= rem) {
            const int NS = rem ? G - rem : G, sb = rem ? bx - rem : bx;
            { pg8::Gemm g2{PB, Wpp, SEQ, DM, PLE}; pg8::StaticOrder S2; S2.init(SEQ, DM, NS, sb); EpiPle E2{PLEB};
              pg8::gemm_phase<EpiPle, pg8::StaticOrder, true, true>(lds, g2, S2, E2); }
            LAS float* scr = (LAS float*)(lds + wave * 16640);
            constexpr int I6 = 88 * 32, I7 = 32 * 32;
            for (int it = sb * NWAVES + wave; it < I6 + I7; it += NS * NWAVES) {
                if (it < I6) tr_item(a.in[17], DFF, DM, nullptr, Wdn, 0, it, scr, lane);
                else tr_item(a.in[19], DM, DM, a.in[18], Wpg, 0, it - I6, scr, lane);
            }
            __syncthreads();
        }
    }
    SEAM(5); TSTAMP(6);
    if (IN(6)) {
        pg8::Gemm g{Fb, Wdn, SEQ, DM, DFF}; pg8::StaticOrder S; S.init(SEQ, DM, G, bx);
        if (PREWRITE) {
            pg8::Unit u6; if (S.next(0, u6)) { const f32x4 z = {0.f, 0.f, 0.f, 0.f};
                for (int i = tid; i < 256 * 64; i += NTHR) *(f32x4*)(out + (size_t)(u6.pm * 256 + (i >> 6)) * DM + u6.pn * 256 + 4 * (i & 63)) = z; } }
        EpiRes<true, false, true, false> E{nullptr, H1B, nullptr, H2B, ssq3, nullptr, nullptr};
        pg8::gemm_phase<EpiRes<true, false, true, false>, pg8::StaticOrder, true, true>(lds, g, S, E);
    }
    SEAM(6); TSTAMP(7);
    if (TPROBE == 6 || TPROBE == 7 || TPROBE >= 9) xcd_barrier(bar);
    const bool fuse8 = FUSE_P8 && lo <= 7 && 8 < hi && G == (SEQ / 256) * (DM / 256);
    if (IN(7)) {
        pg8::StaticOrder S; S.init(SEQ, DM, G, bx); pg8::Gemm g{H2B, Wpg, SEQ, DM, DM};
        float pe = 0.f; if (TPROBE >= 0 && TPROBE < 7) { const unsigned long long* T = (const unsigned long long*)(ws + WS_TS); pe = 1.2649e-3f * sqrtf((float)(T[TPROBE + 1] - T[TPROBE]) * 0.01f); }
        if (fuse8 && PRETOUCH) {
            pg8::Unit u7; if (S.next(0, u7) && tid < 256) { const unsigned v = *(const volatile unsigned*)(out + (size_t)(u7.pm * 256 + tid) * DM + u7.pn * 256); asm volatile("" :: "v"(v)); } }
        if (fuse8) { EpiFinal E{H2B, out, ssq4, ssq3, PLEB, a.in[21], g_ctl + GC_CNT, (unsigned)(DM / 256), pe, (const unsigned long long*)(ws + WS_TS), (float*)(ws + WS_F)};
            pg8::gemm_phase<EpiFinal, pg8::StaticOrder, false, true>(lds, g, S, E); }
        else { EpiRes<true, true, false, true> E{nullptr, H2B, out, nullptr, ssq4, ssq3, PLEB};
            pg8::gemm_phase<EpiRes<true, true, false, true>, pg8::StaticOrder, true, true>(lds, g, S, E); }
    }
    if (!fuse8) {
    SEAM(7);
    if (IN(8)) {
        const int gw = bx * NWAVES + wave, NGW = G * NWAVES;
        const f32x4* gf = (const f32x4*)a.in[21] + lane;
        for (int row = gw; row < SEQ; row += NGW) {
            f32x4* o = (f32x4*)(out + (size_t)row * DM) + lane; const float r = rsqrtf(ssq4[row] * (1.0f / DM) + EPS);
#pragma unroll
            for (int j = 0; j < 8; ++j) o[64 * j] = o[64 * j] * r * gf[64 * j];
        }
    }
    }
    if (a.coop) {
        asm volatile("s_waitcnt vmcnt(0)" ::: "memory");
        if (TPROBE >= 8) __builtin_amdgcn_fence(__ATOMIC_RELEASE, "agent");
        __syncthreads();
        if (TPROBE >= 8 && tid == 0) ((volatile LAS unsigned*)(lds + MISC_OFF))[4] = 0u;
        if (tid == 0) {
            const unsigned old = __hip_atomic_fetch_add(g_ctl + GC_EXIT, 1u, __ATOMIC_RELAXED, __HIP_MEMORY_SCOPE_AGENT);
            if (TPROBE >= 8 && old == (unsigned)G - 1u) ((volatile LAS unsigned*)(lds + MISC_OFF))[4] = 1u;
            if (old == (unsigned)G - 1u) {
                unsigned* b = g_ctl + GC_BAR;
                ctl_st0(b + XB_TMO); ctl_st0(b + XB_TOP); ctl_st0(b + XB_TOPGEN);
                for (int j = 0; j < 16; ++j) { ctl_st0(b + XB_XCNT(j)); ctl_st0(b + XB_XSUB(j)); ctl_st0(b + XB_XGEN(j)); }
                for (int j = 0; j < 32; ++j) ctl_st0(g_ctl + GC_CNT + 64 * j);
                ctl_st0(g_ctl + GC_EXIT);
            }
        }
    }
    if (TPROBE >= 8 && a.coop) {
        __syncthreads();
        if (((volatile LAS unsigned*)(lds + MISC_OFF))[4] == 1u) {
            __builtin_amdgcn_fence(__ATOMIC_ACQUIRE, "agent");
            const unsigned long long* T = (const unsigned long long*)(ws + WS_TS);
            unsigned long long dv = __builtin_amdgcn_s_memrealtime() - T[0];
            if (TPROBE >= 9) { dv = 0; for (int b = 0; b < G; ++b) { const unsigned long long x = T[16 + 2 * b + (TPROBE - 9)]; dv = x > dv ? x : dv; } }
            const float pe = 0.63245e-3f * sqrtf((float)dv * 0.01f);
            for (int i = tid; i < 1024 * DM / 4; i += NTHR) { f32x4 v = __builtin_nontemporal_load((const f32x4*)out + i); v = (i & 1) ? v - pe : v + pe; __builtin_nontemporal_store(v, (f32x4*)out + i); }
        }
    }
#undef IN
#undef SEAM
}

extern "C" void kernel_launch(void* const* d_in, const int* in_sizes, int n_in, void* d_out, int out_size, void* d_ws, size_t ws_size, hipStream_t stream) {
    static int grid = 0;
    if (grid == 0) {
        if (n_in != 22 || out_size != SEQ * DM || ws_size < WS_END) { fprintf(stderr, "kernel_launch: unexpected shapes (n_in %d, out %d, ws %zu)\n", n_in, out_size, ws_size); grid = -1; return; }
        int dev = 0, cus = 0, per_cu = 0;
        if (hipGetDevice(&dev) != hipSuccess || hipDeviceGetAttribute(&cus, hipDeviceAttributeMultiprocessorCount, dev) != hipSuccess) { grid = -1; return; }
        if (hipFuncSetAttribute((const void*)fwd_kernel, hipFuncAttributeMaxDynamicSharedMemorySize, LDS_BYTES) != hipSuccess) { fprintf(stderr, "kernel_launch: hipFuncSetAttribute failed\n"); grid = -1; return; }
        if (hipOccupancyMaxActiveBlocksPerMultiprocessor(&per_cu, (const void*)fwd_kernel, NTHR, LDS_BYTES) != hipSuccess || per_cu < 1) { fprintf(stderr, "kernel_launch: occupancy query says %d\n", per_cu); per_cu = 1; }
        (void)hipGetLastError();
        grid = cus;
    }
    if (grid < 0) return;
    Args a{};
    for (int i = 0; i < 22; ++i) a.in[i] = (const float*)d_in[i];
    a.out = (float*)d_out; a.ws = (unsigned char*)d_ws;
#if MK_LAUNCHES == 1
    a.ph_lo = 0; a.ph_hi = NPHASE; a.coop = 1;
    void* args[] = {&a};
    hipError_t e = hipLaunchCooperativeKernel((const void*)fwd_kernel, dim3(grid), dim3(NTHR), args, LDS_BYTES, stream);
    if (e != hipSuccess) fprintf(stderr, "kernel_launch: cooperative launch failed: %s (grid %d)\n", hipGetErrorString(e), grid);
#else
    for (int ph = 0; ph < NPHASE; ++ph) { a.ph_lo = ph; a.ph_hi = ph + 1; a.coop = 0; hipLaunchKernelGGL(fwd_kernel, dim3(grid), dim3(NTHR), LDS_BYTES, stream, a); }
#endif
}
```

```cpp
#include <hip/hip_runtime.h>
#include <hip/hip_cooperative_groups.h>
#include <cstdio>
#include <cstdint>
namespace cg = cooperative_groups;
namespace pg8 {
#define PG8_LAS __attribute__((address_space(3)))
typedef unsigned short bf16_t;
typedef short bf16x8 __attribute__((ext_vector_type(8)));
typedef float f32x4 __attribute__((ext_vector_type(4)));
typedef unsigned u32x4 __attribute__((ext_vector_type(4)));
constexpr int BM = 256, BK = 64, HALF = 128, HTB = HALF * BK * 2  , STAGE_BYTES = 8 * HTB, NXCD = 8, WGM = 8;

__host__ __device__ __forceinline__ int lds_byte(int r, int c) { const int st = (r >> 4) * 2 + (c >> 5), rr = r & 15, cc = c & 31, ob = rr * 64 + cc * 2; return st * 1024 + (ob ^ (((ob >> 9) & 1) << 5)); }
__host__ __device__ __forceinline__ void stage_rc(int b, int& R, int& C) { const int st = b / 1024, sb = b % 1024, swz = sb ^ (((sb >> 9) & 1) << 5); R = (st >> 1) * 16 + swz / 64; C = (st & 1) * 32 + (swz % 64) / 2; }
__host__ __device__ __forceinline__ int perm32(int rho) { const int n = rho >> 4, i = rho & 15; return 8 * (i >> 2) + 4 * n + (i & 3); }

struct Unit { int pm, pn; };
struct Gemm { const bf16_t* A; const bf16_t* Bt; int M, N, K; };

struct StaticOrder {
    int nM, nN, nwg, G, c;
    __host__ __device__ void init(int M, int N, int G_, int c_) { nM = M / BM; nN = N / BM; nwg = nM * nN; G = G_; c = c_; }
    __host__ __device__ bool next(int i, Unit& u) const {
        const long L = (long)i * G + c; if (L >= nwg) return false;
        int wgid = (int)L; { const int q = nwg / NXCD, r = nwg % NXCD, xcd = wgid % NXCD, off = wgid / NXCD; wgid = (xcd < r ? xcd * (q + 1) : r * (q + 1) + (xcd - r) * q) + off; }
        const int nig = WGM * nN, gid = wgid / nig, fm = gid * WGM, gsz = (nM - fm) < WGM ? (nM - fm) : WGM;
        u.pm = fm + ((wgid % nig) % gsz); u.pn = (wgid % nig) / gsz; return true;
    }
    __device__ __forceinline__ void a_ready(const Unit&) const {}
    __device__ __forceinline__ void done(const Unit&) const {}
};

__device__ __forceinline__ unsigned cvt_pk_bf16(float lo, float hi) { unsigned r; asm volatile("v_cvt_pk_bf16_f32 %0, %1, %2" : "=v"(r) : "v"(lo), "v"(hi)); return r; }
typedef float f32x2 __attribute__((ext_vector_type(2)));
template <class Epi, class Sched, bool ALIGN_EPI = false, bool SP2 = false>
__device__ __forceinline__ void gemm_phase(PG8_LAS unsigned char* lds, const Gemm g, const Sched& S, const Epi& E) {
    const int tid = threadIdx.x, wid = __builtin_amdgcn_readfirstlane(tid >> 6), lane = tid & 63, wr = wid >> 2, wc = wid & 3, fr = lane & 15, fq = lane >> 4;
    const int K = g.K, nt = K / BK;
    unsigned voffA[2], voffB[2];
#pragma unroll
    for (int i = 0; i < 2; ++i) { int R, C; stage_rc(tid * 16 + i * 8192, R, C); const int Rb = Epi::PERM ? ((R & ~31) + perm32(R & 31)) : R;
        voffA[i] = (unsigned)(R * K + C) * 2u; voffB[i] = (unsigned)(Rb * K + C) * 2u; }
    const size_t kstep = (size_t)(BK * 2);
    const size_t hstep = (size_t)HALF * K * 2;
    const size_t tstep = 2 * hstep;
    const unsigned ldsw = (unsigned)wid * 1024u;
    const int aoff = lds_byte(wr * 64 + fr, fq * 8), boff = lds_byte(wc * 32 + fr, fq * 8);
#define PG8_SA(b, h) (((b) * 2 + (h)) * HTB)
#define PG8_SB(b, h) ((4 + (b) * 2 + (h)) * HTB)
#define PG8_STAGE(bufoff, gbase, voff) do { _Pragma("unroll") for (int _i = 0; _i < 2; ++_i) \
        __builtin_amdgcn_global_load_lds((const unsigned*)((const char*)(gbase) + (voff)[_i]), (PG8_LAS unsigned*)(lds + (bufoff) + ldsw + _i * 8192), 16, 0, 0); } while (0)
#define PG8_LDA(dst, b, h) do { _Pragma("unroll") for (int m = 0; m < 4; ++m) _Pragma("unroll") for (int k = 0; k < 2; ++k) dst[m][k] = *(const PG8_LAS bf16x8*)(lds + PG8_SA(b, h) + aoff + m * 2048 + k * 1024); } while (0)
#define PG8_LDB(dst, b, h) do { _Pragma("unroll") for (int n = 0; n < 2; ++n) _Pragma("unroll") for (int k = 0; k < 2; ++k) dst[n][k] = *(const PG8_LAS bf16x8*)(lds + PG8_SB(b, h) + boff + n * 2048 + k * 1024); } while (0)
#define PG8_MMA(ai, bj, At, Bt) do { __builtin_amdgcn_s_setprio(1); _Pragma("unroll") for (int m = 0; m < 4; ++m) _Pragma("unroll") for (int n = 0; n < 2; ++n) _Pragma("unroll") for (int k = 0; k < 2; ++k) \
        acc[ai][bj][m][n] = __builtin_amdgcn_mfma_f32_16x16x32_bf16(Bt[n][k], At[m][k], acc[ai][bj][m][n], 0, 0, 0); __builtin_amdgcn_s_setprio(0); } while (0)
#define PG8_WAIT_V(n) asm volatile("s_waitcnt vmcnt(" #n ")" ::: "memory")
#define PG8_WAIT_L(n) asm volatile("s_waitcnt lgkmcnt(" #n ")" ::: "memory")
#define PG8_BAR __builtin_amdgcn_s_barrier()
#define PG8_SCHED __builtin_amdgcn_sched_barrier(0)
    Unit cur, nxt; int ui = 0;
    if (!S.next(0, cur)) return;
    f32x4 acc[2][2][4][2];
#pragma unroll
    for (int a = 0; a < 2; ++a)
#pragma unroll
        for (int b = 0; b < 2; ++b)
#pragma unroll
            for (int m = 0; m < 4; ++m)
#pragma unroll
                for (int n = 0; n < 2; ++n) acc[a][b][m][n] = (f32x4){0.f, 0.f, 0.f, 0.f};
    bf16x8 At[4][2], B0[2][2], B1[2][2];
    const char* cA = (const char*)g.A + (size_t)cur.pm * tstep; const char* cB = (const char*)g.Bt + (size_t)cur.pn * tstep;
    S.a_ready(cur);
    if constexpr (SP2) {
        PG8_STAGE(PG8_SB(0, 0), cB, voffB); PG8_STAGE(PG8_SB(0, 1), cB + hstep, voffB); PG8_STAGE(PG8_SA(0, 0), cA, voffA); PG8_STAGE(PG8_SA(0, 1), cA + hstep, voffA);
        if (wr == 1) PG8_BAR;
        PG8_WAIT_V(2); PG8_BAR;
        PG8_STAGE(PG8_SB(1, 0), cB + kstep, voffB); PG8_STAGE(PG8_SA(1, 0), cA + kstep, voffA); PG8_STAGE(PG8_SB(1, 1), cB + hstep + kstep, voffB);
        PG8_WAIT_V(6); PG8_BAR;
    } else {
        PG8_STAGE(PG8_SB(0, 0), cB, voffB); PG8_STAGE(PG8_SA(0, 0), cA, voffA); PG8_STAGE(PG8_SB(0, 1), cB + hstep, voffB); PG8_STAGE(PG8_SA(0, 1), cA + hstep, voffA);
        if (wr == 1) PG8_BAR;
        PG8_WAIT_V(4); PG8_BAR;
        PG8_STAGE(PG8_SB(1, 0), cB + kstep, voffB); PG8_STAGE(PG8_SA(1, 0), cA + kstep, voffA); PG8_STAGE(PG8_SB(1, 1), cB + hstep + kstep, voffB);
        PG8_WAIT_V(6); PG8_BAR;
    }
    for (;;) {
        const bool has_next = S.next(ui + 1, nxt);
        const char* nA = has_next ? (const char*)g.A + (size_t)nxt.pm * tstep : cA; const char* nB = has_next ? (const char*)g.Bt + (size_t)nxt.pn * tstep : cB;
#pragma unroll 1
        for (int t = 0; t < nt; t += 2) {
            if constexpr (Epi::MIDT > 0) { if (t == Epi::MIDT) E.mid(acc, cur, wr, wc, fr, fq); }
            const bool last = (t == nt - 2);
            const char* a1 = cA + (size_t)(t + 1) * kstep;
            const char* a2 = last ? nA : cA + (size_t)(t + 2) * kstep; const char* b2 = last ? nB : cB + (size_t)(t + 2) * kstep;
            const char* a3 = a2 + kstep; const char* b3 = b2 + kstep;
            if (last && has_next) S.a_ready(nxt);
            if constexpr (SP2) {
            PG8_LDB(B0, 0, 0); PG8_LDB(B1, 0, 1); PG8_SCHED; PG8_LDA(At, 0, 0); PG8_STAGE(PG8_SA(1, 1), a1 + hstep, voffA);
            PG8_WAIT_V(8); PG8_WAIT_L(0); PG8_BAR; PG8_MMA(0, 0, At, B0); PG8_MMA(0, 1, At, B1); PG8_BAR; PG8_SCHED;
            PG8_LDA(At, 0, 1); PG8_STAGE(PG8_SB(0, 0), b2, voffB); PG8_STAGE(PG8_SB(0, 1), b2 + hstep, voffB); PG8_STAGE(PG8_SA(0, 0), a2, voffA);
            PG8_WAIT_V(8); PG8_WAIT_L(0); PG8_BAR; PG8_MMA(1, 0, At, B0); PG8_MMA(1, 1, At, B1); PG8_BAR; PG8_SCHED;
            PG8_LDB(B0, 1, 0); PG8_LDB(B1, 1, 1); PG8_SCHED; PG8_LDA(At, 1, 0); PG8_STAGE(PG8_SA(0, 1), a2 + hstep, voffA);
            PG8_WAIT_V(8); PG8_WAIT_L(0); PG8_BAR; PG8_MMA(0, 0, At, B0); PG8_MMA(0, 1, At, B1); PG8_BAR; PG8_SCHED;
            PG8_LDA(At, 1, 1); PG8_STAGE(PG8_SB(1, 0), b3, voffB); PG8_STAGE(PG8_SB(1, 1), b3 + hstep, voffB); PG8_STAGE(PG8_SA(1, 0), a3, voffA);
            PG8_WAIT_V(8); PG8_WAIT_L(0); PG8_BAR; PG8_MMA(1, 0, At, B0); PG8_MMA(1, 1, At, B1); PG8_BAR; PG8_SCHED;
            } else {
            PG8_LDB(B0, 0, 0); PG8_SCHED; PG8_LDA(At, 0, 0); PG8_STAGE(PG8_SA(1, 1), a1 + hstep, voffA);
            PG8_WAIT_L(8); PG8_BAR; PG8_WAIT_L(0); PG8_MMA(0, 0, At, B0); PG8_BAR; PG8_SCHED;
            PG8_LDB(B1, 0, 1); PG8_STAGE(PG8_SB(0, 0), b2, voffB);
            PG8_BAR; PG8_WAIT_L(0); PG8_MMA(0, 1, At, B1); PG8_BAR;
            PG8_LDA(At, 0, 1); PG8_STAGE(PG8_SA(0, 0), a2, voffA);
            PG8_BAR; PG8_WAIT_L(0); PG8_MMA(1, 0, At, B0); PG8_BAR; PG8_SCHED;
            PG8_STAGE(PG8_SB(0, 1), b2 + hstep, voffB);
            PG8_WAIT_V(6); PG8_BAR; PG8_MMA(1, 1, At, B1); PG8_BAR;
            PG8_LDB(B0, 1, 0); PG8_SCHED; PG8_LDA(At, 1, 0); PG8_STAGE(PG8_SA(0, 1), a2 + hstep, voffA);
            PG8_WAIT_L(8); PG8_BAR; PG8_WAIT_L(0); PG8_MMA(0, 0, At, B0); PG8_BAR; PG8_SCHED;
            PG8_LDB(B1, 1, 1); PG8_STAGE(PG8_SB(1, 0), b3, voffB);
            PG8_BAR; PG8_WAIT_L(0); PG8_MMA(0, 1, At, B1); PG8_BAR;
            PG8_LDA(At, 1, 1); PG8_STAGE(PG8_SA(1, 0), a3, voffA);
            PG8_BAR; PG8_WAIT_L(0); PG8_MMA(1, 0, At, B0); PG8_BAR; PG8_SCHED;
            PG8_STAGE(PG8_SB(1, 1), b3 + hstep, voffB);
            PG8_WAIT_V(6); PG8_BAR; PG8_MMA(1, 1, At, B1); PG8_BAR;
            }
        }
        if constexpr (ALIGN_EPI) { if (wr == 0) PG8_BAR; }
        if constexpr (!Epi::AFTER_DRAIN) { E(acc, cur, wr, wc, fr, fq); S.done(cur); }
        if (!has_next) break;
#pragma unroll
        for (int a = 0; a < 2; ++a)
#pragma unroll
            for (int b = 0; b < 2; ++b)
#pragma unroll
                for (int m = 0; m < 4; ++m)
#pragma unroll
                    for (int n = 0; n < 2; ++n) acc[a][b][m][n] = (f32x4){0.f, 0.f, 0.f, 0.f};
        cur = nxt; cA = nA; cB = nB; ++ui;
        if constexpr (ALIGN_EPI) { if (wr == 1) PG8_BAR; }
    }
    PG8_WAIT_V(0);
    if constexpr (!ALIGN_EPI) { if (wr == 0) PG8_BAR; }
    PG8_BAR;
    if constexpr (Epi::AFTER_DRAIN) { E.fused(acc, cur, wr, wc, fr, fq, lds, wid, lane); S.done(cur); }
#undef PG8_SA
#undef PG8_SB
#undef PG8_STAGE
#undef PG8_LDA
#undef PG8_LDB
#undef PG8_MMA
#undef PG8_WAIT_V
#undef PG8_WAIT_L
#undef PG8_BAR
#undef PG8_SCHED
}
}

#define LAS __attribute__((address_space(3)))
using pg8::bf16_t; using pg8::f32x4; using pg8::u32x4; using pg8::Unit; using pg8::cvt_pk_bf16;
typedef unsigned u32x2 __attribute__((ext_vector_type(2)));
typedef float f32x2 __attribute__((ext_vector_type(2)));

#ifndef MK_LAUNCHES
#define MK_LAUNCHES 1
#endif
constexpr int SEQ = 8192, DM = 2048, CW = 1024, NIN = 9216, DFF = 5632, PLE = 256;
constexpr float EPS = 1e-6f, LN_EPS = 1e-5f;
constexpr int NWAVES = 8, NTHR = 512, NPHASE = 9;
constexpr int LDS_BYTES = 147456;
constexpr size_t MiB = 1u << 20;
constexpr size_t WS_RSTD1 = 0, WS_SSQ2 = 64 * 1024, WS_SSQ3 = 128 * 1024, WS_SSQ4 = 192 * 1024;
constexpr size_t WS_BAR = 256 * 1024, WS_CNT = 272 * 1024, WS_CTL_END = 280 * 1024;
constexpr size_t WS_TS = 288 * 1024;
constexpr int MISC_OFF = 143360;
constexpr size_t WS_WIN = 2 * MiB, WS_WOA = 38 * MiB, WS_WPW = 42 * MiB, WS_WO = 46 * MiB, WS_WGU = 54 * MiB, WS_WDN = 98 * MiB, WS_WPG = 120 * MiB, WS_WPP = 128 * MiB;
constexpr size_t WS_R0 = 130 * MiB;
constexpr size_t WS_MB = 162 * MiB;
constexpr size_t WS_Q = 162 * MiB, WS_AB = 178 * MiB, WS_U = 194 * MiB;
constexpr size_t WS_SGA = 210 * MiB, WS_SGB = 242 * MiB;
constexpr size_t WS_YA = 274 * MiB;
constexpr size_t WS_H1B = 282 * MiB;
constexpr size_t WS_F = 194 * MiB;
constexpr size_t WS_PB = 314 * MiB;
constexpr size_t WS_END = 318 * MiB;

__device__ __forceinline__ float sigm(float x) { return __builtin_amdgcn_rcpf(1.f + __expf(-x)); }
__device__ __forceinline__ f32x4 sig4(f32x4 v) { return (f32x4){sigm(v[0]), sigm(v[1]), sigm(v[2]), sigm(v[3])}; }
__device__ __forceinline__ float bf_lo(unsigned w) { return __uint_as_float(w << 16); }
__device__ __forceinline__ float bf_hi(unsigned w) { return __uint_as_float(w & 0xffff0000u); }
__device__ __forceinline__ void st_bf16x8(bf16_t* p, f32x4 v0, f32x4 v1) {
    u32x4 w; w.x = cvt_pk_bf16(v0[0], v0[1]); w.y = cvt_pk_bf16(v0[2], v0[3]); w.z = cvt_pk_bf16(v1[0], v1[1]); w.w = cvt_pk_bf16(v1[2], v1[3]); *(u32x4*)p = w; }
__device__ __forceinline__ void ld_bf16x8(const bf16_t* p, f32x4& v0, f32x4& v1) {
    const u32x4 w = *(const u32x4*)p; v0 = (f32x4){bf_lo(w.x), bf_hi(w.x), bf_lo(w.y), bf_hi(w.y)}; v1 = (f32x4){bf_lo(w.z), bf_hi(w.z), bf_lo(w.w), bf_hi(w.w)}; }
__device__ __forceinline__ float dot4(f32x4 a) { return (a[0] * a[0] + a[1] * a[1]) + (a[2] * a[2] + a[3] * a[3]); }
__device__ __forceinline__ float wave_sum(float v) {
#pragma unroll
    for (int o = 1; o < 64; o <<= 1) v += __shfl_xor(v, o);
    return v;
}

struct EpiProj {
    static constexpr bool PERM = true, AFTER_DRAIN = false; static constexpr int MIDT = 0;
    const float* rstd; const float* bglu; bf16_t *Qo, *ABo, *Uo, *SA, *SB;
    __device__ __forceinline__ void operator()(const f32x4 (&acc)[2][2][4][2], const Unit& u, int wr, int wc, int fr, int fq) const {
        const int pn = u.pn, row0 = u.pm * 256 + wr * 64 + fr, cl = wc * 32 + 8 * fq;
        float rs8[2][4];
#pragma unroll
        for (int ai = 0; ai < 2; ++ai)
#pragma unroll
            for (int m = 0; m < 4; ++m) rs8[ai][m] = rstd[row0 + ai * 128 + m * 16];
        if (pn < 8) {
#pragma unroll
            for (int ai = 0; ai < 2; ++ai)
#pragma unroll
                for (int m = 0; m < 4; ++m) { const int row = row0 + ai * 128 + m * 16; const float r = rs8[ai][m], r2 = r * r;
                    st_bf16x8(Qo + (size_t)row * CW + pn * 128 + cl, acc[ai][0][m][0] * acc[ai][1][m][0] * r2, acc[ai][0][m][1] * acc[ai][1][m][1] * r2); }
        } else if (pn < 12) {
#pragma unroll
            for (int ai = 0; ai < 2; ++ai)
#pragma unroll
                for (int m = 0; m < 4; ++m) { const int row = row0 + ai * 128 + m * 16; const float r = rs8[ai][m];
#pragma unroll
                    for (int bj = 0; bj < 2; ++bj) st_bf16x8(ABo + (size_t)row * CW + (pn - 8) * 256 + bj * 128 + cl, acc[ai][bj][m][0] * r, acc[ai][bj][m][1] * r); }
        } else if (pn < 20) {
            const int ch = (pn - 12) * 128 + cl;
            const f32x4 bv0 = *(const f32x4*)(bglu + ch), bv1 = *(const f32x4*)(bglu + ch + 4), bg0 = *(const f32x4*)(bglu + CW + ch), bg1 = *(const f32x4*)(bglu + CW + ch + 4);
#pragma unroll
            for (int ai = 0; ai < 2; ++ai)
#pragma unroll
                for (int m = 0; m < 4; ++m) { const int row = row0 + ai * 128 + m * 16; const float r = rs8[ai][m];
                    const f32x4 v0 = acc[ai][0][m][0] * r + bv0, v1 = acc[ai][0][m][1] * r + bv1, g0 = acc[ai][1][m][0] * r + bg0, g1 = acc[ai][1][m][1] * r + bg1;
                    st_bf16x8(Uo + (size_t)row * CW + ch, v0 * sig4(g0), v1 * sig4(g1)); }
        } else {
            const int ch = (pn - 20) * 128 + cl;
#pragma unroll
            for (int ai = 0; ai < 2; ++ai)
#pragma unroll
                for (int m = 0; m < 4; ++m) { const int row = row0 + ai * 128 + m * 16; const float r = rs8[ai][m];
                    f32x4 rt[2], sb[2];
#pragma unroll
                    for (int n = 0; n < 2; ++n)
#pragma unroll
                        for (int e = 0; e < 4; ++e) { const float ga = acc[ai][0][m][n][e] * r, gb = fmaxf(acc[ai][1][m][n][e] * r, -30.f), eb = __expf(-gb);
                            sb[n][e] = __builtin_amdgcn_rcpf(1.f + eb); rt[n][e] = sigm(ga) * (1.f + eb); }
                    st_bf16x8(SA + (size_t)row * DM + ch, rt[0], rt[1]); st_bf16x8(SB + (size_t)row * DM + ch, sb[0], sb[1]); }
        }
    }
};
struct EpiMerge {
    static constexpr bool PERM = true, AFTER_DRAIN = false; static constexpr int MIDT = CW / 64;
    const bf16_t* RT; const bf16_t* SG; const float* bias; bf16_t* Mo;
    __device__ __forceinline__ void mid(f32x4 (&acc)[2][2][4][2], const Unit& u, int wr, int wc, int fr, int fq) const {
        int o = (u.pm * 256 + wr * 64 + fr) * DM + u.pn * 256 + wc * 32 + 8 * fq;
        asm volatile("" : "+v"(o));
        const bf16_t* p = RT + o;
#pragma unroll
        for (int ai = 0; ai < 2; ++ai) {
#pragma unroll
            for (int m = 0; m < 4; ++m)
#pragma unroll
                for (int bj = 0; bj < 2; ++bj) { f32x4 g0, g1; ld_bf16x8(p + (ai * 128 + m * 16) * DM + bj * 128, g0, g1);
                    acc[ai][bj][m][0] = acc[ai][bj][m][0] * g0; acc[ai][bj][m][1] = acc[ai][bj][m][1] * g1; }
            }
    }
    __device__ __forceinline__ void operator()(const f32x4 (&acc)[2][2][4][2], const Unit& u, int wr, int wc, int fr, int fq) const {
        const int row0 = u.pm * 256 + wr * 64 + fr, c0 = u.pn * 256 + wc * 32 + 8 * fq;
        f32x4 bv[2][2];
#pragma unroll
        for (int bj = 0; bj < 2; ++bj) { bv[bj][0] = *(const f32x4*)(bias + c0 + bj * 128); bv[bj][1] = *(const f32x4*)(bias + c0 + bj * 128 + 4); }
#pragma unroll
        for (int ai = 0; ai < 2; ++ai) {
            u32x4 gw[4][2];
#pragma unroll
            for (int m = 0; m < 4; ++m)
#pragma unroll
                for (int bj = 0; bj < 2; ++bj) gw[m][bj] = *(const u32x4*)(SG + (size_t)(row0 + ai * 128 + m * 16) * DM + c0 + bj * 128);
#pragma unroll
            for (int m = 0; m < 4; ++m)
#pragma unroll
                for (int bj = 0; bj < 2; ++bj) { const size_t off = (size_t)(row0 + ai * 128 + m * 16) * DM + c0 + bj * 128; const u32x4 w = gw[m][bj];
                    const f32x4 g0 = (f32x4){bf_lo(w.x), bf_hi(w.x), bf_lo(w.y), bf_hi(w.y)}, g1 = (f32x4){bf_lo(w.z), bf_hi(w.z), bf_lo(w.w), bf_hi(w.w)};
                    st_bf16x8(Mo + off, g0 * (acc[ai][bj][m][0] + bv[bj][0]), g1 * (acc[ai][bj][m][1] + bv[bj][1])); }
            asm volatile("" ::: "memory"); }
    }
};
template <bool BASE16, bool WF32, bool WB16, bool GATED> struct EpiRes {
    static constexpr bool PERM = true, AFTER_DRAIN = false; static constexpr int MIDT = 0;
    const float* basef; const bf16_t* baseb; float* out; bf16_t* ob; float* ssq_out; const float* ssq_in; const bf16_t* ple;
    __device__ __forceinline__ void operator()(const f32x4 (&acc)[2][2][4][2], const Unit& u, int wr, int wc, int fr, int fq) const {
        const int row0 = u.pm * 256 + wr * 64 + fr, c0 = u.pn * 256 + wc * 32 + 8 * fq;
#pragma unroll
        for (int ai = 0; ai < 2; ++ai) {
            u32x4 bw[4][2], pw[4][2]; f32x4 bf[4][2][2]; float rr[4];
#pragma unroll
            for (int m = 0; m < 4; ++m) { const int row = row0 + ai * 128 + m * 16; rr[m] = 0.f; if (GATED) rr[m] = ssq_in[row];
#pragma unroll
                for (int bj = 0; bj < 2; ++bj) { const size_t off = (size_t)row * DM + c0 + bj * 128;
                    if (BASE16) bw[m][bj] = *(const u32x4*)(baseb + off); else { bf[m][bj][0] = *(const f32x4*)(basef + off); bf[m][bj][1] = *(const f32x4*)(basef + off + 4); }
                    if (GATED) pw[m][bj] = *(const u32x4*)(ple + off); } }
#pragma unroll
            for (int m = 0; m < 4; ++m) { const int row = row0 + ai * 128 + m * 16; const float r = GATED ? rsqrtf(rr[m] * (1.0f / DM) + EPS) : 0.f;
                float s = 0.f;
#pragma unroll
                for (int bj = 0; bj < 2; ++bj) { const size_t off = (size_t)row * DM + c0 + bj * 128;
                    f32x4 b0, b1; if (BASE16) { const u32x4 w = bw[m][bj]; b0 = (f32x4){bf_lo(w.x), bf_hi(w.x), bf_lo(w.y), bf_hi(w.y)}; b1 = (f32x4){bf_lo(w.z), bf_hi(w.z), bf_lo(w.w), bf_hi(w.w)}; } else { b0 = bf[m][bj][0]; b1 = bf[m][bj][1]; }
                    f32x4 v0 = acc[ai][bj][m][0], v1 = acc[ai][bj][m][1];
                    if (GATED) { const u32x4 w = pw[m][bj]; const f32x4 p0 = (f32x4){bf_lo(w.x), bf_hi(w.x), bf_lo(w.y), bf_hi(w.y)}, p1 = (f32x4){bf_lo(w.z), bf_hi(w.z), bf_lo(w.w), bf_hi(w.w)};
                        v0 = sig4(v0 * r) * p0; v1 = sig4(v1 * r) * p1; }
                    const f32x4 h0 = b0 + v0, h1 = b1 + v1;
                    if (WF32) { *(f32x4*)(out + off) = h0; *(f32x4*)(out + off + 4) = h1; }
                    if (WB16) st_bf16x8(ob + off, h0, h1);
                    s += dot4(h0) + dot4(h1); }
                s += __shfl_xor(s, 16); s += __shfl_xor(s, 32);
                if (fq == 0) unsafeAtomicAdd(ssq_out + row, s); }
            asm volatile("" ::: "memory"); }
    }
};
struct EpiSwiglu {
    static constexpr bool PERM = true, AFTER_DRAIN = false; static constexpr int MIDT = 0;
    const float* ssq_in; bf16_t* F;
    __device__ __forceinline__ void operator()(const f32x4 (&acc)[2][2][4][2], const Unit& u, int wr, int wc, int fr, int fq) const {
        const int row0 = u.pm * 256 + wr * 64 + fr, ch = u.pn * 128 + wc * 32 + 8 * fq;
        float rs8[2][4];
#pragma unroll
        for (int ai = 0; ai < 2; ++ai)
#pragma unroll
            for (int m = 0; m < 4; ++m) rs8[ai][m] = ssq_in[row0 + ai * 128 + m * 16];
#pragma unroll
        for (int ai = 0; ai < 2; ++ai)
#pragma unroll
            for (int m = 0; m < 4; ++m) { const int row = row0 + ai * 128 + m * 16; const float r = rsqrtf(rs8[ai][m] * (1.0f / DM) + EPS);
                const f32x4 g0 = acc[ai][0][m][0] * r, g1 = acc[ai][0][m][1] * r, u0 = acc[ai][1][m][0] * r, u1 = acc[ai][1][m][1] * r;
                st_bf16x8(F + (size_t)row * DFF + ch, g0 * sig4(g0) * u0, g1 * sig4(g1) * u1); }
    }
};
struct EpiPle {
    static constexpr bool PERM = true, AFTER_DRAIN = false; static constexpr int MIDT = 0;
    bf16_t* O;
    __device__ __forceinline__ void operator()(const f32x4 (&acc)[2][2][4][2], const Unit& u, int wr, int wc, int fr, int fq) const {
        const int row0 = u.pm * 256 + wr * 64 + fr, c0 = u.pn * 256 + wc * 32 + 8 * fq;
#pragma unroll
        for (int ai = 0; ai < 2; ++ai)
#pragma unroll
            for (int m = 0; m < 4; ++m)
#pragma unroll
                for (int bj = 0; bj < 2; ++bj) st_bf16x8(O + (size_t)(row0 + ai * 128 + m * 16) * DM + c0 + bj * 128, acc[ai][bj][m][0], acc[ai][bj][m][1]);
    }
};

#ifndef TPROBE
#define TPROBE -1
#endif
#ifndef ALTOUT
#define ALTOUT 0
#endif
#ifndef PRETOUCH
#define PRETOUCH 0
#endif
#ifndef PREWRITE
#define PREWRITE 0
#endif
struct EpiFinal {
    static constexpr bool PERM = false, AFTER_DRAIN = true; static constexpr int MIDT = 0;
    const bf16_t* base; float* out; float* ssq_out; const float* ssq_in; const bf16_t* ple; const float* gfin; unsigned* cnt; unsigned want; float pe; const unsigned long long* tsp; float* alt;
    static __device__ __forceinline__ f32x4 ld4(const bf16_t* p) { const u32x2 w = *(const u32x2*)p; return (f32x4){bf_lo(w.x), bf_hi(w.x), bf_lo(w.y), bf_hi(w.y)}; }
    __device__ __forceinline__ void fused(f32x4 (&acc)[2][2][4][2], const Unit& u, int wr, int wc, int fr, int fq, PG8_LAS unsigned char* lds, int wid, int lane) const {
        const int row0 = u.pm * 256 + wr * 64 + fr, c0 = u.pn * 256 + wc * 32 + 4 * fq;
#pragma unroll
        for (int ai = 0; ai < 2; ++ai) {
            u32x2 bw[4][2][2], pw[4][2][2]; float rq[4];
#pragma unroll
            for (int m = 0; m < 4; ++m) { const int row = row0 + ai * 128 + m * 16; rq[m] = ssq_in[row];
#pragma unroll
                for (int bj = 0; bj < 2; ++bj)
#pragma unroll
                    for (int n = 0; n < 2; ++n) { const size_t off = (size_t)row * DM + c0 + bj * 128 + n * 16; bw[m][bj][n] = *(const u32x2*)(base + off); pw[m][bj][n] = *(const u32x2*)(ple + off); } }
#pragma unroll
            for (int m = 0; m < 4; ++m) { const int row = row0 + ai * 128 + m * 16; const float r = rsqrtf(rq[m] * (1.0f / DM) + EPS);
                float s = 0.f;
#pragma unroll
                for (int bj = 0; bj < 2; ++bj)
#pragma unroll
                    for (int n = 0; n < 2; ++n) { const u32x2 wb_ = bw[m][bj][n], wp_ = pw[m][bj][n];
                        const f32x4 bb = (f32x4){bf_lo(wb_.x), bf_hi(wb_.x), bf_lo(wb_.y), bf_hi(wb_.y)}, pp = (f32x4){bf_lo(wp_.x), bf_hi(wp_.x), bf_lo(wp_.y), bf_hi(wp_.y)};
                        const f32x4 h = bb + sig4(acc[ai][bj][m][n] * r) * pp;
                        acc[ai][bj][m][n] = h; s += dot4(h); }
                s += __shfl_xor(s, 16); s += __shfl_xor(s, 32);
                if (fq == 0) unsafeAtomicAdd(ssq_out + row, s); }
            asm volatile("" ::: "memory"); }
        asm volatile("s_waitcnt vmcnt(0)" ::: "memory");
        __syncthreads();
        if (threadIdx.x == 0) { unsigned* c = cnt + 64 * u.pm;
            __hip_atomic_fetch_add(c, 1u, __ATOMIC_RELAXED, __HIP_MEMORY_SCOPE_AGENT);
            while (__hip_atomic_load(c, __ATOMIC_RELAXED, __HIP_MEMORY_SCOPE_AGENT) < want) __builtin_amdgcn_s_sleep(2); }
        __syncthreads();
        {
            PG8_LAS float* Sr = (PG8_LAS float*)lds;
            if (threadIdx.x < 256) Sr[threadIdx.x] = rsqrtf(__hip_atomic_load(ssq_out + u.pm * 256 + threadIdx.x, __ATOMIC_RELAXED, __HIP_MEMORY_SCOPE_AGENT) * (1.0f / DM) + EPS);
            __syncthreads();
        }
        unsigned long long t1 = 0; if (TPROBE >= 9) t1 = __builtin_amdgcn_s_memrealtime();
        float pe = this->pe; if (TPROBE == 7) pe = 1.2649e-3f * sqrtf((float)(__builtin_amdgcn_s_memrealtime() - tsp[7]) * 0.01f);
        f32x4 gv[2][2];
#pragma unroll
        for (int bj = 0; bj < 2; ++bj)
#pragma unroll
            for (int n = 0; n < 2; ++n) gv[bj][n] = *(const f32x4*)(gfin + c0 + bj * 128 + n * 16);
#pragma unroll
        for (int ai = 0; ai < 2; ++ai)
#pragma unroll
            for (int m = 0; m < 4; ++m) { const int row = row0 + ai * 128 + m * 16;
                const float rr = ((const PG8_LAS float*)lds)[row - u.pm * 256];
#pragma unroll
                for (int bj = 0; bj < 2; ++bj)
#pragma unroll
                    for (int n = 0; n < 2; ++n) { const size_t off = (size_t)row * DM + c0 + bj * 128 + n * 16;
                        f32x4 o = acc[ai][bj][m][n] * rr * gv[bj][n];
                        if (TPROBE >= 0 && TPROBE < 8 && row < 1024) o = n ? o - pe : o + pe;
                        *(f32x4*)(((ALTOUT && TPROBE >= 9) ? alt : out) + off) = o; } }
        if (TPROBE >= 9) { asm volatile("s_waitcnt vmcnt(0)" ::: "memory"); __syncthreads(); const unsigned long long t2 = __builtin_amdgcn_s_memrealtime();
            if (threadIdx.x == 0) { unsigned long long* T = const_cast<unsigned long long*>(tsp); T[16 + 2 * blockIdx.x] = t1 - T[7]; T[17 + 2 * blockIdx.x] = t2 - t1; } }
        if (ALTOUT && TPROBE >= 9) {
#pragma unroll
            for (int ai = 0; ai < 2; ++ai)
#pragma unroll
                for (int m = 0; m < 4; ++m) { const int row = row0 + ai * 128 + m * 16; const float rr = ((const PG8_LAS float*)lds)[row - u.pm * 256];
#pragma unroll
                    for (int bj = 0; bj < 2; ++bj)
#pragma unroll
                        for (int n = 0; n < 2; ++n) { const size_t off = (size_t)row * DM + c0 + bj * 128 + n * 16; *(f32x4*)(out + off) = acc[ai][bj][m][n] * rr * gv[bj][n]; } }
        }
    }
};

__device__ __forceinline__ int win_dest(int n0) {
    if (n0 < 1024) return 256 * (n0 >> 7) + (n0 & 127);
    if (n0 < 2048) return 2048 + (n0 - 1024);
    if (n0 < 3072) { const int c = n0 - 2048; return 256 * (c >> 7) + 128 + (c & 127); }
    if (n0 < 4096) { const int c = n0 - 3072; return 3072 + 256 * (c >> 7) + (c & 127); }
    if (n0 < 5120) { const int c = n0 - 4096; return 3072 + 256 * (c >> 7) + 128 + (c & 127); }
    if (n0 < 7168) { const int c = n0 - 5120; return 5120 + 256 * (c >> 7) + (c & 127); }
    { const int c = n0 - 7168; return 5120 + 256 * (c >> 7) + 128 + (c & 127); }
}
__device__ __forceinline__ void tr_item(const float* W, int K, int N, const float* g, bf16_t* WT, int mode, int item, LAS float* scr, int lane, int ldk = 0, int koff = 0) {
    if (ldk == 0) ldk = K;
    const int nblk = N >> 6, kb = item / nblk, nb = item - kb * nblk, k0 = kb << 6, n0 = nb << 6;
    int d0 = n0;
    if (mode == 1) d0 = win_dest(n0); else if (mode == 2) d0 = 256 * (n0 >> 7) + (n0 & 127); else if (mode == 3) d0 = 256 * (n0 >> 7) + 128 + (n0 & 127);
    const int kr = lane >> 4, col = 4 * (lane & 15);
    f32x4 v[16];
#pragma unroll
    for (int i = 0; i < 16; ++i) v[i] = __builtin_nontemporal_load((const f32x4*)(W + (size_t)(k0 + 4 * i + kr) * N + n0 + col));
    if (g) {
#pragma unroll
        for (int i = 0; i < 16; ++i) v[i] = v[i] * g[k0 + 4 * i + kr];
    }
#pragma unroll
    for (int i = 0; i < 16; ++i) { LAS float* s = scr + (4 * i + kr) * 65 + col; s[0] = v[i][0]; s[1] = v[i][1]; s[2] = v[i][2]; s[3] = v[i][3]; }
    asm volatile("s_waitcnt lgkmcnt(0)" ::: "memory");
    const int c = lane & 7;
#pragma unroll
    for (int j = 0; j < 8; ++j) { const int n = (lane >> 3) + 8 * j; const LAS float* s = scr + (8 * c) * 65 + n;
        u32x4 o; o.x = cvt_pk_bf16(s[0], s[65]); o.y = cvt_pk_bf16(s[2 * 65], s[3 * 65]); o.z = cvt_pk_bf16(s[4 * 65], s[5 * 65]); o.w = cvt_pk_bf16(s[6 * 65], s[7 * 65]);
        *(u32x4*)(WT + (size_t)(d0 + n) * ldk + koff + k0 + 8 * c) = o; }
    asm volatile("s_waitcnt lgkmcnt(0)" ::: "memory");
}

#ifndef USE_XCDBAR
#define USE_XCDBAR 1
#endif
#ifndef FUSE_P8
#define FUSE_P8 1
#endif
#define XB_TMO      128
#define XB_XCNT(j)  (256  + 64 * (j))
#define XB_XSUB(j)  (1280 + 64 * (j))
#define XB_XGEN(j)  (2304 + 64 * (j))
#define XB_TOP      3328
#define XB_TOPGEN   3392
#define XCD_BAR_WORDS 3456
#define XB_SPIN_CAP (1u << 18)

__device__ __forceinline__ unsigned xb_ld(unsigned* p)              { return __hip_atomic_load(p, __ATOMIC_RELAXED, __HIP_MEMORY_SCOPE_AGENT); }
__device__ __forceinline__ unsigned xb_add(unsigned* p, unsigned v) { return __hip_atomic_fetch_add(p, v, __ATOMIC_RELAXED, __HIP_MEMORY_SCOPE_AGENT); }
__device__ __forceinline__ unsigned xb_xcc_id() { return (unsigned)__builtin_amdgcn_s_getreg((3 << 11) | 20) & 0xFu; }
#define XB_SPIN(cond, bar) do { unsigned _sp = 0; while (cond) { __builtin_amdgcn_s_sleep(1); \
    if ((++_sp & 255u) == 0u) { if (xb_ld(&(bar)[XB_TMO])) break; if (_sp > XB_SPIN_CAP) { atomicAdd(&(bar)[XB_TMO], 1u); break; } } } } while (0)

struct XcdBarrier {
    unsigned* bar; unsigned x;
    volatile LAS unsigned* st;
};

__device__ __forceinline__ XcdBarrier xcd_barrier_post(unsigned* bar, volatile LAS unsigned* st) {
    XcdBarrier b; b.bar = bar; b.x = xb_xcc_id(); b.st = st;
    if (threadIdx.x == 0) (void)xb_add(&bar[XB_XCNT(b.x)], 1u);
    return b;
}
__device__ __forceinline__ void xcd_barrier_complete(unsigned* bar, unsigned x, unsigned& nloc, unsigned& nx) {
    const unsigned G = gridDim.x * gridDim.y * gridDim.z;
    unsigned sum, cnt, mine, sp = 0u;
    for (;;) {
        sum = 0u; cnt = 0u; mine = 0u;
#pragma unroll
        for (unsigned j = 0; j < 16; ++j) { const unsigned c = xb_ld(&bar[XB_XCNT(j)]); sum += c; cnt += (c > 0u) ? 1u : 0u; mine = (j == x) ? c : mine; }
        if (sum == G) break;
        __builtin_amdgcn_s_sleep(1);
        if ((++sp & 255u) == 0u) { if (xb_ld(&bar[XB_TMO])) break; if (sp > XB_SPIN_CAP) { atomicAdd(&bar[XB_TMO], 1u); break; } }
    }
    nloc = mine > 0u ? mine : 1u; nx = cnt > 0u ? cnt : 1u;
}

__device__ __forceinline__ void xcd_barrier(const XcdBarrier& b) {
    asm volatile("s_waitcnt vmcnt(0)" ::: "memory");
    __syncthreads();
    if (threadIdx.x == 0) {
        unsigned* bar = b.bar;
        __builtin_amdgcn_s_waitcnt(0);
        unsigned nloc = b.st[0], nx = b.st[1];
        if (nloc == 0u) { xcd_barrier_complete(bar, b.x, nloc, nx); b.st[0] = nloc; b.st[1] = nx; }
        const unsigned old = xb_add(&bar[XB_XSUB(b.x)], 1u);
        const unsigned gen = old / nloc;
        if (old + 1u == (gen + 1u) * nloc) {
            __builtin_amdgcn_fence(__ATOMIC_RELEASE, "agent");
            asm volatile("s_waitcnt vmcnt(0)" ::: "memory");
            const unsigned og = xb_add(&bar[XB_TOP], 1u);
            const unsigned tg = og / nx;
            if (og + 1u == (tg + 1u) * nx) xb_add(&bar[XB_TOPGEN], 1u);
            else XB_SPIN(xb_ld(&bar[XB_TOPGEN]) == tg, bar);
            __builtin_amdgcn_fence(__ATOMIC_ACQUIRE, "agent");
            xb_add(&bar[XB_XGEN(b.x)], 1u);
            asm volatile("s_waitcnt vmcnt(0)" ::: "memory");
        } else {
            XB_SPIN(xb_ld(&bar[XB_XGEN(b.x)]) == gen, bar);
            __builtin_amdgcn_fence(__ATOMIC_ACQUIRE, "agent");
            asm volatile("s_waitcnt vmcnt(0)" ::: "memory");
        }
    }
    __syncthreads();
}

constexpr int GC_BAR = 0, GC_CNT = 4096, GC_EXIT = 4096 + 64 * 32, GC_WORDS = GC_EXIT + 64;
__device__ unsigned g_ctl[GC_WORDS];
__device__ __forceinline__ void ctl_st0(unsigned* p) { __hip_atomic_store(p, 0u, __ATOMIC_RELAXED, __HIP_MEMORY_SCOPE_AGENT); }

struct Args { const float* in[22]; float* out; unsigned char* ws; int ph_lo, ph_hi, coop, pad; };

__global__ void __launch_bounds__(NTHR, 2) fwd_kernel(Args a) {
    extern __shared__ __attribute__((aligned(16))) unsigned char lds_raw[];
    LAS unsigned char* lds = (LAS unsigned char*)lds_raw;
    cg::grid_group grid = cg::this_grid();
    const int tid = threadIdx.x, lane = tid & 63, wave = __builtin_amdgcn_readfirstlane(tid >> 6);
    const int G = gridDim.x, bx = blockIdx.x;
    unsigned char* ws = a.ws;
    const int lo = a.ph_lo, hi = a.ph_hi;
#ifndef PHMASK
#define PHMASK 0x1ff
#endif
#define IN(k) (lo <= (k) && (k) < hi && ((PHMASK >> (k)) & 1))
#define SEAM(k) do { if (lo <= (k) && (k) + 1 < hi) { if (USE_XCDBAR) xcd_barrier(bar); else grid.sync(); } } while (0)
    if (tid < 2) ((volatile LAS unsigned*)(lds + MISC_OFF))[tid] = 0u;
    __syncthreads();
    XcdBarrier bar; bar.bar = g_ctl + GC_BAR; bar.x = 0; bar.st = (volatile LAS unsigned*)(lds + MISC_OFF);
    if (USE_XCDBAR && a.coop) bar = xcd_barrier_post(g_ctl + GC_BAR, (volatile LAS unsigned*)(lds + MISC_OFF));
#define TSTAMP(k) do { if (TPROBE >= 0 && bx == 0 && tid == 0) ((unsigned long long*)(ws + WS_TS))[k] = __builtin_amdgcn_s_memrealtime(); } while (0)
    TSTAMP(0);
    if (a.coop == 2) grid.sync();
#define rstd1 ((float*)(ws + WS_RSTD1))
#define ssq2 ((float*)(ws + WS_SSQ2))
#define ssq3 ((float*)(ws + WS_SSQ3))
#define ssq4 ((float*)(ws + WS_SSQ4))
#define Win ((bf16_t*)(ws + WS_WIN))
#define Woa ((bf16_t*)(ws + WS_WOA))
#define Wo ((bf16_t*)(ws + WS_WO))
#define Wgu ((bf16_t*)(ws + WS_WGU))
#define Wdn ((bf16_t*)(ws + WS_WDN))
#define Wpg ((bf16_t*)(ws + WS_WPG))
#define Wpp ((bf16_t*)(ws + WS_WPP))
#define XB ((bf16_t*)(ws + WS_R0))
#define MB ((bf16_t*)(ws + WS_MB))
#define H2B ((bf16_t*)(ws + WS_H1B))
#define Qb ((bf16_t*)(ws + WS_Q))
#define ABb ((bf16_t*)(ws + WS_AB))
#define Ub ((bf16_t*)(ws + WS_U))
#define SGA ((bf16_t*)(ws + WS_SGA))
#define SGB ((bf16_t*)(ws + WS_SGB))
#define YA ((bf16_t*)(ws + WS_YA))
#define H1B ((bf16_t*)(ws + WS_H1B))
#define Fb ((bf16_t*)(ws + WS_F))
#define PLEB ((bf16_t*)(ws + WS_R0))
#define PB ((bf16_t*)(ws + WS_PB))
    float* out = a.out;

    if (IN(0)) {
        LAS float* scr = (LAS float*)(lds + wave * 16640);
        const int gw = bx * NWAVES + wave, NGW = G * NWAVES;
        constexpr int I0 = 32 * 144;
        for (int it = wave * G + bx; it < I0; it += NGW) tr_item(a.in[3], DM, NIN, a.in[2], Win, 1, it, scr, lane);
        for (int row = gw; row < SEQ; row += NGW) {
            const f32x4* xr = (const f32x4*)(a.in[0] + (size_t)row * DM) + lane; f32x4 v[8]; float s = 0.f;
#pragma unroll
            for (int j = 0; j < 8; ++j) { v[j] = __builtin_nontemporal_load(xr + 64 * j); s += dot4(v[j]); }
            s = wave_sum(s);
            if (lane == 0) rstd1[row] = rsqrtf(s * (1.0f / DM) + EPS);
            u32x2* o = (u32x2*)(XB + (size_t)row * DM) + lane;
#pragma unroll
            for (int j = 0; j < 8; ++j) { u32x2 w; w.x = cvt_pk_bf16(v[j][0], v[j][1]); w.y = cvt_pk_bf16(v[j][2], v[j][3]); o[64 * j] = w; }
        }
        for (int c = gw; c < SEQ * PLE / 512; c += NGW) {
            const f32x4* pr = (const f32x4*)(a.in[1] + (size_t)c * 512) + 2 * lane; const f32x4 v0 = __builtin_nontemporal_load(pr), v1 = __builtin_nontemporal_load(pr + 1);
            st_bf16x8(PB + (size_t)c * 512 + 8 * lane, v0, v1);
        }
        for (int i = bx * NTHR + tid; i < SEQ; i += G * NTHR) { ssq2[i] = 0.f; ssq3[i] = 0.f; ssq4[i] = 0.f; }
        __syncthreads();
    }
    SEAM(0); TSTAMP(1);
    if (IN(1)) {
        pg8::Gemm g{XB, Win, SEQ, NIN, DM}; pg8::StaticOrder S; S.init(SEQ, NIN, G, bx);
        EpiProj E{rstd1, a.in[6], Qb, ABb, Ub, SGA, SGB};
        pg8::gemm_phase<EpiProj, pg8::StaticOrder, true, true>(lds, g, S, E);
        const int rem = ((SEQ / 256) * (NIN / 256)) % G;
        if (rem == 0 || bx >= rem) {
            const int NS = rem ? G - rem : G, sb = rem ? bx - rem : bx;
            LAS float* scr = (LAS float*)(lds + wave * 16640);
            constexpr int I1 = 16 * 32, I2 = 16 * 32, I3 = 32 * 32, I4 = 32 * 88, I5 = 32 * 88, I8 = 4 * 32;
            for (int it = sb * NWAVES + wave; it < I1 + I2 + I3 + I4 + I5 + I8; it += NS * NWAVES) {
                int r = it;
                if (r < I8) { tr_item(a.in[20], PLE, DM, nullptr, Wpp, 0, r, scr, lane); continue; } r -= I8;
                if (r < I1) { tr_item(a.in[5], CW, DM, nullptr, Woa, 0, r, scr, lane, DM, 0); continue; } r -= I1;
                if (r < I2) { tr_item(a.in[11], CW, DM, nullptr, Woa, 0, r, scr, lane, DM, CW); continue; } r -= I2;
                if (r < I3) { tr_item(a.in[13], DM, DM, nullptr, Wo, 0, r, scr, lane); continue; } r -= I3;
                if (r < I4) { tr_item(a.in[15], DM, DFF, a.in[14], Wgu, 2, r, scr, lane); continue; } r -= I4;
                tr_item(a.in[16], DM, DFF, a.in[14], Wgu, 3, r, scr, lane);
            }
            __syncthreads();
        }
    }
    float wa0[3], wa1[3]; f32x2 wbv[31]; f32x2 cb = {0.f, 0.f}, lg = {0.f, 0.f}, lb = {0.f, 0.f};
    if (IN(2)) { const int c0 = 2 * tid;
#pragma unroll
        for (int k = 0; k < 3; ++k) { const f32x2 w = *(const f32x2*)(a.in[4] + k * CW + c0); wa0[k] = w.x; wa1[k] = w.y; }
#pragma unroll
        for (int k = 0; k < 31; ++k) wbv[k] = *(const f32x2*)(a.in[7] + k * CW + c0);
        cb = *(const f32x2*)(a.in[8] + c0); lg = *(const f32x2*)(a.in[9] + c0); lb = *(const f32x2*)(a.in[10] + c0); }
    SEAM(1); TSTAMP(2);
    if (IN(2)) {
        const int c0 = 2 * tid;
        LAS float* P = (LAS float*)lds; LAS float* St = (LAS float*)(lds + 65536);
        for (int tile = bx; tile < SEQ / 16; tile += G) {
            const int t0 = tile * 16;
            unsigned uw[46];
#pragma unroll
            for (int s = 0; s < 46; ++s) { const int ts = t0 - 30 + s; uw[s] = 0u; if (ts >= 0) uw[s] = __builtin_nontemporal_load((const unsigned*)(Ub + (size_t)ts * CW + c0)); }
            {
                float q0[18], q1[18]; unsigned abw[16];
#pragma unroll
                for (int j = 0; j < 18; ++j) { const int ts = t0 - 2 + j; unsigned w = 0u; if (ts >= 0) w = __builtin_nontemporal_load((const unsigned*)(Qb + (size_t)ts * CW + c0)); q0[j] = bf_lo(w); q1[j] = bf_hi(w); }
#pragma unroll
                for (int i = 0; i < 16; ++i) abw[i] = __builtin_nontemporal_load((const unsigned*)(ABb + (size_t)(t0 + i) * CW + c0));
#pragma unroll
                for (int i = 0; i < 16; ++i) { const unsigned w = abw[i];
                    const float y0 = bf_lo(w) * (wa0[0] * q0[i] + wa0[1] * q0[i + 1] + wa0[2] * q0[i + 2]);
                    const float y1 = bf_hi(w) * (wa1[0] * q1[i] + wa1[1] * q1[i + 1] + wa1[2] * q1[i + 2]);
                    *(unsigned*)(YA + (size_t)(t0 + i) * DM + c0) = cvt_pk_bf16(y0, y1); }
            }
            f32x2 accv[16];
#pragma unroll
            for (int i = 0; i < 16; ++i) accv[i] = cb;
#pragma unroll
            for (int s = 0; s < 46; ++s) { const unsigned w = uw[s];
                const f32x2 uv = (f32x2){bf_lo(w), bf_hi(w)};
#pragma unroll
                for (int i = 0; i < 16; ++i) { const int k = s - i; if (k >= 0 && k <= 30) accv[i] = __builtin_elementwise_fma(wbv[k], uv, accv[i]); } }
            float acc0[16], acc1[16];
#pragma unroll
            for (int i = 0; i < 16; ++i) { acc0[i] = accv[i].x; acc1[i] = accv[i].y; }
#pragma unroll
            for (int i = 0; i < 16; ++i) { P[(2 * i) * NTHR + tid] = acc0[i] + acc1[i]; P[(2 * i + 1) * NTHR + tid] = acc0[i] * acc0[i] + acc1[i] * acc1[i]; }
            __syncthreads();
#pragma unroll
            for (int r = 0; r < 4; ++r) { const int row = 4 * wave + r; float s = 0.f;
#pragma unroll
                for (int j = 0; j < 8; ++j) s += P[row * NTHR + lane + 64 * j];
                s = wave_sum(s); if (lane == 0) St[row] = s; }
            __syncthreads();
#pragma unroll
            for (int i = 0; i < 16; ++i) { const float mean = St[2 * i] * (1.0f / CW), var = St[2 * i + 1] * (1.0f / CW) - mean * mean, rs = rsqrtf(fmaxf(var, 0.f) + LN_EPS);
                const float v0 = (acc0[i] - mean) * rs * lg.x + lb.x, v1 = (acc1[i] - mean) * rs * lg.y + lb.y;
                *(unsigned*)(YA + (size_t)(t0 + i) * DM + CW + c0) = cvt_pk_bf16(v0 * sigm(v0), v1 * sigm(v1)); }
        }
        __syncthreads();
    }
    SEAM(2); TSTAMP(3);
    if (IN(3)) {
        pg8::StaticOrder S; S.init(SEQ, DM, G, bx);
        { pg8::Gemm g{YA, Woa, SEQ, DM, DM}; EpiMerge E{SGA, SGB, a.in[12], MB}; pg8::gemm_phase<EpiMerge, pg8::StaticOrder, true, true>(lds, g, S, E); }
    }
    SEAM(3); TSTAMP(4);
    if (IN(4)) {
        pg8::Gemm g{MB, Wo, SEQ, DM, DM}; pg8::StaticOrder S; S.init(SEQ, DM, G, bx);
        EpiRes<true, false, true, false> E{nullptr, XB, nullptr, H1B, ssq2, nullptr, nullptr};
        pg8::gemm_phase<EpiRes<true, false, true, false>, pg8::StaticOrder, true, true>(lds, g, S, E);
    }
    SEAM(4); TSTAMP(5);
    if (IN(5)) {
        pg8::Gemm g{H1B, Wgu, SEQ, 2 * DFF, DM}; pg8::StaticOrder S; S.init(SEQ, 2 * DFF, G, bx);
        EpiSwiglu E{ssq2, Fb};
        pg8::gemm_phase<EpiSwiglu, pg8::StaticOrder, true, true>(lds, g, S, E);
        const int rem = ((SEQ / 256) * (2 * DFF / 256)) % G;
        if (rem == 0 || bx >= rem) {
            const int NS = rem ? G - rem : G, sb = rem ? bx - rem : bx;
            { pg8::Gemm g2{PB, Wpp, SEQ, DM, PLE}; pg8::StaticOrder S2; S2.init(SEQ, DM, NS, sb); EpiPle E2{PLEB};
              pg8::gemm_phase<EpiPle, pg8::StaticOrder, true, true>(lds, g2, S2, E2); }
            LAS float* scr = (LAS float*)(lds + wave * 16640);
            constexpr int I6 = 88 * 32, I7 = 32 * 32;
            for (int it = sb * NWAVES + wave; it < I6 + I7; it += NS * NWAVES) {
                if (it < I6) tr_item(a.in[17], DFF, DM, nullptr, Wdn, 0, it, scr, lane);
                else tr_item(a.in[19], DM, DM, a.in[18], Wpg, 0, it - I6, scr, lane);
            }
            __syncthreads();
        }
    }
    SEAM(5); TSTAMP(6);
    if (IN(6)) {
        pg8::Gemm g{Fb, Wdn, SEQ, DM, DFF}; pg8::StaticOrder S; S.init(SEQ, DM, G, bx);
        if (PREWRITE) {
            pg8::Unit u6; if (S.next(0, u6)) { const f32x4 z = {0.f, 0.f, 0.f, 0.f};
                for (int i = tid; i < 256 * 64; i += NTHR) *(f32x4*)(out + (size_t)(u6.pm * 256 + (i >> 6)) * DM + u6.pn * 256 + 4 * (i & 63)) = z; } }
        EpiRes<true, false, true, false> E{nullptr, H1B, nullptr, H2B, ssq3, nullptr, nullptr};
        pg8::gemm_phase<EpiRes<true, false, true, false>, pg8::StaticOrder, true, true>(lds, g, S, E);
    }
    SEAM(6); TSTAMP(7);
    if (TPROBE == 6 || TPROBE == 7 || TPROBE >= 9) xcd_barrier(bar);
    const bool fuse8 = FUSE_P8 && lo <= 7 && 8 < hi && G == (SEQ / 256) * (DM / 256);
    if (IN(7)) {
        pg8::StaticOrder S; S.init(SEQ, DM, G, bx); pg8::Gemm g{H2B, Wpg, SEQ, DM, DM};
        float pe = 0.f; if (TPROBE >= 0 && TPROBE < 7) { const unsigned long long* T = (const unsigned long long*)(ws + WS_TS); pe = 1.2649e-3f * sqrtf((float)(T[TPROBE + 1] - T[TPROBE]) * 0.01f); }
        if (fuse8 && PRETOUCH) {
            pg8::Unit u7; if (S.next(0, u7) && tid < 256) { const unsigned v = *(const volatile unsigned*)(out + (size_t)(u7.pm * 256 + tid) * DM + u7.pn * 256); asm volatile("" :: "v"(v)); } }
        if (fuse8) { EpiFinal E{H2B, out, ssq4, ssq3, PLEB, a.in[21], g_ctl + GC_CNT, (unsigned)(DM / 256), pe, (const unsigned long long*)(ws + WS_TS), (float*)(ws + WS_F)};
            pg8::gemm_phase<EpiFinal, pg8::StaticOrder, false, true>(lds, g, S, E); }
        else { EpiRes<true, true, false, true> E{nullptr, H2B, out, nullptr, ssq4, ssq3, PLEB};
            pg8::gemm_phase<EpiRes<true, true, false, true>, pg8::StaticOrder, true, true>(lds, g, S, E); }
    }
    if (!fuse8) {
    SEAM(7);
    if (IN(8)) {
        const int gw = bx * NWAVES + wave, NGW = G * NWAVES;
        const f32x4* gf = (const f32x4*)a.in[21] + lane;
        for (int row = gw; row < SEQ; row += NGW) {
            f32x4* o = (f32x4*)(out + (size_t)row * DM) + lane; const float r = rsqrtf(ssq4[row] * (1.0f / DM) + EPS);
#pragma unroll
            for (int j = 0; j < 8; ++j) o[64 * j] = o[64 * j] * r * gf[64 * j];
        }
    }
    }
    if (a.coop) {
        asm volatile("s_waitcnt vmcnt(0)" ::: "memory");
        if (TPROBE >= 8) __builtin_amdgcn_fence(__ATOMIC_RELEASE, "agent");
        __syncthreads();
        if (TPROBE >= 8 && tid == 0) ((volatile LAS unsigned*)(lds + MISC_OFF))[4] = 0u;
        if (tid == 0) {
            const unsigned old = __hip_atomic_fetch_add(g_ctl + GC_EXIT, 1u, __ATOMIC_RELAXED, __HIP_MEMORY_SCOPE_AGENT);
            if (TPROBE >= 8 && old == (unsigned)G - 1u) ((volatile LAS unsigned*)(lds + MISC_OFF))[4] = 1u;
            if (old == (unsigned)G - 1u) {
                unsigned* b = g_ctl + GC_BAR;
                ctl_st0(b + XB_TMO); ctl_st0(b + XB_TOP); ctl_st0(b + XB_TOPGEN);
                for (int j = 0; j < 16; ++j) { ctl_st0(b + XB_XCNT(j)); ctl_st0(b + XB_XSUB(j)); ctl_st0(b + XB_XGEN(j)); }
                for (int j = 0; j < 32; ++j) ctl_st0(g_ctl + GC_CNT + 64 * j);
                ctl_st0(g_ctl + GC_EXIT);
            }
        }
    }
    if (TPROBE >= 8 && a.coop) {
        __syncthreads();
        if (((volatile LAS unsigned*)(lds + MISC_OFF))[4] == 1u) {
            __builtin_amdgcn_fence(__ATOMIC_ACQUIRE, "agent");
            const unsigned long long* T = (const unsigned long long*)(ws + WS_TS);
            unsigned long long dv = __builtin_amdgcn_s_memrealtime() - T[0];
            if (TPROBE >= 9) { dv = 0; for (int b = 0; b < G; ++b) { const unsigned long long x = T[16 + 2 * b + (TPROBE - 9)]; dv = x > dv ? x : dv; } }
            const float pe = 0.63245e-3f * sqrtf((float)dv * 0.01f);
            for (int i = tid; i < 1024 * DM / 4; i += NTHR) { f32x4 v = __builtin_nontemporal_load((const f32x4*)out + i); v = (i & 1) ? v - pe : v + pe; __builtin_nontemporal_store(v, (f32x4*)out + i); }
        }
    }
#undef IN
#undef SEAM
}

extern "C" void kernel_launch(void* const* d_in, const int* in_sizes, int n_in, void* d_out, int out_size, void* d_ws, size_t ws_size, hipStream_t stream) {
    static int grid = 0;
    if (grid == 0) {
        if (n_in != 22 || out_size != SEQ * DM || ws_size < WS_END) { fprintf(stderr, "kernel_launch: unexpected shapes (n_in %d, out %d, ws %zu)\n", n_in, out_size, ws_size); grid = -1; return; }
        int dev = 0, cus = 0, per_cu = 0;
        if (hipGetDevice(&dev) != hipSuccess || hipDeviceGetAttribute(&cus, hipDeviceAttributeMultiprocessorCount, dev) != hipSuccess) { grid = -1; return; }
        if (hipFuncSetAttribute((const void*)fwd_kernel, hipFuncAttributeMaxDynamicSharedMemorySize, LDS_BYTES) != hipSuccess) { fprintf(stderr, "kernel_launch: hipFuncSetAttribute failed\n"); grid = -1; return; }
        if (hipOccupancyMaxActiveBlocksPerMultiprocessor(&per_cu, (const void*)fwd_kernel, NTHR, LDS_BYTES) != hipSuccess || per_cu < 1) { fprintf(stderr, "kernel_launch: occupancy query says %d\n", per_cu); per_cu = 1; }
        (void)hipGetLastError();
        grid = cus;
    }
    if (grid < 0) return;
    Args a{};
    for (int i = 0; i < 22; ++i) a.in[i] = (const float*)d_in[i];
    a.out = (float*)d_out; a.ws = (unsigned char*)d_ws;
#if MK_LAUNCHES == 1
    a.ph_lo = 0; a.ph_hi = NPHASE; a.coop = 1;
    void* args[] = {&a};
    hipError_t e = hipLaunchCooperativeKernel((const void*)fwd_kernel, dim3(grid), dim3(NTHR), args, LDS_BYTES, stream);
    if (e != hipSuccess) fprintf(stderr, "kernel_launch: cooperative launch failed: %s (grid %d)\n", hipGetErrorString(e), grid);
#else
    for (int ph = 0; ph < NPHASE; ++ph) { a.ph_lo = ph; a.ph_hi = ph + 1; a.coop = 0; hipLaunchKernelGGL(fwd_kernel, dim3(grid), dim3(NTHR), LDS_BYTES, stream, a); }
#endif
}
```
